# Optimizing an MI355X kernel written in HIP

```python
import jax, jax.numpy as jnp
from jax import lax
import numpy as np

D_MODEL = 2048
BATCH = 1
SEQ = 16384
DEPTH = 4
DEC_BATCH = 4
DEC_SEQ = 8192
PAST_LEN = 128

HEAD_DIM = 128
A_Q_HEADS = 4
A_KV_HEADS = 2
A_HALF_WINDOW = 128
B_GROUPS = ((128, 1), (512, 4), (2048, 16))
B_HEADS_PER_GROUP = 2
B_HEADS = B_HEADS_PER_GROUP * len(B_GROUPS)
C_Q_HEADS = 6
C_KV_HEADS = 2
C_BLOCK = 128
GRID_W = 64
ROPE_THETA = 10000.0
D_FF = 5632
N_BRANCH = 3
NORM_EPS = 1e-6
MASK_VALUE = -1e30

A_Q = A_Q_HEADS * HEAD_DIM
A_KV = A_KV_HEADS * HEAD_DIM
B_W = B_HEADS * HEAD_DIM
C_Q = C_Q_HEADS * HEAD_DIM
C_KV = C_KV_HEADS * HEAD_DIM
A_WIDTH = A_Q + 2 * A_KV
B_WIDTH = 3 * B_W
C_WIDTH = C_Q + 2 * C_KV
IN_WIDTH = A_WIDTH + B_WIDTH + C_WIDTH
MIX_WIDTH = A_Q + B_W + C_Q

kernel_name = "hybrid_gated_window_dilated_axial_encoder"


def rms_norm(x, g):
    xf = x.astype(jnp.float32)
    y = xf * lax.rsqrt(jnp.mean(xf * xf, axis=-1, keepdims=True) + NORM_EPS)
    return (y * g.astype(jnp.float32)).astype(x.dtype)


def rope_angles(pos, dim):
    inv = ROPE_THETA ** (-jnp.arange(0, dim, 2, dtype=jnp.float32) / dim)
    return pos.astype(jnp.float32)[:, None] * inv[None, :]


def apply_rope(x, ang):
    cos = jnp.cos(ang)[None, :, None, :]
    sin = jnp.sin(ang)[None, :, None, :]
    xf = x.astype(jnp.float32)
    x1, x2 = jnp.split(xf, 2, axis=-1)
    out = jnp.concatenate([x1 * cos - x2 * sin, x2 * cos + x1 * sin], axis=-1)
    return out.astype(x.dtype)


def apply_axial_rope(x, ang_row, ang_col):
    half = HEAD_DIM // 2
    return jnp.concatenate([apply_rope(x[..., :half], ang_row), apply_rope(x[..., half:], ang_col)], axis=-1)


def swiglu(x, w_in, w_out):
    gate, up = jnp.split(x @ w_in, 2, axis=-1)
    return (jax.nn.silu(gate) * up) @ w_out


def banded_attention(q, k, v, half_window, sink=None):
    n, L, hkv, g, dh = q.shape
    blk = half_window
    nb = -(-L // blk)
    lp = nb * blk
    padq = lp - L
    qp = jnp.pad(q, ((0, 0), (0, padq), (0, 0), (0, 0), (0, 0)))
    kp = jnp.pad(k, ((0, 0), (blk, padq + blk), (0, 0), (0, 0)))
    vp = jnp.pad(v, ((0, 0), (blk, padq + blk), (0, 0), (0, 0)))
    qb = qp.reshape(n, nb, blk, hkv, g, dh)
    kb = kp.reshape(n, nb + 2, blk, hkv, dh)
    vb = vp.reshape(n, nb + 2, blk, hkv, dh)
    kw = jnp.concatenate([kb[:, :-2], kb[:, 1:-1], kb[:, 2:]], axis=2)
    vw = jnp.concatenate([vb[:, :-2], vb[:, 1:-1], vb[:, 2:]], axis=2)
    s = jnp.einsum('nbqhgd,nbkhd->nbhgqk', qb, kw, preferred_element_type=jnp.float32) * (dh ** -0.5)
    qpos = jnp.arange(nb)[:, None, None] * blk + jnp.arange(blk)[None, :, None]
    kpos = jnp.arange(nb)[:, None, None] * blk - blk + jnp.arange(3 * blk)[None, None, :]
    valid = (jnp.abs(qpos - kpos) <= half_window) & (kpos >= 0) & (kpos < L)
    s = jnp.where(valid[None, :, None, None], s, MASK_VALUE)
    lse = jax.nn.logsumexp(s, axis=-1)
    if sink is not None:
        lse = jnp.logaddexp(lse, sink.astype(jnp.float32)[None, None, :, :, None])
    p = jnp.exp(s - lse[..., None])
    out = jnp.einsum('nbhgqk,nbkhd->nbqhgd', p.astype(v.dtype), vw)
    out = out.reshape(n, lp, hkv, g, dh)[:, :L]
    lse = lse.transpose(0, 1, 4, 2, 3).reshape(n, lp, hkv, g)[:, :L]
    return out, lse


def mixer_a(q, k, v, sink, ang):
    b, s = q.shape[:2]
    q = apply_rope(q, ang)
    k = apply_rope(k, ang)
    q5 = q.reshape(b, s, A_KV_HEADS, A_Q_HEADS // A_KV_HEADS, HEAD_DIM)
    out, _ = banded_attention(q5, k, v, A_HALF_WINDOW, sink)
    return out.reshape(b, s, A_Q)


def mixer_b(q, k, v, ang):
    b, s = q.shape[:2]
    q = apply_rope(q, ang)
    k = apply_rope(k, ang)
    hpg = B_HEADS_PER_GROUP
    outs, lses = [], []
    for gi, (window, dil) in enumerate(B_GROUPS):
        sl = slice(gi * hpg, (gi + 1) * hpg)

        def to_residue(t):
            t = t[:, :, sl].reshape(b, s // dil, dil, hpg, HEAD_DIM).transpose(0, 2, 1, 3, 4)
            return t.reshape(b * dil, s // dil, hpg, HEAD_DIM)

        o, l = banded_attention(to_residue(q)[:, :, :, None], to_residue(k), to_residue(v), window // (2 * dil))
        o = o.reshape(b, dil, s // dil, hpg, HEAD_DIM).transpose(0, 2, 1, 3, 4).reshape(b, s, hpg, HEAD_DIM)
        l = l.reshape(b, dil, s // dil, hpg).transpose(0, 2, 1, 3).reshape(b, s, hpg)
        outs.append(o)
        lses.append(l)
    lse = jnp.stack(lses, axis=2)
    wts = jax.nn.softmax(lse, axis=2)
    o = jnp.stack(outs, axis=2) * wts[..., None].astype(q.dtype)
    return o.reshape(b, s, B_W)


def mixer_c(q, k, v, gq, gk, ang_row, ang_col):
    b, s = q.shape[:2]
    q = apply_axial_rope(rms_norm(q, gq), ang_row, ang_col)
    k = apply_axial_rope(rms_norm(k, gk), ang_row, ang_col)
    nb = s // C_BLOCK
    grp = C_Q_HEADS // C_KV_HEADS
    qblocks = q.reshape(b, nb, C_BLOCK, C_KV_HEADS, grp, HEAD_DIM).transpose(1, 0, 2, 3, 4, 5)
    scale = HEAD_DIM ** -0.5

    def attend(qblk):
        sc = jnp.einsum('bqhgd,bkhd->bhgqk', qblk, k, preferred_element_type=jnp.float32) * scale
        p = jax.nn.softmax(sc, axis=-1)
        return jnp.einsum('bhgqk,bkhd->bqhgd', p.astype(v.dtype), v)

    out = lax.map(attend, qblocks)
    return out.transpose(1, 0, 2, 3, 4, 5).reshape(b, s, C_Q)


def encoder_layer(x, g_ffn1, w_ffn1_in, w_ffn1_out, g_mix, w_in, a_sink, c_q_norm, c_k_norm,
                  w_branch, w_gate, b_gate, w_o, g_ffn2, w_ffn2_in, w_ffn2_out, ang, ang_row, ang_col):
    b, s, _ = x.shape
    h = x + 0.5 * swiglu(rms_norm(x, g_ffn1), w_ffn1_in, w_ffn1_out)
    u = rms_norm(h, g_mix)
    proj = u @ w_in
    o = 0
    def take(width, heads):
        return proj[..., o:o + width].reshape(b, s, heads, HEAD_DIM)
    qa = take(A_Q, A_Q_HEADS); o += A_Q
    ka = take(A_KV, A_KV_HEADS); o += A_KV
    va = take(A_KV, A_KV_HEADS); o += A_KV
    qb = take(B_W, B_HEADS); o += B_W
    kb = take(B_W, B_HEADS); o += B_W
    vb = take(B_W, B_HEADS); o += B_W
    qc = take(C_Q, C_Q_HEADS); o += C_Q
    kc = take(C_KV, C_KV_HEADS); o += C_KV
    vc = take(C_KV, C_KV_HEADS)
    ya = mixer_a(qa, ka, va, a_sink, ang)
    yb = mixer_b(qb, kb, vb, ang)
    yc = mixer_c(qc, kc, vc, c_q_norm, c_k_norm, ang_row, ang_col)
    br_a = ya @ w_branch[:A_Q]
    br_b = yb @ w_branch[A_Q:A_Q + B_W]
    br_c = yc @ w_branch[A_Q + B_W:]
    gates = jax.nn.sigmoid(u @ w_gate + b_gate).reshape(b, s, N_BRANCH, D_MODEL)
    merged = gates[:, :, 0] * br_a + gates[:, :, 1] * br_b + gates[:, :, 2] * br_c
    h = h + merged @ w_o
    return h + 0.5 * swiglu(rms_norm(h, g_ffn2), w_ffn2_in, w_ffn2_out)


def run_trunk(x, g_ffn1, w_ffn1_in, w_ffn1_out, g_mix, w_in, a_sink, c_q_norm, c_k_norm,
              w_branch, w_gate, b_gate, w_o, g_ffn2, w_ffn2_in, w_ffn2_out, g_final):
    s = x.shape[1]
    pos = jnp.arange(s)
    ang = rope_angles(pos, HEAD_DIM)
    rows = s // GRID_W
    row_id = jnp.repeat(jnp.arange(rows), GRID_W)
    col_id = jnp.tile(jnp.arange(GRID_W), rows)
    ang_row = rope_angles(row_id, HEAD_DIM // 2)
    ang_col = rope_angles(col_id, HEAD_DIM // 2)
    for l in range(DEPTH):
        x = encoder_layer(x, g_ffn1[l], w_ffn1_in[l], w_ffn1_out[l], g_mix[l], w_in[l], a_sink[l],
                          c_q_norm[l], c_k_norm[l], w_branch[l], w_gate[l], b_gate[l], w_o[l],
                          g_ffn2[l], w_ffn2_in[l], w_ffn2_out[l], ang, ang_row, ang_col)
    return rms_norm(x, g_final)


def setup_inputs(seed: int = 0) -> dict:
    key = jax.random.key(seed)
    ks = jax.random.split(key, 24)
    f32 = jnp.float32

    def nrm(k, shape, fan):
        return jax.random.normal(k, shape, f32) * (fan ** -0.5)

    def gain(k, shape):
        return 1.0 + 0.02 * jax.random.normal(k, shape, f32)

    w_branch = jnp.concatenate([
        nrm(ks[10], (DEPTH, A_Q, D_MODEL), A_Q),
        nrm(ks[11], (DEPTH, B_W, D_MODEL), B_W),
        nrm(ks[12], (DEPTH, C_Q, D_MODEL), C_Q)], axis=1)
    return {
        "x_prompt": jax.random.normal(ks[0], (BATCH, SEQ, D_MODEL), f32),
        "x_sample": jax.random.normal(ks[1], (DEC_BATCH, DEC_SEQ, D_MODEL), f32),
        "g_ffn1": gain(ks[2], (DEPTH, D_MODEL)),
        "w_ffn1_in": nrm(ks[3], (DEPTH, D_MODEL, 2 * D_FF), D_MODEL),
        "w_ffn1_out": nrm(ks[4], (DEPTH, D_FF, D_MODEL), D_FF),
        "g_mix": gain(ks[5], (DEPTH, D_MODEL)),
        "w_in": nrm(ks[6], (DEPTH, D_MODEL, IN_WIDTH), D_MODEL),
        "a_sink": 0.1 * jax.random.normal(ks[7], (DEPTH, A_KV_HEADS, A_Q_HEADS // A_KV_HEADS), f32),
        "c_q_norm": gain(ks[8], (DEPTH, HEAD_DIM)),
        "c_k_norm": gain(ks[9], (DEPTH, HEAD_DIM)),
        "w_branch": w_branch,
        "w_gate": nrm(ks[13], (DEPTH, D_MODEL, N_BRANCH * D_MODEL), D_MODEL),
        "b_gate": 0.1 * jax.random.normal(ks[14], (DEPTH, N_BRANCH * D_MODEL), f32),
        "w_o": nrm(ks[15], (DEPTH, D_MODEL, D_MODEL), D_MODEL),
        "g_ffn2": gain(ks[16], (DEPTH, D_MODEL)),
        "w_ffn2_in": nrm(ks[17], (DEPTH, D_MODEL, 2 * D_FF), D_MODEL),
        "w_ffn2_out": nrm(ks[18], (DEPTH, D_FF, D_MODEL), D_FF),
        "g_final": gain(ks[19], (D_MODEL,)),
    }


def reference(x_prompt, x_sample, g_ffn1, w_ffn1_in, w_ffn1_out, g_mix, w_in, a_sink, c_q_norm, c_k_norm,
              w_branch, w_gate, b_gate, w_o, g_ffn2, w_ffn2_in, w_ffn2_out, g_final):
    y_prompt = run_trunk(x_prompt, g_ffn1, w_ffn1_in, w_ffn1_out, g_mix, w_in, a_sink, c_q_norm, c_k_norm,
                         w_branch, w_gate, b_gate, w_o, g_ffn2, w_ffn2_in, w_ffn2_out, g_final)
    y_sample = run_trunk(x_sample, g_ffn1, w_ffn1_in, w_ffn1_out, g_mix, w_in, a_sink, c_q_norm, c_k_norm,
                         w_branch, w_gate, b_gate, w_o, g_ffn2, w_ffn2_in, w_ffn2_out, g_final)
    return (y_prompt, y_sample)
```

```cpp
#include <hip/hip_runtime.h>
#include <cstdio>
#include <cstdint>

#define LAS __attribute__((address_space(3)))
#define GAS __attribute__((address_space(1)))
typedef unsigned short bf16_t;
typedef short bf16x8 __attribute__((ext_vector_type(8)));
typedef short s16x4 __attribute__((ext_vector_type(4)));
typedef float f32x2 __attribute__((ext_vector_type(2)));
typedef float f32x4 __attribute__((ext_vector_type(4)));
typedef float f32x16 __attribute__((ext_vector_type(16)));
typedef unsigned u32x2 __attribute__((ext_vector_type(2)));
typedef unsigned u32x4 __attribute__((ext_vector_type(4)));

constexpr int DM = 2048, DFF = 5632, DEPTH = 4, NSTEP = 2 * DEPTH;
constexpr int S_P = 16384, S_S = 8192;
constexpr int M = 49152;
constexpr int INW = 4608, GATEW = 6144, PGW = INW + GATEW, NFF2 = 2 * DFF;
constexpr int COL_QA = 0, COL_KA = 512, COL_VA = 768, COL_QB = 1024, COL_KB = 1792, COL_VB = 2560, COL_QC = 3328, COL_KC = 4096, COL_VC = 4352;
constexpr int YCOL_A = 0, YCOL_B = 512, YCOL_C = 1280;
constexpr float NORM_EPS = 1e-6f;

__device__ __forceinline__ unsigned cvt_pk_bf16(float lo, float hi) { unsigned r; asm volatile("v_cvt_pk_bf16_f32 %0, %1, %2" : "=v"(r) : "v"(lo), "v"(hi)); return r; }
__device__ __forceinline__ float bf_lo(unsigned w) { return __uint_as_float(w << 16); }
__device__ __forceinline__ float bf_hi(unsigned w) { return __uint_as_float(w & 0xffff0000u); }
__device__ __forceinline__ unsigned f2bf(float f) { unsigned u = __float_as_uint(f); return (u + 0x7fffu + ((u >> 16) & 1u)) >> 16; }
__device__ __forceinline__ unsigned pk2(float lo, float hi) { return f2bf(lo) | (f2bf(hi) << 16); }

namespace pg8 {
constexpr int BM = 256, BK = 64, HALF = 128, HTB = HALF * BK * 2, STAGE_BYTES = 8 * HTB, NXCD = 8, WGM = 8;
__host__ __device__ __forceinline__ int lds_byte(int r, int c) { const int st = (r >> 4) * 2 + (c >> 5), rr = r & 15, cc = c & 31, ob = rr * 64 + cc * 2; return st * 1024 + (ob ^ (((ob >> 9) & 1) << 5)); }
__host__ __device__ __forceinline__ void stage_rc(int b, int& R, int& C) { const int st = b / 1024, sb = b % 1024, swz = sb ^ (((sb >> 9) & 1) << 5); R = (st >> 1) * 16 + swz / 64; C = (st & 1) * 32 + (swz % 64) / 2; }
__host__ __device__ __forceinline__ int perm32(int rho) { const int n = rho >> 4, i = rho & 15; return 8 * (i >> 2) + 4 * n + (i & 3); }

struct Unit { int pm, pn, k0, nt, seg; };
struct StaticOrder {
    int nM, nN, nwg, G, c;
    __device__ void init(int M_, int N_, int G_, int c_) { nM = M_ / BM; nN = N_ / BM; nwg = nM * nN; G = G_; c = c_; }
    __device__ bool next(int i, int& pm, int& pn) const {
        const long L = (long)i * G + c; if (L >= nwg) return false;
        int wgid = (int)L; { const int q = nwg / NXCD, r = nwg % NXCD, xcd = wgid % NXCD, off = wgid / NXCD; wgid = (xcd < r ? xcd * (q + 1) : r * (q + 1) + (xcd - r) * q) + off; }
        const int nig = WGM * nN, gid = wgid / nig, fm = gid * WGM, gsz = (nM - fm) < WGM ? (nM - fm) : WGM;
        pm = fm + ((wgid % nig) % gsz); pn = (wgid % nig) / gsz; return true;
    }
};
struct PlainSched { StaticOrder so; int nt;
    __device__ __forceinline__ bool next(int i, Unit& u) const { u.k0 = 0; u.nt = nt; u.seg = 0; return so.next(i, u.pm, u.pn); } };
struct ChainSched { StaticOrder so;
    __device__ __forceinline__ bool next(int i, Unit& u) const { const int t = i / 3, sg = i - 3 * t; u.seg = sg; u.k0 = sg == 0 ? 0 : (sg == 1 ? 512 : 1280); u.nt = sg == 0 ? 8 : 12; return so.next(t, u.pm, u.pn); } };

typedef f32x4 Acc[2][2][4][2];

struct EpiSwiglu { static constexpr bool PERM = true, CHAIN = false; bf16_t* O;
    __device__ __forceinline__ void operator()(Acc& acc, const Unit& u, int wr, int wc, int fr, int fq) const {
        const int row0 = u.pm * BM + wr * 64 + fr, col0 = u.pn * HALF + wc * 32 + 8 * fq;
#pragma unroll
        for (int ai = 0; ai < 2; ++ai)
#pragma unroll
            for (int m = 0; m < 4; ++m) { bf16_t* rowp = O + (size_t)(row0 + ai * HALF + m * 16) * DFF + col0; float v[8];
#pragma unroll
                for (int n = 0; n < 2; ++n)
#pragma unroll
                    for (int j = 0; j < 4; ++j) { const float g = acc[ai][0][m][n][j], up = acc[ai][1][m][n][j];
                        const float e = __builtin_amdgcn_exp2f(g * -1.4426950408889634f); v[4 * n + j] = g * up * __builtin_amdgcn_rcpf(1.0f + e); }
                u32x4 w; w.x = cvt_pk_bf16(v[0], v[1]); w.y = cvt_pk_bf16(v[2], v[3]); w.z = cvt_pk_bf16(v[4], v[5]); w.w = cvt_pk_bf16(v[6], v[7]);
                *(u32x4*)rowp = w; }
    }
};
struct EpiResid { static constexpr bool PERM = false, CHAIN = false; const float* r0; const float* r1; int split; float* out; float alpha;
    __device__ __forceinline__ void operator()(Acc& acc, const Unit& u, int wr, int wc, int fr, int fq) const {
        const int rowt = u.pm * BM; const float* rb = rowt < split ? r0 + (size_t)rowt * DM : r1 + (size_t)(rowt - split) * DM;
        const int rloc = wr * 64 + fr, col0 = u.pn * BM + wc * 32 + 4 * fq; float* ob = out + (size_t)rowt * DM;
#pragma unroll
        for (int ai = 0; ai < 2; ++ai)
#pragma unroll
            for (int m = 0; m < 4; ++m) { const size_t off = (size_t)(rloc + ai * HALF + m * 16) * DM + col0;
#pragma unroll
                for (int bj = 0; bj < 2; ++bj)
#pragma unroll
                    for (int n = 0; n < 2; ++n) { const f32x4 r = *(const f32x4*)(rb + off + bj * HALF + n * 16); *(f32x4*)(ob + off + bj * HALF + n * 16) = r + acc[ai][bj][m][n] * alpha; }
                asm volatile("" ::: "memory"); }
    }
};
struct EpiProjGate { static constexpr bool PERM = true, CHAIN = false; bf16_t* proj; bf16_t* gates; const float* bias;
    __device__ __forceinline__ void operator()(Acc& acc, const Unit& u, int wr, int wc, int fr, int fq) const {
        const int row0 = u.pm * BM + wr * 64 + fr; const bool isg = u.pn >= INW / BM;
        const int col0 = (isg ? (u.pn - INW / BM) * BM : u.pn * BM) + wc * 32 + 8 * fq;
        bf16_t* base = isg ? gates : proj; const int ldc = isg ? GATEW : INW;
        f32x4 bv[2][2];
#pragma unroll
        for (int bj = 0; bj < 2; ++bj)
#pragma unroll
            for (int n = 0; n < 2; ++n) bv[bj][n] = isg ? *(const f32x4*)(bias + col0 + bj * HALF + 4 * n) : (f32x4){0.f, 0.f, 0.f, 0.f};
#pragma unroll
        for (int ai = 0; ai < 2; ++ai)
#pragma unroll
            for (int m = 0; m < 4; ++m) { bf16_t* rowp = base + (size_t)(row0 + ai * HALF + m * 16) * ldc + col0;
#pragma unroll
                for (int bj = 0; bj < 2; ++bj) { f32x4 v0 = acc[ai][bj][m][0] + bv[bj][0], v1 = acc[ai][bj][m][1] + bv[bj][1];
                    if (isg) {
#pragma unroll
                        for (int j = 0; j < 4; ++j) { v0[j] = __builtin_amdgcn_rcpf(1.0f + __builtin_amdgcn_exp2f(v0[j] * -1.4426950408889634f)); v1[j] = __builtin_amdgcn_rcpf(1.0f + __builtin_amdgcn_exp2f(v1[j] * -1.4426950408889634f)); } }
                    u32x4 w; w.x = cvt_pk_bf16(v0[0], v0[1]); w.y = cvt_pk_bf16(v0[2], v0[3]); w.z = cvt_pk_bf16(v1[0], v1[1]); w.w = cvt_pk_bf16(v1[2], v1[3]);
                    *(u32x4*)(rowp + bj * HALF) = w; } }
    }
};
struct EpiBranch { static constexpr bool PERM = true, CHAIN = true; const bf16_t* gates; bf16_t* O;
    __device__ __forceinline__ void operator()(Acc& acc, const Unit& u, int wr, int wc, int fr, int fq) const {
        const int row0 = u.pm * BM + wr * 64 + fr, col0 = u.pn * BM + wc * 32 + 8 * fq; const int seg = u.seg;
        const int no = seg == 0 ? 0 : (seg == 1 ? DM : 2 * DM), dofs = seg == 2 ? 2 * DM : no + DM;
#pragma unroll
        for (int ai = 0; ai < 2; ++ai)
#pragma unroll
            for (int m = 0; m < 4; ++m) { const size_t row = (size_t)(row0 + ai * HALF + m * 16);
#pragma unroll
                for (int bj = 0; bj < 2; ++bj) { const bf16_t* gp = gates + row * GATEW + col0 + bj * HALF;
                    const u32x4 gn = *(const u32x4*)(gp + no); float s[8];
                    s[0] = bf_lo(gn.x); s[1] = bf_hi(gn.x); s[2] = bf_lo(gn.y); s[3] = bf_hi(gn.y); s[4] = bf_lo(gn.z); s[5] = bf_hi(gn.z); s[6] = bf_lo(gn.w); s[7] = bf_hi(gn.w);
                    if (seg != 2) { const u32x4 gd = *(const u32x4*)(gp + dofs); float d[8];
                        d[0] = bf_lo(gd.x); d[1] = bf_hi(gd.x); d[2] = bf_lo(gd.y); d[3] = bf_hi(gd.y); d[4] = bf_lo(gd.z); d[5] = bf_hi(gd.z); d[6] = bf_lo(gd.w); d[7] = bf_hi(gd.w);
#pragma unroll
                        for (int j = 0; j < 8; ++j) s[j] = s[j] * __builtin_amdgcn_rcpf(fmaxf(d[j], 1e-30f));
                    }
#pragma unroll
                    for (int j = 0; j < 4; ++j) { acc[ai][bj][m][0][j] *= s[j]; acc[ai][bj][m][1][j] *= s[4 + j]; }
                    if (seg == 2) { const f32x4 v0 = acc[ai][bj][m][0], v1 = acc[ai][bj][m][1];
                        u32x4 w; w.x = cvt_pk_bf16(v0[0], v0[1]); w.y = cvt_pk_bf16(v0[2], v0[3]); w.z = cvt_pk_bf16(v1[0], v1[1]); w.w = cvt_pk_bf16(v1[2], v1[3]);
                        *(u32x4*)(O + row * DM + col0 + bj * HALF) = w; } }
                asm volatile("" ::: "memory"); }
    }
};

template <class Epi, class Sched>
__device__ __forceinline__ void gemm_phase(LAS unsigned char* lds, const bf16_t* Ag, const bf16_t* Btg, const int Kp, const Sched& S, const Epi& E) {
    int tid = threadIdx.x; asm volatile("" : "+v"(tid));
    const int wid = __builtin_amdgcn_readfirstlane(tid >> 6), lane = tid & 63, wr = wid >> 2, wc = wid & 3, fr = lane & 15, fq = lane >> 4;
    unsigned voffA[2], voffB[2];
#pragma unroll
    for (int i = 0; i < 2; ++i) { int R, C; stage_rc(tid * 16 + i * 8192, R, C); const int Rb = Epi::PERM ? ((R & ~31) + perm32(R & 31)) : R;
        voffA[i] = (unsigned)(R * Kp + C) * 2u; voffB[i] = (unsigned)(Rb * Kp + C) * 2u; }
    const size_t kstep = (size_t)(BK * 2);
    const size_t hstep = (size_t)HALF * Kp * 2;
    const size_t tstep = 2 * hstep;
    const unsigned ldsw = (unsigned)wid * 1024u;
    const int aoff = lds_byte(wr * 64 + fr, fq * 8), boff = lds_byte(wc * 32 + fr, fq * 8);
#define PG8_SA(b, h) (((b) * 2 + (h)) * HTB)
#define PG8_SB(b, h) ((4 + (b) * 2 + (h)) * HTB)
#define PG8_STAGE(bufoff, gbase, voff) do { _Pragma("unroll") for (int _i = 0; _i < 2; ++_i) \
        __builtin_amdgcn_global_load_lds((const unsigned*)((const char*)(gbase) + (voff)[_i]), (LAS unsigned*)(lds + (bufoff) + ldsw + _i * 8192), 16, 0, 0); } while (0)
#define PG8_LDA(dst, b, h) do { _Pragma("unroll") for (int m = 0; m < 4; ++m) _Pragma("unroll") for (int k = 0; k < 2; ++k) dst[m][k] = *(const LAS bf16x8*)(lds + PG8_SA(b, h) + aoff + m * 2048 + k * 1024); } while (0)
#define PG8_LDB(dst, b, h) do { _Pragma("unroll") for (int n = 0; n < 2; ++n) _Pragma("unroll") for (int k = 0; k < 2; ++k) dst[n][k] = *(const LAS bf16x8*)(lds + PG8_SB(b, h) + boff + n * 2048 + k * 1024); } while (0)
#define PG8_MMA(ai, bj, At, Bt) do { __builtin_amdgcn_s_setprio(1); _Pragma("unroll") for (int m = 0; m < 4; ++m) _Pragma("unroll") for (int n = 0; n < 2; ++n) _Pragma("unroll") for (int k = 0; k < 2; ++k) \
        acc[ai][bj][m][n] = __builtin_amdgcn_mfma_f32_16x16x32_bf16(Bt[n][k], At[m][k], acc[ai][bj][m][n], 0, 0, 0); __builtin_amdgcn_s_setprio(0); } while (0)
#define PG8_WAIT_V(n) asm volatile("s_waitcnt vmcnt(" #n ")" ::: "memory")
#define PG8_WAIT_L(n) asm volatile("s_waitcnt lgkmcnt(" #n ")" ::: "memory")
#define PG8_BAR __builtin_amdgcn_s_barrier()
#define PG8_SCHED __builtin_amdgcn_sched_barrier(0)
    Unit cur, nxt; int ui = 0;
    if (!S.next(0, cur)) return;
    Acc acc;
#pragma unroll
    for (int a = 0; a < 2; ++a)
#pragma unroll
        for (int b = 0; b < 2; ++b)
#pragma unroll
            for (int m = 0; m < 4; ++m)
#pragma unroll
                for (int n = 0; n < 2; ++n) acc[a][b][m][n] = (f32x4){0.f, 0.f, 0.f, 0.f};
    bf16x8 At[4][2], B0[2][2], B1[2][2];
    const char* cA = (const char*)Ag + (size_t)cur.pm * tstep + (size_t)cur.k0 * 2; const char* cB = (const char*)Btg + (size_t)cur.pn * tstep + (size_t)cur.k0 * 2;
    PG8_STAGE(PG8_SB(0, 0), cB, voffB); PG8_STAGE(PG8_SB(0, 1), cB + hstep, voffB); PG8_STAGE(PG8_SA(0, 0), cA, voffA); PG8_STAGE(PG8_SA(0, 1), cA + hstep, voffA);
    if (wr == 1) PG8_BAR;
    PG8_WAIT_V(2); PG8_BAR;
    PG8_STAGE(PG8_SB(1, 0), cB + kstep, voffB); PG8_STAGE(PG8_SA(1, 0), cA + kstep, voffA); PG8_STAGE(PG8_SB(1, 1), cB + hstep + kstep, voffB);
    PG8_WAIT_V(6); PG8_BAR;
    for (;;) {
        const bool has_next = S.next(ui + 1, nxt);
        const char* nA = has_next ? (const char*)Ag + (size_t)nxt.pm * tstep + (size_t)nxt.k0 * 2 : cA; const char* nB = has_next ? (const char*)Btg + (size_t)nxt.pn * tstep + (size_t)nxt.k0 * 2 : cB;
        const int nt = cur.nt;
        for (int t = 0; t < nt; t += 2) {
            const bool last = (t == nt - 2);
            const char* a1 = cA + (size_t)(t + 1) * kstep;
            const char* a2 = last ? nA : cA + (size_t)(t + 2) * kstep; const char* b2 = last ? nB : cB + (size_t)(t + 2) * kstep;
            const char* a3 = a2 + kstep; const char* b3 = b2 + kstep;
            PG8_LDB(B0, 0, 0); PG8_LDB(B1, 0, 1); PG8_SCHED; PG8_LDA(At, 0, 0); PG8_STAGE(PG8_SA(1, 1), a1 + hstep, voffA);
            PG8_WAIT_V(8); PG8_WAIT_L(0); PG8_BAR; PG8_MMA(0, 0, At, B0); PG8_MMA(0, 1, At, B1); PG8_BAR; PG8_SCHED;
            PG8_LDA(At, 0, 1); PG8_STAGE(PG8_SB(0, 0), b2, voffB); PG8_STAGE(PG8_SB(0, 1), b2 + hstep, voffB); PG8_STAGE(PG8_SA(0, 0), a2, voffA);
            PG8_WAIT_V(8); PG8_WAIT_L(0); PG8_BAR; PG8_MMA(1, 0, At, B0); PG8_MMA(1, 1, At, B1); PG8_BAR; PG8_SCHED;
            PG8_LDB(B0, 1, 0); PG8_LDB(B1, 1, 1); PG8_SCHED; PG8_LDA(At, 1, 0); PG8_STAGE(PG8_SA(0, 1), a2 + hstep, voffA);
            PG8_WAIT_V(8); PG8_WAIT_L(0); PG8_BAR; PG8_MMA(0, 0, At, B0); PG8_MMA(0, 1, At, B1); PG8_BAR; PG8_SCHED;
            PG8_LDA(At, 1, 1); PG8_STAGE(PG8_SB(1, 0), b3, voffB); PG8_STAGE(PG8_SB(1, 1), b3 + hstep, voffB); PG8_STAGE(PG8_SA(1, 0), a3, voffA);
            PG8_WAIT_V(8); PG8_WAIT_L(0); PG8_BAR; PG8_MMA(1, 0, At, B0); PG8_MMA(1, 1, At, B1); PG8_BAR; PG8_SCHED;
        }
        if (wr == 0) PG8_BAR;
        E(acc, cur, wr, wc, fr, fq);
        if (!has_next) break;
        if (!Epi::CHAIN || cur.seg == 2) {
#pragma unroll
            for (int a = 0; a < 2; ++a)
#pragma unroll
                for (int b = 0; b < 2; ++b)
#pragma unroll
                    for (int m = 0; m < 4; ++m)
#pragma unroll
                        for (int n = 0; n < 2; ++n) acc[a][b][m][n] = (f32x4){0.f, 0.f, 0.f, 0.f};
        }
        cur = nxt; cA = nA; cB = nB; ++ui;
        if (wr == 1) PG8_BAR;
    }
    PG8_WAIT_V(0);
    PG8_BAR;
#undef PG8_SA
#undef PG8_SB
#undef PG8_STAGE
#undef PG8_LDA
#undef PG8_LDB
#undef PG8_MMA
#undef PG8_WAIT_V
#undef PG8_WAIT_L
#undef PG8_BAR
#undef PG8_SCHED
}
}

namespace att {
constexpr int D = 128, NW = 8, QBLK = 32, KVBLK = 64;
constexpr float SCALE = 0.088388347648318440f;
constexpr float THR = 8.f;
constexpr size_t SHM_V = KVBLK * D * 2, SHM_K = KVBLK * D * 2, SHM_ATTN = 2 * SHM_V + 2 * SHM_K + NW * 64 * 4;
#define KSWZ(row, colB) ((row) * 256 + ((colB) ^ (((row) & 7) << 4)))
#define SBAR() __builtin_amdgcn_sched_barrier(0)
__device__ __forceinline__ int crow(int r, int hi) { return (r & 3) + 8 * (r >> 2) + 4 * hi; }
__device__ __forceinline__ unsigned cvtpk(float lo, float hi) { unsigned r; asm volatile("v_cvt_pk_bf16_f32 %0, %1, %2" : "=v"(r) : "v"(lo), "v"(hi)); return r; }

__device__ __forceinline__ void partialSM(f32x16& p0, f32x16& p1, float& m_reg, float& mn, float& alpha) {
  constexpr float C = SCALE * 1.4426950408889634f;
  float pmax = p0[0];
#pragma unroll
  for (int r = 1; r < 16; ++r) pmax = fmaxf(pmax, p0[r]);
#pragma unroll
  for (int r = 0; r < 16; ++r) pmax = fmaxf(pmax, p1[r]);
  { auto rr = __builtin_amdgcn_permlane32_swap(__float_as_uint(pmax), __float_as_uint(pmax), false, false);
    pmax = fmaxf(__uint_as_float(rr[0]), __uint_as_float(rr[1])); }
  if (__builtin_expect(__all(pmax - m_reg <= THR / SCALE), 1)) { mn = m_reg; alpha = 1.f; }
  else { mn = fmaxf(m_reg, pmax); alpha = __builtin_amdgcn_exp2f((m_reg - mn) * C); m_reg = mn; }
  float mnC = -mn * C;
#pragma unroll
  for (int r = 0; r < 16; ++r) p0[r] = fmaf(p0[r], C, mnC);
#pragma unroll
  for (int r = 0; r < 16; ++r) p1[r] = fmaf(p1[r], C, mnC);
#pragma unroll
  for (int r = 0; r < 16; ++r) p0[r] = __builtin_amdgcn_exp2f(p0[r]);
}
__device__ __forceinline__ void finishSM(f32x16& p0, f32x16& p1, float alpha, float& l_reg, bf16x8& pa0, bf16x8& pa1, bf16x8& pa2, bf16x8& pa3) {
#pragma unroll
  for (int r = 0; r < 16; ++r) p1[r] = __builtin_amdgcn_exp2f(p1[r]);
  float ps = 0;
#pragma unroll
  for (int r = 0; r < 16; ++r) ps += p0[r];
#pragma unroll
  for (int r = 0; r < 16; ++r) ps += p1[r];
  { auto rr = __builtin_amdgcn_permlane32_swap(__float_as_uint(ps), __float_as_uint(ps), false, false);
    ps = __uint_as_float(rr[0]) + __uint_as_float(rr[1]); }
  l_reg = l_reg * alpha + ps;
#define PK4(P, BASE, OUT) do { unsigned a0 = cvtpk(P[BASE + 0], P[BASE + 1]), a1 = cvtpk(P[BASE + 2], P[BASE + 3]);   \
    unsigned b0 = cvtpk(P[BASE + 4], P[BASE + 5]), b1 = cvtpk(P[BASE + 6], P[BASE + 7]);                              \
    auto r0 = __builtin_amdgcn_permlane32_swap(a0, b0, false, false); auto r1 = __builtin_amdgcn_permlane32_swap(a1, b1, false, false); \
    u32x4 w = {r0[0], r1[0], r0[1], r1[1]}; OUT = *reinterpret_cast<bf16x8*>(&w); } while (0)
  PK4(p0, 0, pa0); PK4(p0, 8, pa1); PK4(p1, 0, pa2); PK4(p1, 8, pa3);
#undef PK4
}
__device__ __forceinline__ void qkt(f32x16& p0, f32x16& p1, const char* Ks, const bf16x8* qr, int r32, int hi) {
  p0 = f32x16{}; p1 = f32x16{};
#pragma unroll
  for (int d0 = 0; d0 < 8; ++d0) { int cb = (d0 * 16 + hi * 8) * 2;
    bf16x8 b0 = *reinterpret_cast<const bf16x8*>(Ks + KSWZ(r32, cb));
    bf16x8 b1 = *reinterpret_cast<const bf16x8*>(Ks + KSWZ(32 + r32, cb));
    p0 = __builtin_amdgcn_mfma_f32_32x32x16_bf16(b0, qr[d0], p0, 0, 0, 0);
    p1 = __builtin_amdgcn_mfma_f32_32x32x16_bf16(b1, qr[d0], p1, 0, 0, 0); }
}
__device__ __forceinline__ int v_st(int k, int c) { const int kk = (k & ~0xC) | ((k & 4) << 1) | ((k & 8) >> 1); return ((kk >> 3) * 4 + (c >> 5)) * 512 + ((kk & 7) * 32 + (c & 31)) * 2; }
__device__ __forceinline__ int v_rd_base(int lane) { return ((lane & 3) << 3) | (((lane >> 2) & 3) << 6) | (((lane >> 4) & 1) << 5) | (((lane >> 5) & 1) << 8); }
constexpr int v_rd_off(int d0, int ks, int half) { return d0 * 512 + ks * 4096 + half * 2048; }
template <int OFF> __device__ __forceinline__ s16x4 tr_read(int vb) {
  s16x4 r; asm volatile("ds_read_b64_tr_b16 %0, %1 offset:%2" : "=&v"(r) : "v"(vb), "i"(OFF) : "memory"); return r;
}
template <int D0> __device__ __forceinline__ void pv_one(f32x16& od, int vb, bf16x8 pa0, bf16x8 pa1, bf16x8 pa2, bf16x8 pa3) {
  const s16x4 l0 = tr_read<v_rd_off(D0, 0, 0)>(vb), h0 = tr_read<v_rd_off(D0, 0, 1)>(vb), l1 = tr_read<v_rd_off(D0, 1, 0)>(vb), h1 = tr_read<v_rd_off(D0, 1, 1)>(vb);
  const s16x4 l2 = tr_read<v_rd_off(D0, 2, 0)>(vb), h2 = tr_read<v_rd_off(D0, 2, 1)>(vb), l3 = tr_read<v_rd_off(D0, 3, 0)>(vb), h3 = tr_read<v_rd_off(D0, 3, 1)>(vb);
  asm volatile("s_waitcnt lgkmcnt(0)" ::: "memory"); SBAR();
#define PK(L, H) (bf16x8){L[0], L[1], L[2], L[3], H[0], H[1], H[2], H[3]}
  od = __builtin_amdgcn_mfma_f32_32x32x16_bf16(pa0, PK(l0, h0), od, 0, 0, 0);
  od = __builtin_amdgcn_mfma_f32_32x32x16_bf16(pa1, PK(l1, h1), od, 0, 0, 0);
  od = __builtin_amdgcn_mfma_f32_32x32x16_bf16(pa2, PK(l2, h2), od, 0, 0, 0);
  od = __builtin_amdgcn_mfma_f32_32x32x16_bf16(pa3, PK(l3, h3), od, 0, 0, 0);
#undef PK
}
__device__ __forceinline__ void pv_d0(f32x16* o, int vb, bf16x8 pa0, bf16x8 pa1, bf16x8 pa2, bf16x8 pa3) {
  pv_one<0>(o[0], vb, pa0, pa1, pa2, pa3); pv_one<1>(o[1], vb, pa0, pa1, pa2, pa3); pv_one<2>(o[2], vb, pa0, pa1, pa2, pa3); pv_one<3>(o[3], vb, pa0, pa1, pa2, pa3);
}
__device__ __forceinline__ void bmask(f32x16& p0, f32x16& p1, int dq0, int kj0, int hw, int L) {
  const float ninf = -__builtin_inff();
#pragma unroll
  for (int r = 0; r < 16; ++r) { const int c = (r & 3) + 8 * (r >> 2);
    const bool ok0 = ((unsigned)(dq0 + c + hw) <= (unsigned)(2 * hw)) && ((unsigned)(kj0 + c) < (unsigned)L);
    const bool ok1 = ((unsigned)(dq0 + c + 32 + hw) <= (unsigned)(2 * hw)) && ((unsigned)(kj0 + c + 32) < (unsigned)L);
    p0[r] = ok0 ? p0[r] : ninf; p1[r] = ok1 ? p1[r] : ninf; }
}
struct Band { int i0, L, hw, tlo; float m0, l0; float* lse; long lse_ld; };

template <bool BAND>
__device__ __forceinline__ void attn_body(const bf16_t* __restrict__ Qb, const bf16_t* __restrict__ Kh, const bf16_t* __restrict__ Vh, bf16_t* __restrict__ Ob,
                                          const long ldq, const long ldk, const long ldo, const int NT, const Band bd, char* lds) {
  int tid = threadIdx.x; asm volatile("" : "+v"(tid));
  const int wid = tid >> 6, lane = tid & 63, r32 = lane & 31, hi = lane >> 5;
  char* V_lds = lds; char* K_lds = lds + 2 * SHM_V;
  float* ws = (float*)(lds + 2 * SHM_V + 2 * SHM_K) + wid * 64; float* li_l = ws; float* al_l = ws + 32;
  float m_reg = BAND ? bd.m0 : -1e30f, l_reg = BAND ? bd.l0 : 0.f; f32x16 o[4] = {}; bf16x8 qr[8];
  const bf16_t* Qw = Qb + (long)(wid * QBLK + r32) * ldq + hi * 8;
#pragma unroll
  for (int d0 = 0; d0 < 8; ++d0) qr[d0] = *reinterpret_cast<const bf16x8*>(Qw + d0 * 16);
  const int sr = tid >> 4, sc = (tid & 15) * 8, vst0 = v_st(sr, sc), vst1 = v_st(32 + sr, sc);
  const int vb0 = (int)(uintptr_t)V_lds + v_rd_base(lane);
  const int qi = BAND ? bd.i0 + wid * QBLK + r32 : 0;
  struct { bf16x8 vs0, vs1, ks0, ks1; } sr_[2];
#define KROW(k) (BAND ? (long)min(max((k), 0), bd.L - 1) : (long)(k))
#define SLOAD(i, jt) do { const int k0_ = (BAND ? bd.tlo + (jt) : (jt)) * KVBLK; const long ra_ = KROW(k0_ + sr) * ldk + sc, rb_ = KROW(k0_ + 32 + sr) * ldk + sc; \
    sr_[i].vs0 = *reinterpret_cast<const bf16x8*>(Vh + ra_); sr_[i].vs1 = *reinterpret_cast<const bf16x8*>(Vh + rb_); \
    sr_[i].ks0 = *reinterpret_cast<const bf16x8*>(Kh + ra_); sr_[i].ks1 = *reinterpret_cast<const bf16x8*>(Kh + rb_); } while (0)
#define SWRITE(b, i) do { *(bf16x8*)(V_lds + (b) * SHM_V + vst0) = sr_[i].vs0;          \
    *(bf16x8*)(V_lds + (b) * SHM_V + vst1) = sr_[i].vs1; int kc = sc * 2;               \
    *(bf16x8*)(K_lds + (b) * SHM_K + KSWZ(sr, kc)) = sr_[i].ks0;                       \
    *(bf16x8*)(K_lds + (b) * SHM_K + KSWZ(32 + sr, kc)) = sr_[i].ks1; } while (0)
#define SWAIT() asm volatile("s_waitcnt vmcnt(4)" ::: "memory")
#define RESC(a) do { if (__any((a) < 1.f)) { if (hi == 0) al_l[r32] = (a); asm volatile("s_waitcnt lgkmcnt(0)" ::: "memory"); \
    _Pragma("unroll") for (int d = 0; d < 4; ++d) _Pragma("unroll") for (int r = 0; r < 16; ++r) o[d][r] *= al_l[crow(r, hi)]; } } while (0)
#define BMASK(P0, P1, jt) do { if (BAND) { const int kt_ = (bd.tlo + (jt)) * KVBLK + 4 * hi; bmask(P0, P1, kt_ - qi, kt_, bd.hw, bd.L); } } while (0)
  f32x16 pA0, pA1, pB0, pB1; float mnA, mnB, alA, alB; bf16x8 pa0, pa1, pa2, pa3;
  constexpr int SE = 0, SO = 1;
  SLOAD(SE, 0); asm volatile("s_waitcnt vmcnt(0)" ::: "memory"); SWRITE(0, SE); __syncthreads();
  qkt(pA0, pA1, K_lds, qr, r32, hi); BMASK(pA0, pA1, 0); partialSM(pA0, pA1, m_reg, mnA, alA);
  SLOAD(SO, 1); if (2 < NT) SLOAD(SE, 2);
  SWAIT(); SWRITE(1, SO); __syncthreads();
  for (int j = 1; j + 1 < NT; j += 2) {
    SBAR(); qkt(pB0, pB1, K_lds + SHM_K, qr, r32, hi);
    finishSM(pA0, pA1, alA, l_reg, pa0, pa1, pa2, pa3); SBAR();
    SLOAD(SO, j + 2); SBAR();
    pv_d0(o, vb0, pa0, pa1, pa2, pa3); BMASK(pB0, pB1, j); partialSM(pB0, pB1, m_reg, mnB, alB);
    __syncthreads(); SWAIT(); SWRITE(0, SE);
    RESC(alB); __syncthreads();
    SBAR(); qkt(pA0, pA1, K_lds, qr, r32, hi);
    finishSM(pB0, pB1, alB, l_reg, pa0, pa1, pa2, pa3); SBAR();
    if (j + 3 < NT) SLOAD(SE, j + 3); SBAR();
    pv_d0(o, vb0 + (int)SHM_V, pa0, pa1, pa2, pa3); BMASK(pA0, pA1, j + 1); partialSM(pA0, pA1, m_reg, mnA, alA);
    __syncthreads(); SWAIT(); SWRITE(1, SO);
    RESC(alA); __syncthreads();
  }
  SBAR(); qkt(pB0, pB1, K_lds + SHM_K, qr, r32, hi);
  finishSM(pA0, pA1, alA, l_reg, pa0, pa1, pa2, pa3); SBAR();
  pv_d0(o, vb0, pa0, pa1, pa2, pa3); BMASK(pB0, pB1, NT - 1); partialSM(pB0, pB1, m_reg, mnB, alB);
  __syncthreads(); RESC(alB);
  finishSM(pB0, pB1, alB, l_reg, pa0, pa1, pa2, pa3); SBAR();
  pv_d0(o, vb0 + (int)SHM_V, pa0, pa1, pa2, pa3);
  if (hi == 0) li_l[r32] = l_reg; asm volatile("s_waitcnt lgkmcnt(0)" ::: "memory");
  float rli[16];
#pragma unroll
  for (int r = 0; r < 16; ++r) rli[r] = __builtin_amdgcn_rcpf(li_l[crow(r, hi)]);
  bf16_t* Ow = Ob + (long)(wid * QBLK) * ldo;
  const int odd = lane & 1;
#pragma unroll
  for (int r = 0; r < 16; r += 2) { const long orow = crow(r, hi) + odd;
#pragma unroll
    for (int d0 = 0; d0 < 4; ++d0) { const float a = o[d0][r] * rli[r], b = o[d0][r + 1] * rli[r + 1];
      const float snd = odd ? a : b;
      const float rcv = __int_as_float(__builtin_amdgcn_mov_dpp(__float_as_int(snd), 0xB1, 0xF, 0xF, true));
      const unsigned pk = odd ? cvtpk(rcv, b) : cvtpk(a, rcv);
      *(unsigned*)(Ow + orow * ldo + d0 * 32 + (r32 & ~1)) = pk; } }
  if (BAND) { if (bd.lse != nullptr && hi == 0) bd.lse[(long)(wid * QBLK + r32) * bd.lse_ld] = m_reg * SCALE + __logf(l_reg); }
  __syncthreads();
#undef KROW
#undef SLOAD
#undef SWRITE
#undef SWAIT
#undef RESC
#undef BMASK
}
}

constexpr size_t MiB = 1u << 20;
constexpr size_t WS_CTL = 0, CTL_ZERO_BYTES = 1 * MiB;
constexpr size_t WS_ROPE = 1 * MiB;
constexpr size_t WS_ROPEX = 9 * MiB;
constexpr size_t WS_LSE = 10 * MiB;
constexpr size_t WS_W = 12 * MiB;
constexpr size_t WO_F1IN = 0, WO_F1OUT = WO_F1IN + (size_t)NFF2 * DM * 2, WO_PG = WO_F1OUT + (size_t)DM * DFF * 2, WO_BR = WO_PG + (size_t)PGW * DM * 2,
                 WO_WO = WO_BR + (size_t)DM * DM * 2, WO_F2IN = WO_WO + (size_t)DM * DM * 2, WO_F2OUT = WO_F2IN + (size_t)NFF2 * DM * 2, W_BYTES = WO_F2OUT + (size_t)DM * DFF * 2;
constexpr size_t WS_U = WS_W + ((W_BYTES + MiB - 1) / MiB) * MiB;
constexpr size_t WS_Y = WS_U + (size_t)M * DM * 2;
constexpr size_t WS_BIG = WS_Y + (size_t)M * DM * 2;
constexpr size_t WS_PROJ = WS_BIG, WS_GATES = WS_BIG + (size_t)M * INW * 2;
constexpr size_t WS_END = WS_GATES + (size_t)M * GATEW * 2;
static_assert((size_t)M * DFF * 2 <= WS_END - WS_BIG, "act fits the overlay");
constexpr int CW_BAR = 4096;

constexpr int RING_OFF = 0, RING_BYTES = 131072;
constexpr int LDSCTL_OFF = RING_BYTES, MISC_OFF = LDSCTL_OFF + 320;
constexpr int LDS_BYTES = 147456;
constexpr int NWAVES = 8;

typedef GAS unsigned gu32;
#define RLX_AGENT __ATOMIC_RELAXED, __HIP_MEMORY_SCOPE_AGENT
#define LDS_WAIT() asm volatile("s_waitcnt lgkmcnt(0)" ::: "memory")

#define XB_TMO      128
#define XB_XCNT(j)  (256  + 64 * (j))
#define XB_XSUB(j)  (1280 + 64 * (j))
#define XB_XGEN(j)  (2304 + 64 * (j))
#define XB_TOP      3328
#define XB_TOPGEN   3392
#define XCD_BAR_WORDS 3456
#define XB_SPIN_CAP (1u << 22)
__device__ __forceinline__ unsigned xb_ld(unsigned* p)              { return __hip_atomic_load(p, __ATOMIC_RELAXED, __HIP_MEMORY_SCOPE_AGENT); }
__device__ __forceinline__ unsigned xb_add(unsigned* p, unsigned v) { return __hip_atomic_fetch_add(p, v, __ATOMIC_RELAXED, __HIP_MEMORY_SCOPE_AGENT); }
__device__ __forceinline__ unsigned xb_xcc_id() { return (unsigned)__builtin_amdgcn_s_getreg((3 << 11) | 20) & 0xFu; }
#define XB_SPIN(cond, bar) do { unsigned _sp = 0; while (cond) { __builtin_amdgcn_s_sleep(1); \
    if ((++_sp & 255u) == 0u) { if (xb_ld(&(bar)[XB_TMO])) break; if (_sp > XB_SPIN_CAP) { atomicAdd(&(bar)[XB_TMO], 1u); break; } } } } while (0)
struct XcdBarrier { unsigned* bar; unsigned x; volatile LAS unsigned* st; };
__device__ __forceinline__ XcdBarrier xcd_barrier_post(unsigned* bar, volatile LAS unsigned* st) {
    XcdBarrier b; b.bar = bar; b.x = xb_xcc_id(); b.st = st;
    if (threadIdx.x == 0) (void)xb_add(&bar[XB_XCNT(b.x)], 1u);
    return b;
}
__device__ __forceinline__ void xcd_barrier_complete(unsigned* bar, unsigned x, unsigned& nloc, unsigned& nx) {
    const unsigned G = gridDim.x * gridDim.y * gridDim.z;
    unsigned sum, cnt, mine, sp = 0u;
    for (;;) {
        sum = 0u; cnt = 0u; mine = 0u;
#pragma unroll
        for (unsigned j = 0; j < 16; ++j) { const unsigned c = xb_ld(&bar[XB_XCNT(j)]); sum += c; cnt += (c > 0u) ? 1u : 0u; mine = (j == x) ? c : mine; }
        if (sum == G) break;
        __builtin_amdgcn_s_sleep(1);
        if ((++sp & 255u) == 0u) { if (xb_ld(&bar[XB_TMO])) break; if (sp > XB_SPIN_CAP) { atomicAdd(&bar[XB_TMO], 1u); break; } }
    }
    nloc = mine > 0u ? mine : 1u; nx = cnt > 0u ? cnt : 1u;
}
__device__ __forceinline__ void xcd_barrier(const XcdBarrier& b) {
    asm volatile("s_waitcnt vmcnt(0)" ::: "memory");
    __syncthreads();
    if (threadIdx.x == 0) {
        unsigned* bar = b.bar;
        __builtin_amdgcn_s_waitcnt(0);
        unsigned nloc = b.st[0], nx = b.st[1];
        if (nloc == 0u) { xcd_barrier_complete(bar, b.x, nloc, nx); b.st[0] = nloc; b.st[1] = nx; }
        const unsigned old = xb_add(&bar[XB_XSUB(b.x)], 1u);
        const unsigned gen = old / nloc;
        if (old + 1u == (gen + 1u) * nloc) {
            __builtin_amdgcn_fence(__ATOMIC_RELEASE, "agent");
            asm volatile("s_waitcnt vmcnt(0)" ::: "memory");
            const unsigned og = xb_add(&bar[XB_TOP], 1u);
            const unsigned tg = og / nx;
            if (og + 1u == (tg + 1u) * nx) xb_add(&bar[XB_TOPGEN], 1u);
            else XB_SPIN(xb_ld(&bar[XB_TOPGEN]) == tg, bar);
            __builtin_amdgcn_fence(__ATOMIC_ACQUIRE, "agent");
            xb_add(&bar[XB_XGEN(b.x)], 1u);
            asm volatile("s_waitcnt vmcnt(0)" ::: "memory");
        } else {
            XB_SPIN(xb_ld(&bar[XB_XGEN(b.x)]) == gen, bar);
            __builtin_amdgcn_fence(__ATOMIC_ACQUIRE, "agent");
            asm volatile("s_waitcnt vmcnt(0)" ::: "memory");
        }
    }
    __syncthreads();
}

__device__ __forceinline__ float wave_sum(float v) {
#pragma unroll
    for (int o = 1; o < 64; o <<= 1) v += __shfl_xor(v, o);
    return v;
}
__device__ __forceinline__ void transpose_item(const float* W, int K, int N, bf16_t* WT, int k0, int n0, int drow, LAS float* scr, int lane) {
#pragma unroll 8
    for (int i = 0; i < 32; ++i) { const int kk = 2 * i + (lane >> 5); scr[kk * 33 + (lane & 31)] = W[(size_t)(k0 + kk) * N + n0 + (lane & 31)]; }
    LDS_WAIT(); asm volatile("" ::: "memory");
    const int c = lane & 7;
#pragma unroll
    for (int j = 0; j < 4; ++j) { const int n = (lane >> 3) + 8 * j; const LAS float* s = scr + (8 * c) * 33 + n;
        u32x4 o; o.x = pk2(s[0 * 33], s[1 * 33]); o.y = pk2(s[2 * 33], s[3 * 33]); o.z = pk2(s[4 * 33], s[5 * 33]); o.w = pk2(s[6 * 33], s[7 * 33]);
        *(GAS u32x4*)(WT + (size_t)(drow + n) * K + k0 + 8 * c) = o; }
    LDS_WAIT(); asm volatile("" ::: "memory");
}
__device__ __forceinline__ void sincos_d(double a, float& s, float& c) {
    const double q = rint(a * 0.63661977236758134308);
    double y = fma(-q, 1.5707963267948966192, a); y = fma(-q, 6.123233995736766e-17, y);
    const double y2 = y * y;
    double sp = 1.0 / 6227020800.0; sp = fma(sp, y2, -1.0 / 39916800.0); sp = fma(sp, y2, 1.0 / 362880.0); sp = fma(sp, y2, -1.0 / 5040.0); sp = fma(sp, y2, 1.0 / 120.0); sp = fma(sp, y2, -1.0 / 6.0); sp = fma(sp, y2, 1.0);
    const double sy = y * sp;
    double cp = -1.0 / 87178291200.0; cp = fma(cp, y2, 1.0 / 479001600.0); cp = fma(cp, y2, -1.0 / 3628800.0); cp = fma(cp, y2, 1.0 / 40320.0); cp = fma(cp, y2, -1.0 / 720.0); cp = fma(cp, y2, 1.0 / 24.0); cp = fma(cp, y2, -0.5); cp = fma(cp, y2, 1.0);
    const int k = (int)q & 3;
    const double ss = (k & 1) ? cp : sy, cc = (k & 1) ? sy : cp;
    s = (float)((k & 2) ? -ss : ss); c = (float)(((k + 1) & 2) ? -cc : cc);
}

struct Args { const float* in[18]; float* out; unsigned char* ws; int ph_lo, ph_hi; };
constexpr int PH_PER_STEP = 10, PH_FINAL = NSTEP * PH_PER_STEP, PH_END = PH_FINAL + 1;

__global__ void __launch_bounds__(NWAVES * 64, 2) fwd_kernel(Args args) {
    extern __shared__ __attribute__((aligned(16))) unsigned char lds[];
    LAS unsigned char* ldsl = (LAS unsigned char*)lds;
    volatile LAS unsigned* MISC = (volatile LAS unsigned*)(ldsl + MISC_OFF);
    const int G = gridDim.x; const int bx = blockIdx.x;
    const int vcu = (G % 8 == 0) ? (bx % 8) * (G / 8) + bx / 8 : bx;
    unsigned char* ws = args.ws;
    gu32* ctl = (gu32*)(ws + WS_CTL);
    for (int u = threadIdx.x; u < (LDS_BYTES - LDSCTL_OFF) / 4; u += NWAVES * 64) ((LAS unsigned*)(ldsl + LDSCTL_OFF))[u] = 0u;
    __syncthreads();
    const int lo = args.ph_lo, hi = args.ph_hi;
    const bool one_launch = (hi - lo) > 1;
    XcdBarrier bar; bar.bar = (unsigned*)(ctl + CW_BAR); bar.x = 0; bar.st = nullptr;
    if (one_launch) bar = xcd_barrier_post((unsigned*)(ctl + CW_BAR), MISC + 8);
    bool first = true;
#ifndef PH_MASK
#define PH_MASK 0xFFFF
#endif
#define PHASE_BEGIN(p) if (((PH_MASK >> ((p) == PH_FINAL ? 10 : (p) % PH_PER_STEP)) & 1) && lo <= (p) && (p) < hi) { if (!first) xcd_barrier(bar); first = false;
#define PHASE_END }

    const float* xp = args.in[0]; const float* xs = args.in[1];
    float* out = args.out;
    f32x2* rope = (f32x2*)(ws + WS_ROPE); f32x2* ropex = (f32x2*)(ws + WS_ROPEX);
    float* lseb = (float*)(ws + WS_LSE);
    bf16_t* U = (bf16_t*)(ws + WS_U); bf16_t* Y = (bf16_t*)(ws + WS_Y);
    bf16_t* ACT = (bf16_t*)(ws + WS_BIG); bf16_t* PROJ = (bf16_t*)(ws + WS_PROJ); bf16_t* GATES = (bf16_t*)(ws + WS_GATES);
    bf16_t* Wb = (bf16_t*)(ws + WS_W);
    const int NGW = G * NWAVES;
#define LOCAL_IDS int tid = threadIdx.x; asm volatile("" : "+v"(tid)); const int lane = tid & 63, wave = __builtin_amdgcn_readfirstlane(tid >> 6), gw = vcu * NWAVES + wave; (void)lane; (void)gw;

    if (lo == 0) {
        int tid = threadIdx.x; asm volatile("" : "+v"(tid));
        const int gt = vcu * NWAVES * 64 + tid, NGT = G * NWAVES * 64;
        for (int e = gt; e < S_P * 64 + 256 * 32; e += NGT) {
            const bool ax = e >= S_P * 64; const int ee = ax ? e - S_P * 64 : e; const int pos = ax ? ee >> 5 : ee >> 6, i = ax ? ee & 31 : ee & 63;
            const double base = ax ? 0.7498942093324559 : 0.8659643233600653; double inv = 1.0; double bp = base; int ii = i;
            for (int b = 0; b < 6; ++b) { if (ii & 1) inv *= bp; bp *= bp; ii >>= 1; }
            float sn, cs; sincos_d((double)pos * inv, sn, cs);
            (ax ? ropex : rope)[ee] = (f32x2){cs, sn};
        }
    }
    for (int s = 0; s < NSTEP; ++s) {
        const int l = s >> 1, which = s & 1, pb = s * PH_PER_STEP;
        PHASE_BEGIN(pb + 0)
            LOCAL_IDS
            if (which == 0) {
                LAS float* scr = (LAS float*)(ldsl + RING_OFF + wave * 16384);
                constexpr int I_FIN = (DM / 64) * (NFF2 / 32), I_FOUT = (DFF / 64) * (DM / 32), I_IN = (DM / 64) * (INW / 32), I_GT = (DM / 64) * (GATEW / 32), I_SQ = (DM / 64) * (DM / 32);
                constexpr int NITEMS = 2 * I_FIN + 2 * I_FOUT + I_IN + I_GT + 2 * I_SQ;
                const float* w_f1in = args.in[3] + (size_t)l * DM * NFF2; const float* w_f1out = args.in[4] + (size_t)l * DFF * DM;
                const float* w_in = args.in[6] + (size_t)l * DM * INW; const float* w_br = args.in[10] + (size_t)l * DM * DM;
                const float* w_gt = args.in[11] + (size_t)l * DM * GATEW; const float* w_o = args.in[13] + (size_t)l * DM * DM;
                const float* w_f2in = args.in[15] + (size_t)l * DM * NFF2; const float* w_f2out = args.in[16] + (size_t)l * DFF * DM;
                for (int it = gw; it < NITEMS; it += NGW) {
                    int r = it;
                    if (r < 2 * I_FIN) { const bool sec = r >= I_FIN; if (sec) r -= I_FIN; const int nblk = NFF2 / 32, kb = r / nblk, nb = r % nblk, n0 = nb * 32;
                        const int half = n0 >= DFF ? 1 : 0, rem = n0 - half * DFF, drow = (rem >> 7) * 256 + half * 128 + (rem & 127);
                        transpose_item(sec ? w_f2in : w_f1in, DM, NFF2, (bf16_t*)((char*)Wb + (sec ? WO_F2IN : WO_F1IN)), kb * 64, n0, drow, scr, lane); continue; }
                    r -= 2 * I_FIN;
                    if (r < 2 * I_FOUT) { const bool sec = r >= I_FOUT; if (sec) r -= I_FOUT; const int nblk = DM / 32, kb = r / nblk, nb = r % nblk;
                        transpose_item(sec ? w_f2out : w_f1out, DFF, DM, (bf16_t*)((char*)Wb + (sec ? WO_F2OUT : WO_F1OUT)), kb * 64, nb * 32, nb * 32, scr, lane); continue; }
                    r -= 2 * I_FOUT;
                    if (r < I_IN) { const int nblk = INW / 32, kb = r / nblk, nb = r % nblk;
                        transpose_item(w_in, DM, INW, (bf16_t*)((char*)Wb + WO_PG), kb * 64, nb * 32, nb * 32, scr, lane); continue; }
                    r -= I_IN;
                    if (r < I_GT) { const int nblk = GATEW / 32, kb = r / nblk, nb = r % nblk;
                        transpose_item(w_gt, DM, GATEW, (bf16_t*)((char*)Wb + WO_PG), kb * 64, nb * 32, INW + nb * 32, scr, lane); continue; }
                    r -= I_GT;
                    { const bool sec = r >= I_SQ; if (sec) r -= I_SQ; const int nblk = DM / 32, kb = r / nblk, nb = r % nblk;
                        transpose_item(sec ? w_o : w_br, DM, DM, (bf16_t*)((char*)Wb + (sec ? WO_WO : WO_BR)), kb * 64, nb * 32, nb * 32, scr, lane); }
                }
            }
            {
                const float* g = (which == 0 ? args.in[2] : args.in[14]) + (size_t)l * DM;
                f32x4 gv[8];
#pragma unroll
                for (int j = 0; j < 8; ++j) gv[j] = ((const f32x4*)g)[lane + 64 * j];
                for (int m = gw; m < M; m += NGW) {
                    const float* xrow = (s == 0) ? (m < S_P ? xp + (size_t)m * DM : xs + (size_t)(m - S_P) * DM) : out + (size_t)m * DM;
                    const GAS f32x4* xr = (const GAS f32x4*)xrow + lane; f32x4 v[8]; float ss = 0.f;
#pragma unroll
                    for (int j = 0; j < 8; ++j) { v[j] = xr[64 * j]; ss += (v[j].x * v[j].x + v[j].y * v[j].y) + (v[j].z * v[j].z + v[j].w * v[j].w); }
                    const float rstd = 1.0f / sqrtf(wave_sum(ss) * (1.0f / DM) + NORM_EPS);
                    GAS u32x2* o8 = (GAS u32x2*)(U + (size_t)m * DM) + lane;
#pragma unroll
                    for (int j = 0; j < 8; ++j) { const f32x4 y = v[j] * rstd * gv[j]; o8[64 * j] = (u32x2){cvt_pk_bf16(y.x, y.y), cvt_pk_bf16(y.z, y.w)}; }
                }
            }
        PHASE_END
        PHASE_BEGIN(pb + 1)
            pg8::PlainSched S; S.so.init(M, NFF2, G, bx); S.nt = DM / 64;
            pg8::EpiSwiglu E{ACT};
            pg8::gemm_phase<pg8::EpiSwiglu, pg8::PlainSched>(ldsl + RING_OFF, U, (const bf16_t*)((char*)Wb + (which ? WO_F2IN : WO_F1IN)), DM, S, E);
        PHASE_END
        PHASE_BEGIN(pb + 2)
            pg8::PlainSched S; S.so.init(M, DM, G, bx); S.nt = DFF / 64;
            pg8::EpiResid E{s == 0 ? xp : out, s == 0 ? xs : out + (size_t)S_P * DM, S_P, out, 0.5f};
            pg8::gemm_phase<pg8::EpiResid, pg8::PlainSched>(ldsl + RING_OFF, ACT, (const bf16_t*)((char*)Wb + (which ? WO_F2OUT : WO_F1OUT)), DFF, S, E);
        PHASE_END
        if (which == 0) {
        PHASE_BEGIN(pb + 3)
            LOCAL_IDS
            const float* g = args.in[5] + (size_t)l * DM;
            f32x4 gv[8];
#pragma unroll
            for (int j = 0; j < 8; ++j) gv[j] = ((const f32x4*)g)[lane + 64 * j];
            for (int m = gw; m < M; m += NGW) {
                const GAS f32x4* xr = (const GAS f32x4*)(out + (size_t)m * DM) + lane; f32x4 v[8]; float ss = 0.f;
#pragma unroll
                for (int j = 0; j < 8; ++j) { v[j] = xr[64 * j]; ss += (v[j].x * v[j].x + v[j].y * v[j].y) + (v[j].z * v[j].z + v[j].w * v[j].w); }
                const float rstd = 1.0f / sqrtf(wave_sum(ss) * (1.0f / DM) + NORM_EPS);
                GAS u32x2* o8 = (GAS u32x2*)(U + (size_t)m * DM) + lane;
#pragma unroll
                for (int j = 0; j < 8; ++j) { const f32x4 y = v[j] * rstd * gv[j]; o8[64 * j] = (u32x2){cvt_pk_bf16(y.x, y.y), cvt_pk_bf16(y.z, y.w)}; }
            }
        PHASE_END
        PHASE_BEGIN(pb + 4)
            pg8::PlainSched S; S.so.init(M, PGW, G, bx); S.nt = DM / 64;
            pg8::EpiProjGate E{PROJ, GATES, args.in[12] + (size_t)l * GATEW};
            pg8::gemm_phase<pg8::EpiProjGate, pg8::PlainSched>(ldsl + RING_OFF, U, (const bf16_t*)((char*)Wb + WO_PG), DM, S, E);
        PHASE_END
        PHASE_BEGIN(pb + 5)
            LOCAL_IDS
            const float* gq = args.in[8] + (size_t)l * 128; const float* gk = args.in[9] + (size_t)l * 128;
            const int e1x = (lane >> 5) * 64 + (lane & 31), e2x = e1x + 32;
            const float gq1 = gq[e1x], gq2 = gq[e2x], gk1 = gk[e1x], gk2 = gk[e2x];
            for (int m = gw; m < M; m += NGW) {
                const int pos = m < S_P ? m : (m & (S_S - 1));
                const f32x2 cs = rope[pos * 64 + lane];
                const int idx = (lane >> 5) ? (pos & 63) : (pos >> 6);
                const f32x2 cx = ropex[idx * 32 + (lane & 31)];
                bf16_t* row = PROJ + (size_t)m * INW;
#pragma unroll 6
                for (int hh = 0; hh < 18; ++hh) {
                    bf16_t* hp = row + (hh < 6 ? hh * 128 : COL_QB + (hh - 6) * 128);
                    const float x1 = __uint_as_float((unsigned)hp[lane] << 16), x2 = __uint_as_float((unsigned)hp[lane + 64] << 16);
                    hp[lane] = (bf16_t)f2bf(x1 * cs.x - x2 * cs.y); hp[lane + 64] = (bf16_t)f2bf(x2 * cs.x + x1 * cs.y);
                }
#pragma unroll 4
                for (int hh = 0; hh < 8; ++hh) {
                    bf16_t* hp = row + COL_QC + hh * 128;
                    const float x1 = __uint_as_float((unsigned)hp[e1x] << 16), x2 = __uint_as_float((unsigned)hp[e2x] << 16);
                    const float rstd = 1.0f / sqrtf(wave_sum(x1 * x1 + x2 * x2) * (1.0f / 128.0f) + NORM_EPS);
                    const float y1 = x1 * rstd * (hh < 6 ? gq1 : gk1), y2 = x2 * rstd * (hh < 6 ? gq2 : gk2);
                    hp[e1x] = (bf16_t)f2bf(y1 * cx.x - y2 * cx.y); hp[e2x] = (bf16_t)f2bf(y2 * cx.x + y1 * cx.y);
                }
            }
        PHASE_END
        PHASE_BEGIN(pb + 6)
            char* alds = (char*)lds + RING_OFF;
            att::Band nob{0, 0, 0, 0, -1e30f, 0.f, nullptr, 0};
            for (int v = vcu; v < 256; v += G) {
                const bool pr = v < 128;
                const int nun = pr ? 3 : 6, x = (v - 128) >> 5, qb = pr ? (v & 63) : (v & 31);
                for (int r6 = 0; r6 < nun; ++r6) {
                    const int pair = x * 2 + r6 / 3, sq = pair >> 1, kvh = pr ? (v >> 6) : (pair & 1), h = kvh * 3 + (r6 % 3);
                    const size_t sb = pr ? 0 : (size_t)S_P + (size_t)sq * S_S, r0 = sb + (size_t)qb * 256;
                    att::attn_body<false>(PROJ + r0 * INW + COL_QC + h * 128, PROJ + sb * INW + COL_KC + kvh * 128, PROJ + sb * INW + COL_VC + kvh * 128, Y + r0 * DM + YCOL_C + h * 128, INW, INW, DM, pr ? S_P / 64 : S_S / 64, nob, alds);
                }
            }
            const float* sink = args.in[7] + (size_t)l * 4;
            for (int u = vcu; u < 768 + 1152; u += G) {
                const bool isA = u < 768; const int ub = u - 768;
                const int hh = isA ? (u & 3) : ub % 6, blk = isA ? (u >> 2) : ub / 6, dil = isA ? 1 : (hh < 2 ? 1 : (hh < 4 ? 4 : 16));
                const int R0 = blk * 256; const int sb = R0 < S_P ? 0 : S_P + ((R0 - S_P) / S_S) * S_S, Ls = R0 < S_P ? S_P : S_S;
                const int bis = (R0 - sb) / 256, L = Ls / dil, nbr = L / 256, res = bis / nbr, i0 = (bis - res * nbr) * 256;
                const size_t t0 = (size_t)sb + res + (size_t)i0 * dil;
                att::Band bd; bd.i0 = i0; bd.L = L; bd.hw = isA ? 128 : 64; bd.tlo = i0 / 64 - (isA ? 2 : 1); bd.m0 = isA ? sink[hh] * (1.0f / att::SCALE) : -1e30f; bd.l0 = isA ? 1.0f : 0.f;
                bd.lse = isA ? nullptr : lseb + t0 * 8 + hh; bd.lse_ld = (long)8 * dil;
                const bf16_t* pb_ = PROJ + ((size_t)sb + res) * INW;
                const int cq = isA ? COL_QA + hh * 128 : COL_QB + hh * 128, ck = isA ? COL_KA + (hh >> 1) * 128 : COL_KB + hh * 128, cv = isA ? COL_VA + (hh >> 1) * 128 : COL_VB + hh * 128;
                att::attn_body<true>(PROJ + t0 * INW + cq, pb_ + ck, pb_ + cv, Y + t0 * DM + (isA ? YCOL_A : YCOL_B) + hh * 128, (long)INW * dil, (long)INW * dil, (long)DM * dil, isA ? 8 : 6, bd, alds);
            }
        PHASE_END
        PHASE_BEGIN(pb + 7)
            LOCAL_IDS
            for (int m = gw; m < M; m += NGW) {
                const float* lp = lseb + (size_t)m * 8;
                const f32x4 l03 = *(const f32x4*)lp; const f32x2 l45 = *(const f32x2*)(lp + 4);
                const int j = lane >> 5;
                const float a = j ? l03.y : l03.x, b = j ? l03.w : l03.z, c = j ? l45.y : l45.x, mx = fmaxf(a, fmaxf(b, c));
                const float ea = __expf(a - mx), eb = __expf(b - mx), ec = __expf(c - mx), inv = 1.0f / (ea + eb + ec);
                const float w0 = ea * inv, w1 = eb * inv, w2 = ec * inv;
                GAS u32x2* yp = (GAS u32x2*)(Y + (size_t)m * DM + YCOL_B);
#pragma unroll
                for (int k = 0; k < 3; ++k) { const int uu = lane + 64 * k;
                    const float sc = k == 0 ? w0 : (k == 1 ? w1 : w2);
                    const u32x2 v = yp[uu]; yp[uu] = (u32x2){cvt_pk_bf16(bf_lo(v.x) * sc, bf_hi(v.x) * sc), cvt_pk_bf16(bf_lo(v.y) * sc, bf_hi(v.y) * sc)}; }
            }
        PHASE_END
        PHASE_BEGIN(pb + 8)
            pg8::ChainSched S; S.so.init(M, DM, G, bx);
            pg8::EpiBranch E{GATES, U};
            pg8::gemm_phase<pg8::EpiBranch, pg8::ChainSched>(ldsl + RING_OFF, Y, (const bf16_t*)((char*)Wb + WO_BR), DM, S, E);
        PHASE_END
        PHASE_BEGIN(pb + 9)
            pg8::PlainSched S; S.so.init(M, DM, G, bx); S.nt = DM / 64;
            pg8::EpiResid E{out, out + (size_t)S_P * DM, S_P, out, 1.0f};
            pg8::gemm_phase<pg8::EpiResid, pg8::PlainSched>(ldsl + RING_OFF, U, (const bf16_t*)((char*)Wb + WO_WO), DM, S, E);
        PHASE_END
        }
    }
    PHASE_BEGIN(PH_FINAL)
        LOCAL_IDS
        const float* g = args.in[17];
        f32x4 gv[8];
#pragma unroll
        for (int j = 0; j < 8; ++j) gv[j] = ((const f32x4*)g)[lane + 64 * j];
        for (int m = gw; m < M; m += NGW) {
            GAS f32x4* xr = (GAS f32x4*)(out + (size_t)m * DM) + lane; f32x4 v[8]; float ss = 0.f;
#pragma unroll
            for (int j = 0; j < 8; ++j) { v[j] = xr[64 * j]; ss += (v[j].x * v[j].x + v[j].y * v[j].y) + (v[j].z * v[j].z + v[j].w * v[j].w); }
            const float rstd = 1.0f / sqrtf(wave_sum(ss) * (1.0f / DM) + NORM_EPS);
#pragma unroll
            for (int j = 0; j < 8; ++j) xr[64 * j] = v[j] * rstd * gv[j];
        }
    PHASE_END
#undef PHASE_BEGIN
#undef PHASE_END
}

#ifndef N_LAUNCH_MODE
#define N_LAUNCH_MODE 0
#endif
extern "C" void kernel_launch(void* const* d_in, const int* in_sizes, int n_in, void* d_out, int out_size, void* d_ws, size_t ws_size, hipStream_t stream) {
    static int grid = 0;
    if (grid == 0) {
        if (n_in != 18 || out_size != M * DM || ws_size < WS_END) { fprintf(stderr, "kernel_launch: unexpected shapes: n_in %d out %d ws %zu (need %zu)\n", n_in, out_size, ws_size, (size_t)WS_END); grid = -1; return; }
        int dev = 0, cus = 0, per_cu = 0;
        if (hipGetDevice(&dev) != hipSuccess || hipDeviceGetAttribute(&cus, hipDeviceAttributeMultiprocessorCount, dev) != hipSuccess) { grid = -1; return; }
        if (hipFuncSetAttribute((const void*)fwd_kernel, hipFuncAttributeMaxDynamicSharedMemorySize, LDS_BYTES) != hipSuccess) { fprintf(stderr, "kernel_launch: hipFuncSetAttribute failed\n"); grid = -1; return; }
        if (hipOccupancyMaxActiveBlocksPerMultiprocessor(&per_cu, (const void*)fwd_kernel, NWAVES * 64, LDS_BYTES) != hipSuccess || per_cu < 1)
            fprintf(stderr, "kernel_launch: note: occupancy query reports %d workgroups per CU\n", per_cu);
        (void)hipGetLastError();
        grid = cus < 256 ? cus : 256;
    }
    if (grid < 0) return;
    if (hipMemsetAsync((char*)d_ws + WS_CTL, 0, CTL_ZERO_BYTES, stream) != hipSuccess) return;
    Args a{};
    for (int i = 0; i < 18; ++i) a.in[i] = (const float*)d_in[i];
    a.out = (float*)d_out; a.ws = (unsigned char*)d_ws;
#if N_LAUNCH_MODE == 1
    a.ph_lo = 0; a.ph_hi = PH_END;
    hipLaunchKernelGGL(fwd_kernel, dim3(grid), dim3(NWAVES * 64), LDS_BYTES, stream, a);
#else
    for (int s = 0; s < NSTEP; ++s)
        for (int p = 0; p < PH_PER_STEP; ++p) { if ((s & 1) && p >= 3) continue; a.ph_lo = s * PH_PER_STEP + p; a.ph_hi = a.ph_lo + 1;
            hipLaunchKernelGGL(fwd_kernel, dim3(grid), dim3(NWAVES * 64), LDS_BYTES, stream, a); }
    a.ph_lo = PH_FINAL; a.ph_hi = PH_END;
    hipLaunchKernelGGL(fwd_kernel, dim3(grid), dim3(NWAVES * 64), LDS_BYTES, stream, a);
#endif
    const hipError_t le = hipPeekAtLastError();
    if (le != hipSuccess) fprintf(stderr, "kernel_launch: launch failed: %s\n", hipGetErrorName(le));
}
```

```cpp
#include <hip/hip_runtime.h>
#include <cstdio>
#include <cstdint>

#define LAS __attribute__((address_space(3)))
#define GAS __attribute__((address_space(1)))
typedef unsigned short bf16_t;
typedef short bf16x8 __attribute__((ext_vector_type(8)));
typedef short s16x4 __attribute__((ext_vector_type(4)));
typedef float f32x2 __attribute__((ext_vector_type(2)));
typedef float f32x4 __attribute__((ext_vector_type(4)));
typedef float f32x16 __attribute__((ext_vector_type(16)));
typedef unsigned u32x2 __attribute__((ext_vector_type(2)));
typedef unsigned u32x4 __attribute__((ext_vector_type(4)));

constexpr int DM = 2048, DFF = 5632, DEPTH = 4, NSTEP = 2 * DEPTH;
constexpr int S_P = 16384, S_S = 8192;
constexpr int M = 49152;
constexpr int INW = 4608, GATEW = 6144, PGW = INW + GATEW, NFF2 = 2 * DFF;
constexpr int COL_QA = 0, COL_KA = 512, COL_VA = 768, COL_QB = 1024, COL_KB = 1792, COL_VB = 2560, COL_QC = 3328, COL_KC = 4096, COL_VC = 4352;
constexpr int YCOL_A = 0, YCOL_B = 512, YCOL_C = 1280;
constexpr float NORM_EPS = 1e-6f;

__device__ __forceinline__ unsigned cvt_pk_bf16(float lo, float hi) { unsigned r; asm volatile("v_cvt_pk_bf16_f32 %0, %1, %2" : "=v"(r) : "v"(lo), "v"(hi)); return r; }
__device__ __forceinline__ float bf_lo(unsigned w) { return __uint_as_float(w << 16); }
__device__ __forceinline__ float bf_hi(unsigned w) { return __uint_as_float(w & 0xffff0000u); }
__device__ __forceinline__ unsigned f2bf(float f) { unsigned u = __float_as_uint(f); return (u + 0x7fffu + ((u >> 16) & 1u)) >> 16; }
__device__ __forceinline__ unsigned pk2(float lo, float hi) { return f2bf(lo) | (f2bf(hi) << 16); }

namespace pg8 {
constexpr int BM = 256, BK = 64, HALF = 128, HTB = HALF * BK * 2, STAGE_BYTES = 8 * HTB, NXCD = 8, WGM = 8;
__host__ __device__ __forceinline__ int lds_byte(int r, int c) { const int st = (r >> 4) * 2 + (c >> 5), rr = r & 15, cc = c & 31, ob = rr * 64 + cc * 2; return st * 1024 + (ob ^ (((ob >> 9) & 1) << 5)); }
__host__ __device__ __forceinline__ void stage_rc(int b, int& R, int& C) { const int st = b / 1024, sb = b % 1024, swz = sb ^ (((sb >> 9) & 1) << 5); R = (st >> 1) * 16 + swz / 64; C = (st & 1) * 32 + (swz % 64) / 2; }
__host__ __device__ __forceinline__ int perm32(int rho) { const int n = rho >> 4, i = rho & 15; return 8 * (i >> 2) + 4 * n + (i & 3); }

struct Unit { int pm, pn, k0, nt, seg; };
struct StaticOrder {
    int nM, nN, nwg, G, c;
    __device__ void init(int M_, int N_, int G_, int c_) { nM = M_ / BM; nN = N_ / BM; nwg = nM * nN; G = G_; c = c_; }
    __device__ bool next(int i, int& pm, int& pn) const {
        const long L = (long)i * G + c; if (L >= nwg) return false;
        int wgid = (int)L; { const int q = nwg / NXCD, r = nwg % NXCD, xcd = wgid % NXCD, off = wgid / NXCD; wgid = (xcd < r ? xcd * (q + 1) : r * (q + 1) + (xcd - r) * q) + off; }
        const int nig = WGM * nN, gid = wgid / nig, fm = gid * WGM, gsz = (nM - fm) < WGM ? (nM - fm) : WGM;
        pm = fm + ((wgid % nig) % gsz); pn = (wgid % nig) / gsz; return true;
    }
};
struct PlainSched { StaticOrder so; int nt;
    __device__ __forceinline__ bool next(int i, Unit& u) const { u.k0 = 0; u.nt = nt; u.seg = 0; return so.next(i, u.pm, u.pn); } };
struct ChainSched { StaticOrder so;
    __device__ __forceinline__ bool next(int i, Unit& u) const { const int t = i / 3, sg = i - 3 * t; u.seg = sg; u.k0 = sg == 0 ? 0 : (sg == 1 ? 512 : 1280); u.nt = sg == 0 ? 8 : 12; return so.next(t, u.pm, u.pn); } };

typedef f32x4 Acc[2][2][4][2];

struct EpiSwiglu { static constexpr bool PERM = true, CHAIN = false; bf16_t* O;
    __device__ __forceinline__ void operator()(Acc& acc, const Unit& u, int wr, int wc, int fr, int fq) const {
        const int row0 = u.pm * BM + wr * 64 + fr, col0 = u.pn * HALF + wc * 32 + 8 * fq;
#pragma unroll
        for (int ai = 0; ai < 2; ++ai)
#pragma unroll
            for (int m = 0; m < 4; ++m) { bf16_t* rowp = O + (size_t)(row0 + ai * HALF + m * 16) * DFF + col0; float v[8];
#pragma unroll
                for (int n = 0; n < 2; ++n)
#pragma unroll
                    for (int j = 0; j < 4; ++j) { const float g = acc[ai][0][m][n][j], up = acc[ai][1][m][n][j];
                        const float e = __builtin_amdgcn_exp2f(g * -1.4426950408889634f); v[4 * n + j] = g * up * __builtin_amdgcn_rcpf(1.0f + e); }
                u32x4 w; w.x = cvt_pk_bf16(v[0], v[1]); w.y = cvt_pk_bf16(v[2], v[3]); w.z = cvt_pk_bf16(v[4], v[5]); w.w = cvt_pk_bf16(v[6], v[7]);
                *(u32x4*)rowp = w; }
    }
};
struct EpiResid { static constexpr bool PERM = false, CHAIN = false; const float* r0; const float* r1; int split; float* out; float alpha;
    __device__ __forceinline__ void operator()(Acc& acc, const Unit& u, int wr, int wc, int fr, int fq) const {
        const int rowt = u.pm * BM; const float* rb = rowt < split ? r0 + (size_t)rowt * DM : r1 + (size_t)(rowt - split) * DM;
        const int rloc = wr * 64 + fr, col0 = u.pn * BM + wc * 32 + 4 * fq; float* ob = out + (size_t)rowt * DM;
#pragma unroll
        for (int ai = 0; ai < 2; ++ai)
#pragma unroll
            for (int m = 0; m < 4; ++m) { const size_t off = (size_t)(rloc + ai * HALF + m * 16) * DM + col0;
#pragma unroll
                for (int bj = 0; bj < 2; ++bj)
#pragma unroll
                    for (int n = 0; n < 2; ++n) { const f32x4 r = *(const f32x4*)(rb + off + bj * HALF + n * 16); *(f32x4*)(ob + off + bj * HALF + n * 16) = r + acc[ai][bj][m][n] * alpha; }
                asm volatile("" ::: "memory"); }
    }
};
struct EpiProjGate { static constexpr bool PERM = true, CHAIN = false; bf16_t* proj; bf16_t* gates; const float* bias;
    __device__ __forceinline__ void operator()(Acc& acc, const Unit& u, int wr, int wc, int fr, int fq) const {
        const int row0 = u.pm * BM + wr * 64 + fr; const bool isg = u.pn >= INW / BM;
        const int col0 = (isg ? (u.pn - INW / BM) * BM : u.pn * BM) + wc * 32 + 8 * fq;
        bf16_t* base = isg ? gates : proj; const int ldc = isg ? GATEW : INW;
        f32x4 bv[2][2];
#pragma unroll
        for (int bj = 0; bj < 2; ++bj)
#pragma unroll
            for (int n = 0; n < 2; ++n) bv[bj][n] = isg ? *(const f32x4*)(bias + col0 + bj * HALF + 4 * n) : (f32x4){0.f, 0.f, 0.f, 0.f};
#pragma unroll
        for (int ai = 0; ai < 2; ++ai)
#pragma unroll
            for (int m = 0; m < 4; ++m) { bf16_t* rowp = base + (size_t)(row0 + ai * HALF + m * 16) * ldc + col0;
#pragma unroll
                for (int bj = 0; bj < 2; ++bj) { f32x4 v0 = acc[ai][bj][m][0] + bv[bj][0], v1 = acc[ai][bj][m][1] + bv[bj][1];
                    if (isg) {
#pragma unroll
                        for (int j = 0; j < 4; ++j) { v0[j] = __builtin_amdgcn_rcpf(1.0f + __builtin_amdgcn_exp2f(v0[j] * -1.4426950408889634f)); v1[j] = __builtin_amdgcn_rcpf(1.0f + __builtin_amdgcn_exp2f(v1[j] * -1.4426950408889634f)); } }
                    u32x4 w; w.x = cvt_pk_bf16(v0[0], v0[1]); w.y = cvt_pk_bf16(v0[2], v0[3]); w.z = cvt_pk_bf16(v1[0], v1[1]); w.w = cvt_pk_bf16(v1[2], v1[3]);
                    *(u32x4*)(rowp + bj * HALF) = w; } }
    }
};
struct EpiBranch { static constexpr bool PERM = true, CHAIN = true; const bf16_t* gates; bf16_t* O;
    __device__ __forceinline__ void operator()(Acc& acc, const Unit& u, int wr, int wc, int fr, int fq) const {
        const int row0 = u.pm * BM + wr * 64 + fr, col0 = u.pn * BM + wc * 32 + 8 * fq; const int seg = u.seg;
        const int no = seg == 0 ? 0 : (seg == 1 ? DM : 2 * DM), dofs = seg == 2 ? 2 * DM : no + DM;
#pragma unroll
        for (int ai = 0; ai < 2; ++ai)
#pragma unroll
            for (int m = 0; m < 4; ++m) { const size_t row = (size_t)(row0 + ai * HALF + m * 16);
#pragma unroll
                for (int bj = 0; bj < 2; ++bj) { const bf16_t* gp = gates + row * GATEW + col0 + bj * HALF;
                    const u32x4 gn = *(const u32x4*)(gp + no); float s[8];
                    s[0] = bf_lo(gn.x); s[1] = bf_hi(gn.x); s[2] = bf_lo(gn.y); s[3] = bf_hi(gn.y); s[4] = bf_lo(gn.z); s[5] = bf_hi(gn.z); s[6] = bf_lo(gn.w); s[7] = bf_hi(gn.w);
                    if (seg != 2) { const u32x4 gd = *(const u32x4*)(gp + dofs); float d[8];
                        d[0] = bf_lo(gd.x); d[1] = bf_hi(gd.x); d[2] = bf_lo(gd.y); d[3] = bf_hi(gd.y); d[4] = bf_lo(gd.z); d[5] = bf_hi(gd.z); d[6] = bf_lo(gd.w); d[7] = bf_hi(gd.w);
#pragma unroll
                        for (int j = 0; j < 8; ++j) s[j] = s[j] * __builtin_amdgcn_rcpf(fmaxf(d[j], 1e-30f));
                    }
#pragma unroll
                    for (int j = 0; j < 4; ++j) { acc[ai][bj][m][0][j] *= s[j]; acc[ai][bj][m][1][j] *= s[4 + j]; }
                    if (seg == 2) { const f32x4 v0 = acc[ai][bj][m][0], v1 = acc[ai][bj][m][1];
                        u32x4 w; w.x = cvt_pk_bf16(v0[0], v0[1]); w.y = cvt_pk_bf16(v0[2], v0[3]); w.z = cvt_pk_bf16(v1[0], v1[1]); w.w = cvt_pk_bf16(v1[2], v1[3]);
                        *(u32x4*)(O + row * DM + col0 + bj * HALF) = w; } }
                asm volatile("" ::: "memory"); }
    }
};

template <class Epi, class Sched>
__device__ __forceinline__ void gemm_phase(LAS unsigned char* lds, const bf16_t* Ag, const bf16_t* Btg, const int Kp, const Sched& S, const Epi& E) {
    int tid = threadIdx.x; asm volatile("" : "+v"(tid));
    const int wid = __builtin_amdgcn_readfirstlane(tid >> 6), lane = tid & 63, wr = wid >> 2, wc = wid & 3, fr = lane & 15, fq = lane >> 4;
    unsigned voffA[2], voffB[2];
#pragma unroll
    for (int i = 0; i < 2; ++i) { int R, C; stage_rc(tid * 16 + i * 8192, R, C); const int Rb = Epi::PERM ? ((R & ~31) + perm32(R & 31)) : R;
        voffA[i] = (unsigned)(R * Kp + C) * 2u; voffB[i] = (unsigned)(Rb * Kp + C) * 2u; }
    const size_t kstep = (size_t)(BK * 2);
    const size_t hstep = (size_t)HALF * Kp * 2;
    const size_t tstep = 2 * hstep;
    const unsigned ldsw = (unsigned)wid * 1024u;
    const int aoff = lds_byte(wr * 64 + fr, fq * 8), boff = lds_byte(wc * 32 + fr, fq * 8);
#define PG8_SA(b, h) (((b) * 2 + (h)) * HTB)
#define PG8_SB(b, h) ((4 + (b) * 2 + (h)) * HTB)
#define PG8_STAGE(bufoff, gbase, voff) do { _Pragma("unroll") for (int _i = 0; _i < 2; ++_i) \
        __builtin_amdgcn_global_load_lds((const unsigned*)((const char*)(gbase) + (voff)[_i]), (LAS unsigned*)(lds + (bufoff) + ldsw + _i * 8192), 16, 0, 0); } while (0)
#define PG8_LDA(dst, b, h) do { _Pragma("unroll") for (int m = 0; m < 4; ++m) _Pragma("unroll") for (int k = 0; k < 2; ++k) dst[m][k] = *(const LAS bf16x8*)(lds + PG8_SA(b, h) + aoff + m * 2048 + k * 1024); } while (0)
#define PG8_LDB(dst, b, h) do { _Pragma("unroll") for (int n = 0; n < 2; ++n) _Pragma("unroll") for (int k = 0; k < 2; ++k) dst[n][k] = *(const LAS bf16x8*)(lds + PG8_SB(b, h) + boff + n * 2048 + k * 1024); } while (0)
#define PG8_MMA(ai, bj, At, Bt) do { __builtin_amdgcn_s_setprio(1); _Pragma("unroll") for (int m = 0; m < 4; ++m) _Pragma("unroll") for (int n = 0; n < 2; ++n) _Pragma("unroll") for (int k = 0; k < 2; ++k) \
        acc[ai][bj][m][n] = __builtin_amdgcn_mfma_f32_16x16x32_bf16(Bt[n][k], At[m][k], acc[ai][bj][m][n], 0, 0, 0); __builtin_amdgcn_s_setprio(0); } while (0)
#define PG8_WAIT_V(n) asm volatile("s_waitcnt vmcnt(" #n ")" ::: "memory")
#define PG8_WAIT_L(n) asm volatile("s_waitcnt lgkmcnt(" #n ")" ::: "memory")
#define PG8_BAR __builtin_amdgcn_s_barrier()
#define PG8_SCHED __builtin_amdgcn_sched_barrier(0)
    Unit cur, nxt; int ui = 0;
    if (!S.next(0, cur)) return;
    Acc acc;
#pragma unroll
    for (int a = 0; a < 2; ++a)
#pragma unroll
        for (int b = 0; b < 2; ++b)
#pragma unroll
            for (int m = 0; m < 4; ++m)
#pragma unroll
                for (int n = 0; n < 2; ++n) acc[a][b][m][n] = (f32x4){0.f, 0.f, 0.f, 0.f};
    bf16x8 At[4][2], B0[2][2], B1[2][2];
    const char* cA = (const char*)Ag + (size_t)cur.pm * tstep + (size_t)cur.k0 * 2; const char* cB = (const char*)Btg + (size_t)cur.pn * tstep + (size_t)cur.k0 * 2;
    PG8_STAGE(PG8_SB(0, 0), cB, voffB); PG8_STAGE(PG8_SB(0, 1), cB + hstep, voffB); PG8_STAGE(PG8_SA(0, 0), cA, voffA); PG8_STAGE(PG8_SA(0, 1), cA + hstep, voffA);
    if (wr == 1) PG8_BAR;
    PG8_WAIT_V(2); PG8_BAR;
    PG8_STAGE(PG8_SB(1, 0), cB + kstep, voffB); PG8_STAGE(PG8_SA(1, 0), cA + kstep, voffA); PG8_STAGE(PG8_SB(1, 1), cB + hstep + kstep, voffB);
    PG8_WAIT_V(6); PG8_BAR;
    for (;;) {
        const bool has_next = S.next(ui + 1, nxt);
        const char* nA = has_next ? (const char*)Ag + (size_t)nxt.pm * tstep + (size_t)nxt.k0 * 2 : cA; const char* nB = has_next ? (const char*)Btg + (size_t)nxt.pn * tstep + (size_t)nxt.k0 * 2 : cB;
        const int nt = cur.nt;
        for (int t = 0; t < nt; t += 2) {
            const bool last = (t == nt - 2);
            const char* a1 = cA + (size_t)(t + 1) * kstep;
            const char* a2 = last ? nA : cA + (size_t)(t + 2) * kstep; const char* b2 = last ? nB : cB + (size_t)(t + 2) * kstep;
            const char* a3 = a2 + kstep; const char* b3 = b2 + kstep;
            PG8_LDB(B0, 0, 0); PG8_LDB(B1, 0, 1); PG8_SCHED; PG8_LDA(At, 0, 0); PG8_STAGE(PG8_SA(1, 1), a1 + hstep, voffA);
            PG8_WAIT_V(8); PG8_WAIT_L(0); PG8_BAR; PG8_MMA(0, 0, At, B0); PG8_MMA(0, 1, At, B1); PG8_BAR; PG8_SCHED;
            PG8_LDA(At, 0, 1); PG8_STAGE(PG8_SB(0, 0), b2, voffB); PG8_STAGE(PG8_SB(0, 1), b2 + hstep, voffB); PG8_STAGE(PG8_SA(0, 0), a2, voffA);
            PG8_WAIT_V(8); PG8_WAIT_L(0); PG8_BAR; PG8_MMA(1, 0, At, B0); PG8_MMA(1, 1, At, B1); PG8_BAR; PG8_SCHED;
            PG8_LDB(B0, 1, 0); PG8_LDB(B1, 1, 1); PG8_SCHED; PG8_LDA(At, 1, 0); PG8_STAGE(PG8_SA(0, 1), a2 + hstep, voffA);
            PG8_WAIT_V(8); PG8_WAIT_L(0); PG8_BAR; PG8_MMA(0, 0, At, B0); PG8_MMA(0, 1, At, B1); PG8_BAR; PG8_SCHED;
            PG8_LDA(At, 1, 1); PG8_STAGE(PG8_SB(1, 0), b3, voffB); PG8_STAGE(PG8_SB(1, 1), b3 + hstep, voffB); PG8_STAGE(PG8_SA(1, 0), a3, voffA);
            PG8_WAIT_V(8); PG8_WAIT_L(0); PG8_BAR; PG8_MMA(1, 0, At, B0); PG8_MMA(1, 1, At, B1); PG8_BAR; PG8_SCHED;
        }
        if (wr == 0) PG8_BAR;
        E(acc, cur, wr, wc, fr, fq);
        if (!has_next) break;
        if (!Epi::CHAIN || cur.seg == 2) {
#pragma unroll
            for (int a = 0; a < 2; ++a)
#pragma unroll
                for (int b = 0; b < 2; ++b)
#pragma unroll
                    for (int m = 0; m < 4; ++m)
#pragma unroll
                        for (int n = 0; n < 2; ++n) acc[a][b][m][n] = (f32x4){0.f, 0.f, 0.f, 0.f};
        }
        cur = nxt; cA = nA; cB = nB; ++ui;
        if (wr == 1) PG8_BAR;
    }
    PG8_WAIT_V(0);
    PG8_BAR;
#undef PG8_SA
#undef PG8_SB
#undef PG8_STAGE
#undef PG8_LDA
#undef PG8_LDB
#undef PG8_MMA
#undef PG8_WAIT_V
#undef PG8_WAIT_L
#undef PG8_BAR
#undef PG8_SCHED
}
}

namespace att {
constexpr int D = 128, NW = 8, QBLK = 32, KVBLK = 64;
constexpr float SCALE = 0.088388347648318440f;
constexpr float THR = 8.f;
constexpr size_t SHM_V = KVBLK * D * 2, SHM_K = KVBLK * D * 2, SHM_ATTN = 2 * SHM_V + 2 * SHM_K + NW * 64 * 4;
#define KSWZ(row, colB) ((row) * 256 + ((colB) ^ (((row) & 7) << 4)))
#define SBAR() __builtin_amdgcn_sched_barrier(0)
__device__ __forceinline__ int crow(int r, int hi) { return (r & 3) + 8 * (r >> 2) + 4 * hi; }
__device__ __forceinline__ unsigned cvtpk(float lo, float hi) { unsigned r; asm volatile("v_cvt_pk_bf16_f32 %0, %1, %2" : "=v"(r) : "v"(lo), "v"(hi)); return r; }

__device__ __forceinline__ void partialSM(f32x16& p0, f32x16& p1, float& m_reg, float& mn, float& alpha) {
  constexpr float C = SCALE * 1.4426950408889634f;
  float pmax = p0[0];
#pragma unroll
  for (int r = 1; r < 16; ++r) pmax = fmaxf(pmax, p0[r]);
#pragma unroll
  for (int r = 0; r < 16; ++r) pmax = fmaxf(pmax, p1[r]);
  { auto rr = __builtin_amdgcn_permlane32_swap(__float_as_uint(pmax), __float_as_uint(pmax), false, false);
    pmax = fmaxf(__uint_as_float(rr[0]), __uint_as_float(rr[1])); }
  if (__builtin_expect(__all(pmax - m_reg <= THR / SCALE), 1)) { mn = m_reg; alpha = 1.f; }
  else { mn = fmaxf(m_reg, pmax); alpha = __builtin_amdgcn_exp2f((m_reg - mn) * C); m_reg = mn; }
  float mnC = -mn * C;
#pragma unroll
  for (int r = 0; r < 16; ++r) p0[r] = fmaf(p0[r], C, mnC);
#pragma unroll
  for (int r = 0; r < 16; ++r) p1[r] = fmaf(p1[r], C, mnC);
#pragma unroll
  for (int r = 0; r < 16; ++r) p0[r] = __builtin_amdgcn_exp2f(p0[r]);
}
__device__ __forceinline__ void finishSM(f32x16& p0, f32x16& p1, float alpha, float& l_reg, bf16x8& pa0, bf16x8& pa1, bf16x8& pa2, bf16x8& pa3) {
#pragma unroll
  for (int r = 0; r < 16; ++r) p1[r] = __builtin_amdgcn_exp2f(p1[r]);
  float ps = 0;
#pragma unroll
  for (int r = 0; r < 16; ++r) ps += p0[r];
#pragma unroll
  for (int r = 0; r < 16; ++r) ps += p1[r];
  { auto rr = __builtin_amdgcn_permlane32_swap(__float_as_uint(ps), __float_as_uint(ps), false, false);
    ps = __uint_as_float(rr[0]) + __uint_as_float(rr[1]); }
  l_reg = l_reg * alpha + ps;
#define PK4(P, BASE, OUT) do { unsigned a0 = cvtpk(P[BASE + 0], P[BASE + 1]), a1 = cvtpk(P[BASE + 2], P[BASE + 3]);   \
    unsigned b0 = cvtpk(P[BASE + 4], P[BASE + 5]), b1 = cvtpk(P[BASE + 6], P[BASE + 7]);                              \
    auto r0 = __builtin_amdgcn_permlane32_swap(a0, b0, false, false); auto r1 = __builtin_amdgcn_permlane32_swap(a1, b1, false, false); \
    u32x4 w = {r0[0], r1[0], r0[1], r1[1]}; OUT = *reinterpret_cast<bf16x8*>(&w); } while (0)
  PK4(p0, 0, pa0); PK4(p0, 8, pa1); PK4(p1, 0, pa2); PK4(p1, 8, pa3);
#undef PK4
}
__device__ __forceinline__ void qkt(f32x16& p0, f32x16& p1, const char* Ks, const bf16x8* qr, int r32, int hi) {
  p0 = f32x16{}; p1 = f32x16{};
#pragma unroll
  for (int d0 = 0; d0 < 8; ++d0) { int cb = (d0 * 16 + hi * 8) * 2;
    bf16x8 b0 = *reinterpret_cast<const bf16x8*>(Ks + KSWZ(r32, cb));
    bf16x8 b1 = *reinterpret_cast<const bf16x8*>(Ks + KSWZ(32 + r32, cb));
    p0 = __builtin_amdgcn_mfma_f32_32x32x16_bf16(b0, qr[d0], p0, 0, 0, 0);
    p1 = __builtin_amdgcn_mfma_f32_32x32x16_bf16(b1, qr[d0], p1, 0, 0, 0); }
}
__device__ __forceinline__ int v_st(int k, int c) { const int kk = (k & ~0xC) | ((k & 4) << 1) | ((k & 8) >> 1); return ((kk >> 3) * 4 + (c >> 5)) * 512 + ((kk & 7) * 32 + (c & 31)) * 2; }
__device__ __forceinline__ int v_rd_base(int lane) { return ((lane & 3) << 3) | (((lane >> 2) & 3) << 6) | (((lane >> 4) & 1) << 5) | (((lane >> 5) & 1) << 8); }
constexpr int v_rd_off(int d0, int ks, int half) { return d0 * 512 + ks * 4096 + half * 2048; }
template <int OFF> __device__ __forceinline__ s16x4 tr_read(int vb) {
  s16x4 r; asm volatile("ds_read_b64_tr_b16 %0, %1 offset:%2" : "=&v"(r) : "v"(vb), "i"(OFF) : "memory"); return r;
}
template <int D0> __device__ __forceinline__ void pv_one(f32x16& od, int vb, bf16x8 pa0, bf16x8 pa1, bf16x8 pa2, bf16x8 pa3) {
  const s16x4 l0 = tr_read<v_rd_off(D0, 0, 0)>(vb), h0 = tr_read<v_rd_off(D0, 0, 1)>(vb), l1 = tr_read<v_rd_off(D0, 1, 0)>(vb), h1 = tr_read<v_rd_off(D0, 1, 1)>(vb);
  const s16x4 l2 = tr_read<v_rd_off(D0, 2, 0)>(vb), h2 = tr_read<v_rd_off(D0, 2, 1)>(vb), l3 = tr_read<v_rd_off(D0, 3, 0)>(vb), h3 = tr_read<v_rd_off(D0, 3, 1)>(vb);
  asm volatile("s_waitcnt lgkmcnt(0)" ::: "memory"); SBAR();
#define PK(L, H) (bf16x8){L[0], L[1], L[2], L[3], H[0], H[1], H[2], H[3]}
  od = __builtin_amdgcn_mfma_f32_32x32x16_bf16(pa0, PK(l0, h0), od, 0, 0, 0);
  od = __builtin_amdgcn_mfma_f32_32x32x16_bf16(pa1, PK(l1, h1), od, 0, 0, 0);
  od = __builtin_amdgcn_mfma_f32_32x32x16_bf16(pa2, PK(l2, h2), od, 0, 0, 0);
  od = __builtin_amdgcn_mfma_f32_32x32x16_bf16(pa3, PK(l3, h3), od, 0, 0, 0);
#undef PK
}
__device__ __forceinline__ void pv_d0(f32x16* o, int vb, bf16x8 pa0, bf16x8 pa1, bf16x8 pa2, bf16x8 pa3) {
  pv_one<0>(o[0], vb, pa0, pa1, pa2, pa3); pv_one<1>(o[1], vb, pa0, pa1, pa2, pa3); pv_one<2>(o[2], vb, pa0, pa1, pa2, pa3); pv_one<3>(o[3], vb, pa0, pa1, pa2, pa3);
}
__device__ __forceinline__ void bmask(f32x16& p0, f32x16& p1, int dq0, int kj0, int hw, int L) {
  const float ninf = -__builtin_inff();
#pragma unroll
  for (int r = 0; r < 16; ++r) { const int c = (r & 3) + 8 * (r >> 2);
    const bool ok0 = ((unsigned)(dq0 + c + hw) <= (unsigned)(2 * hw)) && ((unsigned)(kj0 + c) < (unsigned)L);
    const bool ok1 = ((unsigned)(dq0 + c + 32 + hw) <= (unsigned)(2 * hw)) && ((unsigned)(kj0 + c + 32) < (unsigned)L);
    p0[r] = ok0 ? p0[r] : ninf; p1[r] = ok1 ? p1[r] : ninf; }
}
struct Band { int i0, L, hw, tlo; float m0, l0; float* lse; long lse_ld; };

template <bool BAND>
__device__ __forceinline__ void attn_body(const bf16_t* __restrict__ Qb, const bf16_t* __restrict__ Kh, const bf16_t* __restrict__ Vh, bf16_t* __restrict__ Ob,
                                          const long ldq, const long ldk, const long ldo, const int NT, const Band bd, char* lds) {
  int tid = threadIdx.x; asm volatile("" : "+v"(tid));
  const int wid = tid >> 6, lane = tid & 63, r32 = lane & 31, hi = lane >> 5;
  char* V_lds = lds; char* K_lds = lds + 2 * SHM_V;
  float* ws = (float*)(lds + 2 * SHM_V + 2 * SHM_K) + wid * 64; float* li_l = ws; float* al_l = ws + 32;
  float m_reg = BAND ? bd.m0 : -1e30f, l_reg = BAND ? bd.l0 : 0.f; f32x16 o[4] = {}; bf16x8 qr[8];
  const bf16_t* Qw = Qb + (long)(wid * QBLK + r32) * ldq + hi * 8;
#pragma unroll
  for (int d0 = 0; d0 < 8; ++d0) qr[d0] = *reinterpret_cast<const bf16x8*>(Qw + d0 * 16);
  const int sr = tid >> 4, sc = (tid & 15) * 8, vst0 = v_st(sr, sc), vst1 = v_st(32 + sr, sc);
  const int vb0 = (int)(uintptr_t)V_lds + v_rd_base(lane);
  const int qi = BAND ? bd.i0 + wid * QBLK + r32 : 0;
  struct { bf16x8 vs0, vs1, ks0, ks1; } sr_[2];
#define KROW(k) (BAND ? (long)min(max((k), 0), bd.L - 1) : (long)(k))
#define SLOAD(i, jt) do { const int k0_ = (BAND ? bd.tlo + (jt) : (jt)) * KVBLK; const long ra_ = KROW(k0_ + sr) * ldk + sc, rb_ = KROW(k0_ + 32 + sr) * ldk + sc; \
    sr_[i].vs0 = *reinterpret_cast<const bf16x8*>(Vh + ra_); sr_[i].vs1 = *reinterpret_cast<const bf16x8*>(Vh + rb_); \
    sr_[i].ks0 = *reinterpret_cast<const bf16x8*>(Kh + ra_); sr_[i].ks1 = *reinterpret_cast<const bf16x8*>(Kh + rb_); } while (0)
#define SWRITE(b, i) do { *(bf16x8*)(V_lds + (b) * SHM_V + vst0) = sr_[i].vs0;          \
    *(bf16x8*)(V_lds + (b) * SHM_V + vst1) = sr_[i].vs1; int kc = sc * 2;               \
    *(bf16x8*)(K_lds + (b) * SHM_K + KSWZ(sr, kc)) = sr_[i].ks0;                       \
    *(bf16x8*)(K_lds + (b) * SHM_K + KSWZ(32 + sr, kc)) = sr_[i].ks1; } while (0)
#define SWAIT() asm volatile("s_waitcnt vmcnt(4)" ::: "memory")
#define RESC(a) do { if (__any((a) < 1.f)) { if (hi == 0) al_l[r32] = (a); asm volatile("s_waitcnt lgkmcnt(0)" ::: "memory"); \
    _Pragma("unroll") for (int d = 0; d < 4; ++d) _Pragma("unroll") for (int r = 0; r < 16; ++r) o[d][r] *= al_l[crow(r, hi)]; } } while (0)
#define BMASK(P0, P1, jt) do { if (BAND) { const int kt_ = (bd.tlo + (jt)) * KVBLK + 4 * hi; bmask(P0, P1, kt_ - qi, kt_, bd.hw, bd.L); } } while (0)
  f32x16 pA0, pA1, pB0, pB1; float mnA, mnB, alA, alB; bf16x8 pa0, pa1, pa2, pa3;
  constexpr int SE = 0, SO = 1;
  SLOAD(SE, 0); asm volatile("s_waitcnt vmcnt(0)" ::: "memory"); SWRITE(0, SE); __syncthreads();
  qkt(pA0, pA1, K_lds, qr, r32, hi); BMASK(pA0, pA1, 0); partialSM(pA0, pA1, m_reg, mnA, alA);
  SLOAD(SO, 1); if (2 < NT) SLOAD(SE, 2);
  SWAIT(); SWRITE(1, SO); __syncthreads();
  for (int j = 1; j + 1 < NT; j += 2) {
    SBAR(); qkt(pB0, pB1, K_lds + SHM_K, qr, r32, hi);
    finishSM(pA0, pA1, alA, l_reg, pa0, pa1, pa2, pa3); SBAR();
    SLOAD(SO, j + 2); SBAR();
    pv_d0(o, vb0, pa0, pa1, pa2, pa3); BMASK(pB0, pB1, j); partialSM(pB0, pB1, m_reg, mnB, alB);
    __syncthreads(); SWAIT(); SWRITE(0, SE);
    RESC(alB); __syncthreads();
    SBAR(); qkt(pA0, pA1, K_lds, qr, r32, hi);
    finishSM(pB0, pB1, alB, l_reg, pa0, pa1, pa2, pa3); SBAR();
    if (j + 3 < NT) SLOAD(SE, j + 3); SBAR();
    pv_d0(o, vb0 + (int)SHM_V, pa0, pa1, pa2, pa3); BMASK(pA0, pA1, j + 1); partialSM(pA0, pA1, m_reg, mnA, alA);
    __syncthreads(); SWAIT(); SWRITE(1, SO);
    RESC(alA); __syncthreads();
  }
  SBAR(); qkt(pB0, pB1, K_lds + SHM_K, qr, r32, hi);
  finishSM(pA0, pA1, alA, l_reg, pa0, pa1, pa2, pa3); SBAR();
  pv_d0(o, vb0, pa0, pa1, pa2, pa3); BMASK(pB0, pB1, NT - 1); partialSM(pB0, pB1, m_reg, mnB, alB);
  __syncthreads(); RESC(alB);
  finishSM(pB0, pB1, alB, l_reg, pa0, pa1, pa2, pa3); SBAR();
  pv_d0(o, vb0 + (int)SHM_V, pa0, pa1, pa2, pa3);
  if (hi == 0) li_l[r32] = l_reg; asm volatile("s_waitcnt lgkmcnt(0)" ::: "memory");
  float rli[16];
#pragma unroll
  for (int r = 0; r < 16; ++r) rli[r] = __builtin_amdgcn_rcpf(li_l[crow(r, hi)]);
  bf16_t* Ow = Ob + (long)(wid * QBLK) * ldo;
  const int odd = lane & 1;
#pragma unroll
  for (int r = 0; r < 16; r += 2) { const long orow = crow(r, hi) + odd;
#pragma unroll
    for (int d0 = 0; d0 < 4; ++d0) { const float a = o[d0][r] * rli[r], b = o[d0][r + 1] * rli[r + 1];
      const float snd = odd ? a : b;
      const float rcv = __int_as_float(__builtin_amdgcn_mov_dpp(__float_as_int(snd), 0xB1, 0xF, 0xF, true));
      const unsigned pk = odd ? cvtpk(rcv, b) : cvtpk(a, rcv);
      *(unsigned*)(Ow + orow * ldo + d0 * 32 + (r32 & ~1)) = pk; } }
  if (BAND) { if (bd.lse != nullptr && hi == 0) bd.lse[(long)(wid * QBLK + r32) * bd.lse_ld] = m_reg * SCALE + __logf(l_reg); }
  __syncthreads();
#undef KROW
#undef SLOAD
#undef SWRITE
#undef SWAIT
#undef RESC
#undef BMASK
}
}

constexpr size_t MiB = 1u << 20;
constexpr size_t WS_CTL = 0, CTL_ZERO_BYTES = 1 * MiB;
constexpr size_t WS_ROPE = 1 * MiB;
constexpr size_t WS_ROPEX = 9 * MiB;
constexpr size_t WS_LSE = 10 * MiB;
constexpr size_t WS_W = 12 * MiB;
constexpr size_t WO_F1IN = 0, WO_F1OUT = WO_F1IN + (size_t)NFF2 * DM * 2, WO_PG = WO_F1OUT + (size_t)DM * DFF * 2, WO_BR = WO_PG + (size_t)PGW * DM * 2,
                 WO_WO = WO_BR + (size_t)DM * DM * 2, WO_F2IN = WO_WO + (size_t)DM * DM * 2, WO_F2OUT = WO_F2IN + (size_t)NFF2 * DM * 2, W_BYTES = WO_F2OUT + (size_t)DM * DFF * 2;
constexpr size_t WS_U = WS_W + ((W_BYTES + MiB - 1) / MiB) * MiB;
constexpr size_t WS_Y = WS_U + (size_t)M * DM * 2;
constexpr size_t WS_BIG = WS_Y + (size_t)M * DM * 2;
constexpr size_t WS_PROJ = WS_BIG, WS_GATES = WS_BIG + (size_t)M * INW * 2;
constexpr size_t WS_END = WS_GATES + (size_t)M * GATEW * 2;
static_assert((size_t)M * DFF * 2 <= WS_END - WS_BIG, "act fits the overlay");
constexpr int CW_BAR = 4096;

constexpr int RING_OFF = 0, RING_BYTES = 131072;
constexpr int LDSCTL_OFF = RING_BYTES, MISC_OFF = LDSCTL_OFF + 320;
constexpr int LDS_BYTES = 147456;
constexpr int NWAVES = 8;

typedef GAS unsigned gu32;
#define RLX_AGENT __ATOMIC_RELAXED, __HIP_MEMORY_SCOPE_AGENT
#define LDS_WAIT() asm volatile("s_waitcnt lgkmcnt(0)" ::: "memory")

#define XB_TMO      128
#define XB_XCNT(j)  (256  + 64 * (j))
#define XB_XSUB(j)  (1280 + 64 * (j))
#define XB_XGEN(j)  (2304 + 64 * (j))
#define XB_TOP      3328
#define XB_TOPGEN   3392
#define XCD_BAR_WORDS 3456
#define XB_SPIN_CAP (1u << 22)
__device__ __forceinline__ unsigned xb_ld(unsigned* p)              { return __hip_atomic_load(p, __ATOMIC_RELAXED, __HIP_MEMORY_SCOPE_AGENT); }
__device__ __forceinline__ unsigned xb_add(unsigned* p, unsigned v) { return __hip_atomic_fetch_add(p, v, __ATOMIC_RELAXED, __HIP_MEMORY_SCOPE_AGENT); }
__device__ __forceinline__ unsigned xb_xcc_id() { return (unsigned)__builtin_amdgcn_s_getreg((3 << 11) | 20) & 0xFu; }
#define XB_SPIN(cond, bar) do { unsigned _sp = 0; while (cond) { __builtin_amdgcn_s_sleep(1); \
    if ((++_sp & 255u) == 0u) { if (xb_ld(&(bar)[XB_TMO])) break; if (_sp > XB_SPIN_CAP) { atomicAdd(&(bar)[XB_TMO], 1u); break; } } } } while (0)
struct XcdBarrier { unsigned* bar; unsigned x; volatile LAS unsigned* st; };
__device__ __forceinline__ XcdBarrier xcd_barrier_post(unsigned* bar, volatile LAS unsigned* st) {
    XcdBarrier b; b.bar = bar; b.x = xb_xcc_id(); b.st = st;
    if (threadIdx.x == 0) (void)xb_add(&bar[XB_XCNT(b.x)], 1u);
    return b;
}
__device__ __forceinline__ void xcd_barrier_complete(unsigned* bar, unsigned x, unsigned& nloc, unsigned& nx) {
    const unsigned G = gridDim.x * gridDim.y * gridDim.z;
    unsigned sum, cnt, mine, sp = 0u;
    for (;;) {
        sum = 0u; cnt = 0u; mine = 0u;
#pragma unroll
        for (unsigned j = 0; j < 16; ++j) { const unsigned c = xb_ld(&bar[XB_XCNT(j)]); sum += c; cnt += (c > 0u) ? 1u : 0u; mine = (j == x) ? c : mine; }
        if (sum == G) break;
        __builtin_amdgcn_s_sleep(1);
        if ((++sp & 255u) == 0u) { if (xb_ld(&bar[XB_TMO])) break; if (sp > XB_SPIN_CAP) { atomicAdd(&bar[XB_TMO], 1u); break; } }
    }
    nloc = mine > 0u ? mine : 1u; nx = cnt > 0u ? cnt : 1u;
}
__device__ __forceinline__ void xcd_barrier(const XcdBarrier& b) {
    asm volatile("s_waitcnt vmcnt(0)" ::: "memory");
    __syncthreads();
    if (threadIdx.x == 0) {
        unsigned* bar = b.bar;
        __builtin_amdgcn_s_waitcnt(0);
        unsigned nloc = b.st[0], nx = b.st[1];
        if (nloc == 0u) { xcd_barrier_complete(bar, b.x, nloc, nx); b.st[0] = nloc; b.st[1] = nx; }
        const unsigned old = xb_add(&bar[XB_XSUB(b.x)], 1u);
        const unsigned gen = old / nloc;
        if (old + 1u == (gen + 1u) * nloc) {
            __builtin_amdgcn_fence(__ATOMIC_RELEASE, "agent");
            asm volatile("s_waitcnt vmcnt(0)" ::: "memory");
            const unsigned og = xb_add(&bar[XB_TOP], 1u);
            const unsigned tg = og / nx;
            if (og + 1u == (tg + 1u) * nx) xb_add(&bar[XB_TOPGEN], 1u);
            else XB_SPIN(xb_ld(&bar[XB_TOPGEN]) == tg, bar);
            __builtin_amdgcn_fence(__ATOMIC_ACQUIRE, "agent");
            xb_add(&bar[XB_XGEN(b.x)], 1u);
            asm volatile("s_waitcnt vmcnt(0)" ::: "memory");
        } else {
            XB_SPIN(xb_ld(&bar[XB_XGEN(b.x)]) == gen, bar);
            __builtin_amdgcn_fence(__ATOMIC_ACQUIRE, "agent");
            asm volatile("s_waitcnt vmcnt(0)" ::: "memory");
        }
    }
    __syncthreads();
}

__device__ __forceinline__ float wave_sum(float v) {
#pragma unroll
    for (int o = 1; o < 64; o <<= 1) v += __shfl_xor(v, o);
    return v;
}
__device__ __forceinline__ void transpose_item(const float* W, int K, int N, bf16_t* WT, int k0, int n0, int drow, LAS float* scr, int lane) {
#pragma unroll 8
    for (int i = 0; i < 32; ++i) { const int kk = 2 * i + (lane >> 5); scr[kk * 33 + (lane & 31)] = W[(size_t)(k0 + kk) * N + n0 + (lane & 31)]; }
    LDS_WAIT(); asm volatile("" ::: "memory");
    const int c = lane & 7;
#pragma unroll
    for (int j = 0; j < 4; ++j) { const int n = (lane >> 3) + 8 * j; const LAS float* s = scr + (8 * c) * 33 + n;
        u32x4 o; o.x = pk2(s[0 * 33], s[1 * 33]); o.y = pk2(s[2 * 33], s[3 * 33]); o.z = pk2(s[4 * 33], s[5 * 33]); o.w = pk2(s[6 * 33], s[7 * 33]);
        *(GAS u32x4*)(WT + (size_t)(drow + n) * K + k0 + 8 * c) = o; }
    LDS_WAIT(); asm volatile("" ::: "memory");
}
__device__ __forceinline__ void sincos_d(double a, float& s, float& c) {
    const double q = rint(a * 0.63661977236758134308);
    double y = fma(-q, 1.5707963267948966192, a); y = fma(-q, 6.123233995736766e-17, y);
    const double y2 = y * y;
    double sp = 1.0 / 6227020800.0; sp = fma(sp, y2, -1.0 / 39916800.0); sp = fma(sp, y2, 1.0 / 362880.0); sp = fma(sp, y2, -1.0 / 5040.0); sp = fma(sp, y2, 1.0 / 120.0); sp = fma(sp, y2, -1.0 / 6.0); sp = fma(sp, y2, 1.0);
    const double sy = y * sp;
    double cp = -1.0 / 87178291200.0; cp = fma(cp, y2, 1.0 / 479001600.0); cp = fma(cp, y2, -1.0 / 3628800.0); cp = fma(cp, y2, 1.0 / 40320.0); cp = fma(cp, y2, -1.0 / 720.0); cp = fma(cp, y2, 1.0 / 24.0); cp = fma(cp, y2, -0.5); cp = fma(cp, y2, 1.0);
    const int k = (int)q & 3;
    const double ss = (k & 1) ? cp : sy, cc = (k & 1) ? sy : cp;
    s = (float)((k & 2) ? -ss : ss); c = (float)(((k + 1) & 2) ? -cc : cc);
}

struct Args { const float* in[18]; float* out; unsigned char* ws; int ph_lo, ph_hi; };
constexpr int PH_PER_STEP = 10, PH_FINAL = NSTEP * PH_PER_STEP, PH_END = PH_FINAL + 1;

__global__ void __launch_bounds__(NWAVES * 64, 2) fwd_kernel(Args args) {
    extern __shared__ __attribute__((aligned(16))) unsigned char lds[];
    LAS unsigned char* ldsl = (LAS unsigned char*)lds;
    volatile LAS unsigned* MISC = (volatile LAS unsigned*)(ldsl + MISC_OFF);
    const int G = gridDim.x; const int bx = blockIdx.x;
    const int vcu = (G % 8 == 0) ? (bx % 8) * (G / 8) + bx / 8 : bx;
    unsigned char* ws = args.ws;
    gu32* ctl = (gu32*)(ws + WS_CTL);
    for (int u = threadIdx.x; u < (LDS_BYTES - LDSCTL_OFF) / 4; u += NWAVES * 64) ((LAS unsigned*)(ldsl + LDSCTL_OFF))[u] = 0u;
    __syncthreads();
    const int lo = args.ph_lo, hi = args.ph_hi;
    const bool one_launch = (hi - lo) > 1;
    XcdBarrier bar; bar.bar = (unsigned*)(ctl + CW_BAR); bar.x = 0; bar.st = nullptr;
    if (one_launch) bar = xcd_barrier_post((unsigned*)(ctl + CW_BAR), MISC + 8);
    bool first = true;
#ifndef PH_MASK
#define PH_MASK 0xFFFF
#endif
#define PHASE_BEGIN(p) if (((PH_MASK >> ((p) == PH_FINAL ? 10 : (p) % PH_PER_STEP)) & 1) && lo <= (p) && (p) < hi) { if (!first) xcd_barrier(bar); first = false;
#define PHASE_END }

    const float* xp = args.in[0]; const float* xs = args.in[1];
    float* out = args.out;
    f32x2* rope = (f32x2*)(ws + WS_ROPE); f32x2* ropex = (f32x2*)(ws + WS_ROPEX);
    float* lseb = (float*)(ws + WS_LSE);
    bf16_t* U = (bf16_t*)(ws + WS_U); bf16_t* Y = (bf16_t*)(ws + WS_Y);
    bf16_t* ACT = (bf16_t*)(ws + WS_BIG); bf16_t* PROJ = (bf16_t*)(ws + WS_PROJ); bf16_t* GATES = (bf16_t*)(ws + WS_GATES);
    bf16_t* Wb = (bf16_t*)(ws + WS_W);
    const int NGW = G * NWAVES;
#define LOCAL_IDS int tid = threadIdx.x; asm volatile("" : "+v"(tid)); const int lane = tid & 63, wave = __builtin_amdgcn_readfirstlane(tid >> 6), gw = vcu * NWAVES + wave; (void)lane; (void)gw;

    if (lo == 0) {
        int tid = threadIdx.x; asm volatile("" : "+v"(tid));
        const int gt = vcu * NWAVES * 64 + tid, NGT = G * NWAVES * 64;
        for (int e = gt; e < S_P * 64 + 256 * 32; e += NGT) {
            const bool ax = e >= S_P * 64; const int ee = ax ? e - S_P * 64 : e; const int pos = ax ? ee >> 5 : ee >> 6, i = ax ? ee & 31 : ee & 63;
            const double base = ax ? 0.7498942093324559 : 0.8659643233600653; double inv = 1.0; double bp = base; int ii = i;
            for (int b = 0; b < 6; ++b) { if (ii & 1) inv *= bp; bp *= bp; ii >>= 1; }
            float sn, cs; sincos_d((double)pos * inv, sn, cs);
            (ax ? ropex : rope)[ee] = (f32x2){cs, sn};
        }
    }
    for (int s = 0; s < NSTEP; ++s) {
        const int l = s >> 1, which = s & 1, pb = s * PH_PER_STEP;
        PHASE_BEGIN(pb + 0)
            LOCAL_IDS
            if (which == 0) {
                LAS float* scr = (LAS float*)(ldsl + RING_OFF + wave * 16384);
                constexpr int I_FIN = (DM / 64) * (NFF2 / 32), I_FOUT = (DFF / 64) * (DM / 32), I_IN = (DM / 64) * (INW / 32), I_GT = (DM / 64) * (GATEW / 32), I_SQ = (DM / 64) * (DM / 32);
                constexpr int NITEMS = 2 * I_FIN + 2 * I_FOUT + I_IN + I_GT + 2 * I_SQ;
                const float* w_f1in = args.in[3] + (size_t)l * DM * NFF2; const float* w_f1out = args.in[4] + (size_t)l * DFF * DM;
                const float* w_in = args.in[6] + (size_t)l * DM * INW; const float* w_br = args.in[10] + (size_t)l * DM * DM;
                const float* w_gt = args.in[11] + (size_t)l * DM * GATEW; const float* w_o = args.in[13] + (size_t)l * DM * DM;
                const float* w_f2in = args.in[15] + (size_t)l * DM * NFF2; const float* w_f2out = args.in[16] + (size_t)l * DFF * DM;
                for (int it = gw; it < NITEMS; it += NGW) {
                    int r = it;
                    if (r < 2 * I_FIN) { const bool sec = r >= I_FIN; if (sec) r -= I_FIN; const int nblk = NFF2 / 32, kb = r / nblk, nb = r % nblk, n0 = nb * 32;
                        const int half = n0 >= DFF ? 1 : 0, rem = n0 - half * DFF, drow = (rem >> 7) * 256 + half * 128 + (rem & 127);
                        transpose_item(sec ? w_f2in : w_f1in, DM, NFF2, (bf16_t*)((char*)Wb + (sec ? WO_F2IN : WO_F1IN)), kb * 64, n0, drow, scr, lane); continue; }
                    r -= 2 * I_FIN;
                    if (r < 2 * I_FOUT) { const bool sec = r >= I_FOUT; if (sec) r -= I_FOUT; const int nblk = DM / 32, kb = r / nblk, nb = r % nblk;
                        transpose_item(sec ? w_f2out : w_f1out, DFF, DM, (bf16_t*)((char*)Wb + (sec ? WO_F2OUT : WO_F1OUT)), kb * 64, nb * 32, nb * 32, scr, lane); continue; }
                    r -= 2 * I_FOUT;
                    if (r < I_IN) { const int nblk = INW / 32, kb = r / nblk, nb = r % nblk;
                        transpose_item(w_in, DM, INW, (bf16_t*)((char*)Wb + WO_PG), kb * 64, nb * 32, nb * 32, scr, lane); continue; }
                    r -= I_IN;
                    if (r < I_GT) { const int nblk = GATEW / 32, kb = r / nblk, nb = r % nblk;
                        transpose_item(w_gt, DM, GATEW, (bf16_t*)((char*)Wb + WO_PG), kb * 64, nb * 32, INW + nb * 32, scr, lane); continue; }
                    r -= I_GT;
                    { const bool sec = r >= I_SQ; if (sec) r -= I_SQ; const int nblk = DM / 32, kb = r / nblk, nb = r % nblk;
                        transpose_item(sec ? w_o : w_br, DM, DM, (bf16_t*)((char*)Wb + (sec ? WO_WO : WO_BR)), kb * 64, nb * 32, nb * 32, scr, lane); }
                }
            }
            {
                const float* g = (which == 0 ? args.in[2] : args.in[14]) + (size_t)l * DM;
                f32x4 gv[8];
#pragma unroll
                for (int j = 0; j < 8; ++j) gv[j] = ((const f32x4*)g)[lane + 64 * j];
                for (int m = gw; m < M; m += NGW) {
                    const float* xrow = (s == 0) ? (m < S_P ? xp + (size_t)m * DM : xs + (size_t)(m - S_P) * DM) : out + (size_t)m * DM;
                    const GAS f32x4* xr = (const GAS f32x4*)xrow + lane; f32x4 v[8]; float ss = 0.f;
#pragma unroll
                    for (int j = 0; j < 8; ++j) { v[j] = xr[64 * j]; ss += (v[j].x * v[j].x + v[j].y * v[j].y) + (v[j].z * v[j].z + v[j].w * v[j].w); }
                    const float rstd = 1.0f / sqrtf(wave_sum(ss) * (1.0f / DM) + NORM_EPS);
                    GAS u32x2* o8 = (GAS u32x2*)(U + (size_t)m * DM) + lane;
#pragma unroll
                    for (int j = 0; j < 8; ++j) { const f32x4 y = v[j] * rstd * gv[j]; o8[64 * j] = (u32x2){cvt_pk_bf16(y.x, y.y), cvt_pk_bf16(y.z, y.w)}; }
                }
            }
        PHASE_END
        PHASE_BEGIN(pb + 1)
            pg8::PlainSched S; S.so.init(M, NFF2, G, bx); S.nt = DM / 64;
            pg8::EpiSwiglu E{ACT};
            pg8::gemm_phase<pg8::EpiSwiglu, pg8::PlainSched>(ldsl + RING_OFF, U, (const bf16_t*)((char*)Wb + (which ? WO_F2IN : WO_F1IN)), DM, S, E);
        PHASE_END
        PHASE_BEGIN(pb + 2)
            pg8::PlainSched S; S.so.init(M, DM, G, bx); S.nt = DFF / 64;
            pg8::EpiResid E{s == 0 ? xp : out, s == 0 ? xs : out + (size_t)S_P * DM, S_P, out, 0.5f};
            pg8::gemm_phase<pg8::EpiResid, pg8::PlainSched>(ldsl + RING_OFF, ACT, (const bf16_t*)((char*)Wb + (which ? WO_F2OUT : WO_F1OUT)), DFF, S, E);
        PHASE_END
        if (which == 0) {
        PHASE_BEGIN(pb + 3)
            LOCAL_IDS
            const float* g = args.in[5] + (size_t)l * DM;
            f32x4 gv[8];
#pragma unroll
            for (int j = 0; j < 8; ++j) gv[j] = ((const f32x4*)g)[lane + 64 * j];
            for (int m = gw; m < M; m += NGW) {
                const GAS f32x4* xr = (const GAS f32x4*)(out + (size_t)m * DM) + lane; f32x4 v[8]; float ss = 0.f;
#pragma unroll
                for (int j = 0; j < 8; ++j) { v[j] = xr[64 * j]; ss += (v[j].x * v[j].x + v[j].y * v[j].y) + (v[j].z * v[j].z + v[j].w * v[j].w); }
                const float rstd = 1.0f / sqrtf(wave_sum(ss) * (1.0f / DM) + NORM_EPS);
                GAS u32x2* o8 = (GAS u32x2*)(U + (size_t)m * DM) + lane;
#pragma unroll
                for (int j = 0; j < 8; ++j) { const f32x4 y = v[j] * rstd * gv[j]; o8[64 * j] = (u32x2){cvt_pk_bf16(y.x, y.y), cvt_pk_bf16(y.z, y.w)}; }
            }
        PHASE_END
        PHASE_BEGIN(pb + 4)
            pg8::PlainSched S; S.so.init(M, PGW, G, bx); S.nt = DM / 64;
            pg8::EpiProjGate E{PROJ, GATES, args.in[12] + (size_t)l * GATEW};
            pg8::gemm_phase<pg8::EpiProjGate, pg8::PlainSched>(ldsl + RING_OFF, U, (const bf16_t*)((char*)Wb + WO_PG), DM, S, E);
        PHASE_END
        PHASE_BEGIN(pb + 5)
            LOCAL_IDS
            const float* gq = args.in[8] + (size_t)l * 128; const float* gk = args.in[9] + (size_t)l * 128;
            const int e1x = (lane >> 5) * 64 + (lane & 31), e2x = e1x + 32;
            const float gq1 = gq[e1x], gq2 = gq[e2x], gk1 = gk[e1x], gk2 = gk[e2x];
            for (int m = gw; m < M; m += NGW) {
                const int pos = m < S_P ? m : (m & (S_S - 1));
                const f32x2 cs = rope[pos * 64 + lane];
                const int idx = (lane >> 5) ? (pos & 63) : (pos >> 6);
                const f32x2 cx = ropex[idx * 32 + (lane & 31)];
                bf16_t* row = PROJ + (size_t)m * INW;
#pragma unroll 6
                for (int hh = 0; hh < 18; ++hh) {
                    bf16_t* hp = row + (hh < 6 ? hh * 128 : COL_QB + (hh - 6) * 128);
                    const float x1 = __uint_as_float((unsigned)hp[lane] << 16), x2 = __uint_as_float((unsigned)hp[lane + 64] << 16);
                    hp[lane] = (bf16_t)f2bf(x1 * cs.x - x2 * cs.y); hp[lane + 64] = (bf16_t)f2bf(x2 * cs.x + x1 * cs.y);
                }
#pragma unroll 4
                for (int hh = 0; hh < 8; ++hh) {
                    bf16_t* hp = row + COL_QC + hh * 128;
                    const float x1 = __uint_as_float((unsigned)hp[e1x] << 16), x2 = __uint_as_float((unsigned)hp[e2x] << 16);
                    const float rstd = 1.0f / sqrtf(wave_sum(x1 * x1 + x2 * x2) * (1.0f / 128.0f) + NORM_EPS);
                    const float y1 = x1 * rstd * (hh < 6 ? gq1 : gk1), y2 = x2 * rstd * (hh < 6 ? gq2 : gk2);
                    hp[e1x] = (bf16_t)f2bf(y1 * cx.x - y2 * cx.y); hp[e2x] = (bf16_t)f2bf(y2 * cx.x + y1 * cx.y);
                }
            }
        PHASE_END
        PHASE_BEGIN(pb + 6)
            char* alds = (char*)lds + RING_OFF;
            att::Band nob{0, 0, 0, 0, -1e30f, 0.f, nullptr, 0};
            for (int v = vcu; v < 256; v += G) {
                const bool pr = v < 128;
                const int nun = pr ? 3 : 6, x = (v - 128) >> 5, qb = pr ? (v & 63) : (v & 31);
                for (int r6 = 0; r6 < nun; ++r6) {
                    const int pair = x * 2 + r6 / 3, sq = pair >> 1, kvh = pr ? (v >> 6) : (pair & 1), h = kvh * 3 + (r6 % 3);
                    const size_t sb = pr ? 0 : (size_t)S_P + (size_t)sq * S_S, r0 = sb + (size_t)qb * 256;
                    att::attn_body<false>(PROJ + r0 * INW + COL_QC + h * 128, PROJ + sb * INW + COL_KC + kvh * 128, PROJ + sb * INW + COL_VC + kvh * 128, Y + r0 * DM + YCOL_C + h * 128, INW, INW, DM, pr ? S_P / 64 : S_S / 64, nob, alds);
                }
            }
            const float* sink = args.in[7] + (size_t)l * 4;
            for (int u = vcu; u < 768 + 1152; u += G) {
                const bool isA = u < 768; const int ub = u - 768;
                const int hh = isA ? (u & 3) : ub % 6, blk = isA ? (u >> 2) : ub / 6, dil = isA ? 1 : (hh < 2 ? 1 : (hh < 4 ? 4 : 16));
                const int R0 = blk * 256; const int sb = R0 < S_P ? 0 : S_P + ((R0 - S_P) / S_S) * S_S, Ls = R0 < S_P ? S_P : S_S;
                const int bis = (R0 - sb) / 256, L = Ls / dil, nbr = L / 256, res = bis / nbr, i0 = (bis - res * nbr) * 256;
                const size_t t0 = (size_t)sb + res + (size_t)i0 * dil;
                att::Band bd; bd.i0 = i0; bd.L = L; bd.hw = isA ? 128 : 64; bd.tlo = i0 / 64 - (isA ? 2 : 1); bd.m0 = isA ? sink[hh] * (1.0f / att::SCALE) : -1e30f; bd.l0 = isA ? 1.0f : 0.f;
                bd.lse = isA ? nullptr : lseb + t0 * 8 + hh; bd.lse_ld = (long)8 * dil;
                const bf16_t* pb_ = PROJ + ((size_t)sb + res) * INW;
                const int cq = isA ? COL_QA + hh * 128 : COL_QB + hh * 128, ck = isA ? COL_KA + (hh >> 1) * 128 : COL_KB + hh * 128, cv = isA ? COL_VA + (hh >> 1) * 128 : COL_VB + hh * 128;
                att::attn_body<true>(PROJ + t0 * INW + cq, pb_ + ck, pb_ + cv, Y + t0 * DM + (isA ? YCOL_A : YCOL_B) + hh * 128, (long)INW * dil, (long)INW * dil, (long)DM * dil, isA ? 8 : 6, bd, alds);
            }
        PHASE_END
        PHASE_BEGIN(pb + 7)
            LOCAL_IDS
            for (int m = gw; m < M; m += NGW) {
                const float* lp = lseb + (size_t)m * 8;
                const f32x4 l03 = *(const f32x4*)lp; const f32x2 l45 = *(const f32x2*)(lp + 4);
                const int j = lane >> 5;
                const float a = j ? l03.y : l03.x, b = j ? l03.w : l03.z, c = j ? l45.y : l45.x, mx = fmaxf(a, fmaxf(b, c));
                const float ea = __expf(a - mx), eb = __expf(b - mx), ec = __expf(c - mx), inv = 1.0f / (ea + eb + ec);
                const float w0 = ea * inv, w1 = eb * inv, w2 = ec * inv;
                GAS u32x2* yp = (GAS u32x2*)(Y + (size_t)m * DM + YCOL_B);
#pragma unroll
                for (int k = 0; k < 3; ++k) { const int uu = lane + 64 * k;
                    const float sc = k == 0 ? w0 : (k == 1 ? w1 : w2);
                    const u32x2 v = yp[uu]; yp[uu] = (u32x2){cvt_pk_bf16(bf_lo(v.x) * sc, bf_hi(v.x) * sc), cvt_pk_bf16(bf_lo(v.y) * sc, bf_hi(v.y) * sc)}; }
            }
        PHASE_END
        PHASE_BEGIN(pb + 8)
            pg8::ChainSched S; S.so.init(M, DM, G, bx);
            pg8::EpiBranch E{GATES, U};
            pg8::gemm_phase<pg8::EpiBranch, pg8::ChainSched>(ldsl + RING_OFF, Y, (const bf16_t*)((char*)Wb + WO_BR), DM, S, E);
        PHASE_END
        PHASE_BEGIN(pb + 9)
            pg8::PlainSched S; S.so.init(M, DM, G, bx); S.nt = DM / 64;
            pg8::EpiResid E{out, out + (size_t)S_P * DM, S_P, out, 1.0f};
            pg8::gemm_phase<pg8::EpiResid, pg8::PlainSched>(ldsl + RING_OFF, U, (const bf16_t*)((char*)Wb + WO_WO), DM, S, E);
        PHASE_END
        }
    }
    PHASE_BEGIN(PH_FINAL)
        LOCAL_IDS
        const float* g = args.in[17];
        f32x4 gv[8];
#pragma unroll
        for (int j = 0; j < 8; ++j) gv[j] = ((const f32x4*)g)[lane + 64 * j];
        for (int m = gw; m < M; m += NGW) {
            GAS f32x4* xr = (GAS f32x4*)(out + (size_t)m * DM) + lane; f32x4 v[8]; float ss = 0.f;
#pragma unroll
            for (int j = 0; j < 8; ++j) { v[j] = xr[64 * j]; ss += (v[j].x * v[j].x + v[j].y * v[j].y) + (v[j].z * v[j].z + v[j].w * v[j].w); }
            const float rstd = 1.0f / sqrtf(wave_sum(ss) * (1.0f / DM) + NORM_EPS);
#pragma unroll
            for (int j = 0; j < 8; ++j) xr[64 * j] = v[j] * rstd * gv[j];
        }
    PHASE_END
#undef PHASE_BEGIN
#undef PHASE_END
}

#ifndef N_LAUNCH_MODE
#define N_LAUNCH_MODE 1
#endif
extern "C" void kernel_launch(void* const* d_in, const int* in_sizes, int n_in, void* d_out, int out_size, void* d_ws, size_t ws_size, hipStream_t stream) {
    static int grid = 0;
    if (grid == 0) {
        if (n_in != 18 || out_size != M * DM || ws_size < WS_END) { fprintf(stderr, "kernel_launch: unexpected shapes: n_in %d out %d ws %zu (need %zu)\n", n_in, out_size, ws_size, (size_t)WS_END); grid = -1; return; }
        int dev = 0, cus = 0, per_cu = 0;
        if (hipGetDevice(&dev) != hipSuccess || hipDeviceGetAttribute(&cus, hipDeviceAttributeMultiprocessorCount, dev) != hipSuccess) { grid = -1; return; }
        if (hipFuncSetAttribute((const void*)fwd_kernel, hipFuncAttributeMaxDynamicSharedMemorySize, LDS_BYTES) != hipSuccess) { fprintf(stderr, "kernel_launch: hipFuncSetAttribute failed\n"); grid = -1; return; }
        if (hipOccupancyMaxActiveBlocksPerMultiprocessor(&per_cu, (const void*)fwd_kernel, NWAVES * 64, LDS_BYTES) != hipSuccess || per_cu < 1)
            fprintf(stderr, "kernel_launch: note: occupancy query reports %d workgroups per CU\n", per_cu);
        (void)hipGetLastError();
        grid = cus < 256 ? cus : 256;
    }
    if (grid < 0) return;
    if (hipMemsetAsync((char*)d_ws + WS_CTL, 0, CTL_ZERO_BYTES, stream) != hipSuccess) return;
    Args a{};
    for (int i = 0; i < 18; ++i) a.in[i] = (const float*)d_in[i];
    a.out = (float*)d_out; a.ws = (unsigned char*)d_ws;
#if N_LAUNCH_MODE == 1
    a.ph_lo = 0; a.ph_hi = PH_END;
    hipLaunchKernelGGL(fwd_kernel, dim3(grid), dim3(NWAVES * 64), LDS_BYTES, stream, a);
#else
    for (int s = 0; s < NSTEP; ++s)
        for (int p = 0; p < PH_PER_STEP; ++p) { if ((s & 1) && p >= 3) continue; a.ph_lo = s * PH_PER_STEP + p; a.ph_hi = a.ph_lo + 1;
            hipLaunchKernelGGL(fwd_kernel, dim3(grid), dim3(NWAVES * 64), LDS_BYTES, stream, a); }
    a.ph_lo = PH_FINAL; a.ph_hi = PH_END;
    hipLaunchKernelGGL(fwd_kernel, dim3(grid), dim3(NWAVES * 64), LDS_BYTES, stream, a);
#endif
    const hipError_t le = hipPeekAtLastError();
    if (le != hipSuccess) fprintf(stderr, "kernel_launch: launch failed: %s\n", hipGetErrorName(le));
}
```

```cpp
#include <hip/hip_runtime.h>
#include <cstdio>
#include <cstdint>
#define PROBE_MODE 3
#ifndef REP_MASK
#define REP_MASK 0
#endif

#define LAS __attribute__((address_space(3)))
#define GAS __attribute__((address_space(1)))
typedef unsigned short bf16_t;
typedef short bf16x8 __attribute__((ext_vector_type(8)));
typedef short s16x4 __attribute__((ext_vector_type(4)));
typedef float f32x2 __attribute__((ext_vector_type(2)));
typedef float f32x4 __attribute__((ext_vector_type(4)));
typedef float f32x16 __attribute__((ext_vector_type(16)));
typedef unsigned u32x2 __attribute__((ext_vector_type(2)));
typedef unsigned u32x4 __attribute__((ext_vector_type(4)));

constexpr int DM = 2048, DFF = 5632, DEPTH = 4, NSTEP = 2 * DEPTH;
constexpr int S_P = 16384, S_S = 8192;
constexpr int M = 49152;
constexpr int INW = 4608, GATEW = 6144, PGW = INW + GATEW, NFF2 = 2 * DFF;
constexpr int COL_QA = 0, COL_KA = 512, COL_VA = 768, COL_QB = 1024, COL_KB = 1792, COL_VB = 2560, COL_QC = 3328, COL_KC = 4096, COL_VC = 4352;
constexpr int YCOL_A = 0, YCOL_B = 512, YCOL_C = 1280;
constexpr float NORM_EPS = 1e-6f;

__device__ __forceinline__ unsigned cvt_pk_bf16(float lo, float hi) { unsigned r; asm volatile("v_cvt_pk_bf16_f32 %0, %1, %2" : "=v"(r) : "v"(lo), "v"(hi)); return r; }
__device__ __forceinline__ float bf_lo(unsigned w) { return __uint_as_float(w << 16); }
__device__ __forceinline__ float bf_hi(unsigned w) { return __uint_as_float(w & 0xffff0000u); }
__device__ __forceinline__ unsigned f2bf(float f) { unsigned u = __float_as_uint(f); return (u + 0x7fffu + ((u >> 16) & 1u)) >> 16; }
__device__ __forceinline__ unsigned pk2(float lo, float hi) { return f2bf(lo) | (f2bf(hi) << 16); }

namespace pg8 {
constexpr int BM = 256, BK = 64, HALF = 128, HTB = HALF * BK * 2, STAGE_BYTES = 8 * HTB, NXCD = 8;
__host__ __device__ __forceinline__ int lds_byte(int r, int c) { const int st = (r >> 4) * 2 + (c >> 5), rr = r & 15, cc = c & 31, ob = rr * 64 + cc * 2; return st * 1024 + (ob ^ (((ob >> 9) & 1) << 5)); }
__host__ __device__ __forceinline__ void stage_rc(int b, int& R, int& C) { const int st = b / 1024, sb = b % 1024, swz = sb ^ (((sb >> 9) & 1) << 5); R = (st >> 1) * 16 + swz / 64; C = (st & 1) * 32 + (swz % 64) / 2; }
__host__ __device__ __forceinline__ int perm32(int rho) { const int n = rho >> 4, i = rho & 15; return 8 * (i >> 2) + 4 * n + (i & 3); }

struct Unit { int pm, pn, k0, nt, seg; };
struct StaticOrder {
    int nM, nN, nwg, G, c, WGM;
    __device__ void init(int M_, int N_, int G_, int c_, int wgm) { nM = M_ / BM; nN = N_ / BM; nwg = nM * nN; G = G_; c = c_; WGM = wgm; }
    __device__ bool next(int i, int& pm, int& pn) const {
        const long L = (long)i * G + c; if (L >= nwg) return false;
        int wgid = (int)L; { const int q = nwg / NXCD, r = nwg % NXCD, xcd = wgid % NXCD, off = wgid / NXCD; wgid = (xcd < r ? xcd * (q + 1) : r * (q + 1) + (xcd - r) * q) + off; }
        const int nig = WGM * nN, gid = wgid / nig, fm = gid * WGM, gsz = (nM - fm) < WGM ? (nM - fm) : WGM;
        pm = fm + ((wgid % nig) % gsz); pn = (wgid % nig) / gsz; return true;
    }
};
struct PlainSched { StaticOrder so; int nt;
    __device__ __forceinline__ bool next(int i, Unit& u) const { u.k0 = 0; u.nt = nt; u.seg = 0; return so.next(i, u.pm, u.pn); } };
struct ChainSched { StaticOrder so;
    __device__ __forceinline__ bool next(int i, Unit& u) const { const int t = i / 3, sg = i - 3 * t; u.seg = sg; u.k0 = sg == 0 ? 0 : (sg == 1 ? 512 : 1280); u.nt = sg == 0 ? 8 : 12; return so.next(t, u.pm, u.pn); } };

typedef f32x4 Acc[2][2][4][2];

struct EpiSwiglu { static constexpr bool PERM = true, CHAIN = false; bf16_t* O;
    __device__ __forceinline__ void operator()(Acc& acc, const Unit& u, int wr, int wc, int fr, int fq) const {
        const int row0 = u.pm * BM + wr * 64 + fr, col0 = u.pn * HALF + wc * 32 + 8 * fq;
#pragma unroll
        for (int ai = 0; ai < 2; ++ai)
#pragma unroll
            for (int m = 0; m < 4; ++m) { bf16_t* rowp = O + (size_t)(row0 + ai * HALF + m * 16) * DFF + col0; float v[8];
#pragma unroll
                for (int n = 0; n < 2; ++n)
#pragma unroll
                    for (int j = 0; j < 4; ++j) { const float g = acc[ai][0][m][n][j], up = acc[ai][1][m][n][j];
                        const float e = __builtin_amdgcn_exp2f(g * -1.4426950408889634f); v[4 * n + j] = g * up * __builtin_amdgcn_rcpf(1.0f + e); }
                u32x4 w; w.x = cvt_pk_bf16(v[0], v[1]); w.y = cvt_pk_bf16(v[2], v[3]); w.z = cvt_pk_bf16(v[4], v[5]); w.w = cvt_pk_bf16(v[6], v[7]);
                *(u32x4*)rowp = w; }
    }
};
__device__ __forceinline__ f32x4 dpp_xor1(f32x4 v) { f32x4 r;
#pragma unroll
    for (int j = 0; j < 4; ++j) r[j] = __int_as_float(__builtin_amdgcn_mov_dpp(__float_as_int(v[j]), 0xB1, 0xF, 0xF, true));
    return r; }
struct EpiResid { static constexpr bool PERM = false, CHAIN = false; const float* r0; const float* r1; int split; float* out; float alpha; int mode; float* scratch;
    __device__ __forceinline__ void operator()(Acc& acc, const Unit& u, int wr, int wc, int fr, int fq) const {
        if (REP_MASK && mode == 1) return;
        const int rowt = u.pm * BM; const float* rb = rowt < split ? r0 + (size_t)rowt * DM : r1 + (size_t)(rowt - split) * DM;
        const int odd = fr & 1;
        const int rloc = wr * 64 + (fr & ~1), col0 = u.pn * BM + wc * 32 + 4 * fq + 16 * odd; float* ob = out + (size_t)rowt * DM;
#pragma unroll
        for (int ai = 0; ai < 2; ++ai) {
            f32x4 r[4][2][2];
#pragma unroll
            for (int m = 0; m < 4; ++m) { const size_t off = (size_t)(rloc + ai * HALF + m * 16) * DM + col0;
#pragma unroll
                for (int bj = 0; bj < 2; ++bj)
#pragma unroll
                    for (int x = 0; x < 2; ++x) r[m][bj][x] = *(const f32x4*)(rb + off + bj * HALF + (size_t)x * DM); }
#pragma unroll
            for (int m = 0; m < 4; ++m) { const size_t off = (size_t)(rloc + ai * HALF + m * 16) * DM + col0;
#pragma unroll
                for (int bj = 0; bj < 2; ++bj) { const f32x4 a0 = acc[ai][bj][m][0], a1 = acc[ai][bj][m][1];
                    const f32x4 rcv = dpp_xor1(odd ? a0 : a1);
                    const f32x4 vx = odd ? rcv : a0, vy = odd ? a1 : rcv;
                    *(f32x4*)(ob + off + bj * HALF) = r[m][bj][0] + vx * alpha; *(f32x4*)(ob + off + bj * HALF + DM) = r[m][bj][1] + vy * alpha; } }
            asm volatile("" ::: "memory"); }
    }
};
struct EpiProjGate { static constexpr bool PERM = true, CHAIN = false; bf16_t* proj; bf16_t* gates; const float* bias;
    __device__ __forceinline__ void operator()(Acc& acc, const Unit& u, int wr, int wc, int fr, int fq) const {
        const int row0 = u.pm * BM + wr * 64 + fr; const bool isg = u.pn >= INW / BM;
        const int col0 = (isg ? (u.pn - INW / BM) * BM : u.pn * BM) + wc * 32 + 8 * fq;
        bf16_t* base = isg ? gates : proj; const int ldc = isg ? GATEW : INW;
        f32x4 bv[2][2];
#pragma unroll
        for (int bj = 0; bj < 2; ++bj)
#pragma unroll
            for (int n = 0; n < 2; ++n) bv[bj][n] = isg ? *(const f32x4*)(bias + col0 + bj * HALF + 4 * n) : (f32x4){0.f, 0.f, 0.f, 0.f};
#pragma unroll
        for (int ai = 0; ai < 2; ++ai)
#pragma unroll
            for (int m = 0; m < 4; ++m) { bf16_t* rowp = base + (size_t)(row0 + ai * HALF + m * 16) * ldc + col0;
#pragma unroll
                for (int bj = 0; bj < 2; ++bj) { f32x4 v0 = acc[ai][bj][m][0] + bv[bj][0], v1 = acc[ai][bj][m][1] + bv[bj][1];
                    if (isg) {
#pragma unroll
                        for (int j = 0; j < 4; ++j) { v0[j] = __builtin_amdgcn_rcpf(1.0f + __builtin_amdgcn_exp2f(v0[j] * -1.4426950408889634f)); v1[j] = __builtin_amdgcn_rcpf(1.0f + __builtin_amdgcn_exp2f(v1[j] * -1.4426950408889634f)); } }
                    u32x4 w; w.x = cvt_pk_bf16(v0[0], v0[1]); w.y = cvt_pk_bf16(v0[2], v0[3]); w.z = cvt_pk_bf16(v1[0], v1[1]); w.w = cvt_pk_bf16(v1[2], v1[3]);
                    *(u32x4*)(rowp + bj * HALF) = w; } }
    }
};
struct EpiBranch { static constexpr bool PERM = true, CHAIN = true; const bf16_t* gates; bf16_t* O;
    __device__ __forceinline__ void operator()(Acc& acc, const Unit& u, int wr, int wc, int fr, int fq) const {
        const int row0 = u.pm * BM + wr * 64 + fr, col0 = u.pn * BM + wc * 32 + 8 * fq; const int seg = u.seg;
        const int no = seg == 0 ? 0 : (seg == 1 ? DM : 2 * DM), dofs = seg == 2 ? 2 * DM : no + DM;
#pragma unroll
        for (int ai = 0; ai < 2; ++ai) {
            u32x4 gn[4][2], gd[4][2];
#pragma unroll
            for (int m = 0; m < 4; ++m)
#pragma unroll
                for (int bj = 0; bj < 2; ++bj) { const bf16_t* gp = gates + (size_t)(row0 + ai * HALF + m * 16) * GATEW + col0 + bj * HALF;
                    gn[m][bj] = *(const u32x4*)(gp + no); if (seg != 2) gd[m][bj] = *(const u32x4*)(gp + dofs); else gd[m][bj] = (u32x4){0u, 0u, 0u, 0u}; }
#pragma unroll
            for (int m = 0; m < 4; ++m) { const size_t row = (size_t)(row0 + ai * HALF + m * 16);
#pragma unroll
                for (int bj = 0; bj < 2; ++bj) { const u32x4 a = gn[m][bj]; float s[8];
                    s[0] = bf_lo(a.x); s[1] = bf_hi(a.x); s[2] = bf_lo(a.y); s[3] = bf_hi(a.y); s[4] = bf_lo(a.z); s[5] = bf_hi(a.z); s[6] = bf_lo(a.w); s[7] = bf_hi(a.w);
                    if (seg != 2) { const u32x4 b = gd[m][bj]; float d[8];
                        d[0] = bf_lo(b.x); d[1] = bf_hi(b.x); d[2] = bf_lo(b.y); d[3] = bf_hi(b.y); d[4] = bf_lo(b.z); d[5] = bf_hi(b.z); d[6] = bf_lo(b.w); d[7] = bf_hi(b.w);
#pragma unroll
                        for (int j = 0; j < 8; ++j) s[j] = s[j] * __builtin_amdgcn_rcpf(fmaxf(d[j], 1e-30f));
                    }
#pragma unroll
                    for (int j = 0; j < 4; ++j) { acc[ai][bj][m][0][j] *= s[j]; acc[ai][bj][m][1][j] *= s[4 + j]; }
                    if (seg == 2) { const f32x4 v0 = acc[ai][bj][m][0], v1 = acc[ai][bj][m][1];
                        u32x4 w; w.x = cvt_pk_bf16(v0[0], v0[1]); w.y = cvt_pk_bf16(v0[2], v0[3]); w.z = cvt_pk_bf16(v1[0], v1[1]); w.w = cvt_pk_bf16(v1[2], v1[3]);
                        *(u32x4*)(O + row * DM + col0 + bj * HALF) = w; } } }
            asm volatile("" ::: "memory"); }
    }
};

template <class Epi, class Sched>
__device__ __forceinline__ void gemm_phase(LAS unsigned char* lds, const bf16_t* Ag, const bf16_t* Btg, const int Kp, const Sched& S, const Epi& E) {
    int tid = threadIdx.x; asm volatile("" : "+v"(tid));
    const int wid = __builtin_amdgcn_readfirstlane(tid >> 6), lane = tid & 63, wr = wid >> 2, wc = wid & 3, fr = lane & 15, fq = lane >> 4;
    unsigned voffA[2], voffB[2];
#pragma unroll
    for (int i = 0; i < 2; ++i) { int R, C; stage_rc(tid * 16 + i * 8192, R, C); const int Rb = Epi::PERM ? ((R & ~31) + perm32(R & 31)) : R;
        voffA[i] = (unsigned)(R * Kp + C) * 2u; voffB[i] = (unsigned)(Rb * Kp + C) * 2u; }
    const size_t kstep = (size_t)(BK * 2);
    const size_t hstep = (size_t)HALF * Kp * 2;
    const size_t tstep = 2 * hstep;
    const unsigned ldsw = (unsigned)wid * 1024u;
    const int aoff = lds_byte(wr * 64 + fr, fq * 8), boff = lds_byte(wc * 32 + fr, fq * 8);
#define PG8_SA(b, h) (((b) * 2 + (h)) * HTB)
#define PG8_SB(b, h) ((4 + (b) * 2 + (h)) * HTB)
#define PG8_STAGE(bufoff, gbase, voff) do { _Pragma("unroll") for (int _i = 0; _i < 2; ++_i) \
        __builtin_amdgcn_global_load_lds((const unsigned*)((const char*)(gbase) + (voff)[_i]), (LAS unsigned*)(lds + (bufoff) + ldsw + _i * 8192), 16, 0, 0); } while (0)
#define PG8_LDA(dst, b, h) do { _Pragma("unroll") for (int m = 0; m < 4; ++m) _Pragma("unroll") for (int k = 0; k < 2; ++k) dst[m][k] = *(const LAS bf16x8*)(lds + PG8_SA(b, h) + aoff + m * 2048 + k * 1024); } while (0)
#define PG8_LDB(dst, b, h) do { _Pragma("unroll") for (int n = 0; n < 2; ++n) _Pragma("unroll") for (int k = 0; k < 2; ++k) dst[n][k] = *(const LAS bf16x8*)(lds + PG8_SB(b, h) + boff + n * 2048 + k * 1024); } while (0)
#define PG8_MMA(ai, bj, At, Bt) do { __builtin_amdgcn_s_setprio(1); _Pragma("unroll") for (int m = 0; m < 4; ++m) _Pragma("unroll") for (int n = 0; n < 2; ++n) _Pragma("unroll") for (int k = 0; k < 2; ++k) \
        acc[ai][bj][m][n] = __builtin_amdgcn_mfma_f32_16x16x32_bf16(Bt[n][k], At[m][k], acc[ai][bj][m][n], 0, 0, 0); __builtin_amdgcn_s_setprio(0); } while (0)
#define PG8_WAIT_V(n) asm volatile("s_waitcnt vmcnt(" #n ")" ::: "memory")
#define PG8_WAIT_L(n) asm volatile("s_waitcnt lgkmcnt(" #n ")" ::: "memory")
#define PG8_BAR __builtin_amdgcn_s_barrier()
#define PG8_SCHED __builtin_amdgcn_sched_barrier(0)
    Unit cur, nxt; int ui = 0;
    if (!S.next(0, cur)) return;
    Acc acc;
#pragma unroll
    for (int a = 0; a < 2; ++a)
#pragma unroll
        for (int b = 0; b < 2; ++b)
#pragma unroll
            for (int m = 0; m < 4; ++m)
#pragma unroll
                for (int n = 0; n < 2; ++n) acc[a][b][m][n] = (f32x4){0.f, 0.f, 0.f, 0.f};
    bf16x8 At[4][2], B0[2][2], B1[2][2];
    const char* cA = (const char*)Ag + (size_t)cur.pm * tstep + (size_t)cur.k0 * 2; const char* cB = (const char*)Btg + (size_t)cur.pn * tstep + (size_t)cur.k0 * 2;
    PG8_STAGE(PG8_SB(0, 0), cB, voffB); PG8_STAGE(PG8_SB(0, 1), cB + hstep, voffB); PG8_STAGE(PG8_SA(0, 0), cA, voffA); PG8_STAGE(PG8_SA(0, 1), cA + hstep, voffA);
    if (wr == 1) PG8_BAR;
    PG8_WAIT_V(2); PG8_BAR;
    PG8_STAGE(PG8_SB(1, 0), cB + kstep, voffB); PG8_STAGE(PG8_SA(1, 0), cA + kstep, voffA); PG8_STAGE(PG8_SB(1, 1), cB + hstep + kstep, voffB);
    PG8_WAIT_V(6); PG8_BAR;
    for (;;) {
        const bool has_next = S.next(ui + 1, nxt);
        const char* nA = has_next ? (const char*)Ag + (size_t)nxt.pm * tstep + (size_t)nxt.k0 * 2 : cA; const char* nB = has_next ? (const char*)Btg + (size_t)nxt.pn * tstep + (size_t)nxt.k0 * 2 : cB;
        const int nt = cur.nt;
        for (int t = 0; t < nt; t += 2) {
            const bool last = (t == nt - 2);
            const char* a1 = cA + (size_t)(t + 1) * kstep;
            const char* a2 = last ? nA : cA + (size_t)(t + 2) * kstep; const char* b2 = last ? nB : cB + (size_t)(t + 2) * kstep;
            const char* a3 = a2 + kstep; const char* b3 = b2 + kstep;
            PG8_LDB(B0, 0, 0); PG8_LDB(B1, 0, 1); PG8_SCHED; PG8_LDA(At, 0, 0); PG8_STAGE(PG8_SA(1, 1), a1 + hstep, voffA);
            PG8_WAIT_V(8); PG8_WAIT_L(0); PG8_BAR; PG8_MMA(0, 0, At, B0); PG8_MMA(0, 1, At, B1); PG8_BAR; PG8_SCHED;
            PG8_LDA(At, 0, 1); PG8_STAGE(PG8_SB(0, 0), b2, voffB); PG8_STAGE(PG8_SB(0, 1), b2 + hstep, voffB); PG8_STAGE(PG8_SA(0, 0), a2, voffA);
            PG8_WAIT_V(8); PG8_WAIT_L(0); PG8_BAR; PG8_MMA(1, 0, At, B0); PG8_MMA(1, 1, At, B1); PG8_BAR; PG8_SCHED;
            PG8_LDB(B0, 1, 0); PG8_LDB(B1, 1, 1); PG8_SCHED; PG8_LDA(At, 1, 0); PG8_STAGE(PG8_SA(0, 1), a2 + hstep, voffA);
            PG8_WAIT_V(8); PG8_WAIT_L(0); PG8_BAR; PG8_MMA(0, 0, At, B0); PG8_MMA(0, 1, At, B1); PG8_BAR; PG8_SCHED;
            PG8_LDA(At, 1, 1); PG8_STAGE(PG8_SB(1, 0), b3, voffB); PG8_STAGE(PG8_SB(1, 1), b3 + hstep, voffB); PG8_STAGE(PG8_SA(1, 0), a3, voffA);
            PG8_WAIT_V(8); PG8_WAIT_L(0); PG8_BAR; PG8_MMA(1, 0, At, B0); PG8_MMA(1, 1, At, B1); PG8_BAR; PG8_SCHED;
        }
        if (wr == 0) PG8_BAR;
        E(acc, cur, wr, wc, fr, fq);
        if (!has_next) break;
        if (!Epi::CHAIN || cur.seg == 2) {
#pragma unroll
            for (int a = 0; a < 2; ++a)
#pragma unroll
                for (int b = 0; b < 2; ++b)
#pragma unroll
                    for (int m = 0; m < 4; ++m)
#pragma unroll
                        for (int n = 0; n < 2; ++n) acc[a][b][m][n] = (f32x4){0.f, 0.f, 0.f, 0.f};
        }
        cur = nxt; cA = nA; cB = nB; ++ui;
        if (wr == 1) PG8_BAR;
    }
    PG8_WAIT_V(0);
    PG8_BAR;
#undef PG8_SA
#undef PG8_SB
#undef PG8_STAGE
#undef PG8_LDA
#undef PG8_LDB
#undef PG8_MMA
#undef PG8_WAIT_V
#undef PG8_WAIT_L
#undef PG8_BAR
#undef PG8_SCHED
}
}

namespace att {
constexpr int D = 128, NW = 8, QBLK = 32, KVBLK = 64;
constexpr float SCALE = 0.088388347648318440f;
constexpr float THR = 8.f;
constexpr size_t SHM_V = KVBLK * D * 2, SHM_K = KVBLK * D * 2, SHM_ATTN = 2 * SHM_V + 2 * SHM_K + NW * 64 * 4;
#define KSWZ(row, colB) ((row) * 256 + ((colB) ^ (((row) & 7) << 4)))
#define SBAR() __builtin_amdgcn_sched_barrier(0)
__device__ __forceinline__ int crow(int r, int hi) { return (r & 3) + 8 * (r >> 2) + 4 * hi; }
__device__ __forceinline__ unsigned cvtpk(float lo, float hi) { unsigned r; asm volatile("v_cvt_pk_bf16_f32 %0, %1, %2" : "=v"(r) : "v"(lo), "v"(hi)); return r; }

__device__ __forceinline__ void partialSM(f32x16& p0, f32x16& p1, float& m_reg, float& mn, float& alpha) {
  constexpr float C = SCALE * 1.4426950408889634f;
  float pmax = p0[0];
#pragma unroll
  for (int r = 1; r < 16; ++r) pmax = fmaxf(pmax, p0[r]);
#pragma unroll
  for (int r = 0; r < 16; ++r) pmax = fmaxf(pmax, p1[r]);
  { auto rr = __builtin_amdgcn_permlane32_swap(__float_as_uint(pmax), __float_as_uint(pmax), false, false);
    pmax = fmaxf(__uint_as_float(rr[0]), __uint_as_float(rr[1])); }
  if (__builtin_expect(__all(pmax - m_reg <= THR / SCALE), 1)) { mn = m_reg; alpha = 1.f; }
  else { mn = fmaxf(m_reg, pmax); alpha = __builtin_amdgcn_exp2f((m_reg - mn) * C); m_reg = mn; }
  float mnC = -mn * C;
#pragma unroll
  for (int r = 0; r < 16; ++r) p0[r] = fmaf(p0[r], C, mnC);
#pragma unroll
  for (int r = 0; r < 16; ++r) p1[r] = fmaf(p1[r], C, mnC);
#pragma unroll
  for (int r = 0; r < 16; ++r) p0[r] = __builtin_amdgcn_exp2f(p0[r]);
}
__device__ __forceinline__ void finishSM(f32x16& p0, f32x16& p1, float alpha, float& l_reg, bf16x8& pa0, bf16x8& pa1, bf16x8& pa2, bf16x8& pa3) {
#pragma unroll
  for (int r = 0; r < 16; ++r) p1[r] = __builtin_amdgcn_exp2f(p1[r]);
  float ps = 0;
#pragma unroll
  for (int r = 0; r < 16; ++r) ps += p0[r];
#pragma unroll
  for (int r = 0; r < 16; ++r) ps += p1[r];
  { auto rr = __builtin_amdgcn_permlane32_swap(__float_as_uint(ps), __float_as_uint(ps), false, false);
    ps = __uint_as_float(rr[0]) + __uint_as_float(rr[1]); }
  l_reg = l_reg * alpha + ps;
#define PK4(P, BASE, OUT) do { unsigned a0 = cvtpk(P[BASE + 0], P[BASE + 1]), a1 = cvtpk(P[BASE + 2], P[BASE + 3]);   \
    unsigned b0 = cvtpk(P[BASE + 4], P[BASE + 5]), b1 = cvtpk(P[BASE + 6], P[BASE + 7]);                              \
    auto r0 = __builtin_amdgcn_permlane32_swap(a0, b0, false, false); auto r1 = __builtin_amdgcn_permlane32_swap(a1, b1, false, false); \
    u32x4 w = {r0[0], r1[0], r0[1], r1[1]}; OUT = *reinterpret_cast<bf16x8*>(&w); } while (0)
  PK4(p0, 0, pa0); PK4(p0, 8, pa1); PK4(p1, 0, pa2); PK4(p1, 8, pa3);
#undef PK4
}
__device__ __forceinline__ void qkt(f32x16& p0, f32x16& p1, const char* Ks, const bf16x8* qr, int r32, int hi) {
  p0 = f32x16{}; p1 = f32x16{};
#pragma unroll
  for (int d0 = 0; d0 < 8; ++d0) { int cb = (d0 * 16 + hi * 8) * 2;
    bf16x8 b0 = *reinterpret_cast<const bf16x8*>(Ks + KSWZ(r32, cb));
    bf16x8 b1 = *reinterpret_cast<const bf16x8*>(Ks + KSWZ(32 + r32, cb));
    p0 = __builtin_amdgcn_mfma_f32_32x32x16_bf16(b0, qr[d0], p0, 0, 0, 0);
    p1 = __builtin_amdgcn_mfma_f32_32x32x16_bf16(b1, qr[d0], p1, 0, 0, 0); }
}
__device__ __forceinline__ int v_st(int k, int c) { const int kk = (k & ~0xC) | ((k & 4) << 1) | ((k & 8) >> 1); return ((kk >> 3) * 4 + (c >> 5)) * 512 + ((kk & 7) * 32 + (c & 31)) * 2; }
__device__ __forceinline__ int v_rd_base(int lane) { return ((lane & 3) << 3) | (((lane >> 2) & 3) << 6) | (((lane >> 4) & 1) << 5) | (((lane >> 5) & 1) << 8); }
constexpr int v_rd_off(int d0, int ks, int half) { return d0 * 512 + ks * 4096 + half * 2048; }
template <int OFF> __device__ __forceinline__ s16x4 tr_read(int vb) {
  s16x4 r; asm volatile("ds_read_b64_tr_b16 %0, %1 offset:%2" : "=&v"(r) : "v"(vb), "i"(OFF) : "memory"); return r;
}
template <int D0> __device__ __forceinline__ void pv_one(f32x16& od, int vb, bf16x8 pa0, bf16x8 pa1, bf16x8 pa2, bf16x8 pa3) {
  const s16x4 l0 = tr_read<v_rd_off(D0, 0, 0)>(vb), h0 = tr_read<v_rd_off(D0, 0, 1)>(vb), l1 = tr_read<v_rd_off(D0, 1, 0)>(vb), h1 = tr_read<v_rd_off(D0, 1, 1)>(vb);
  const s16x4 l2 = tr_read<v_rd_off(D0, 2, 0)>(vb), h2 = tr_read<v_rd_off(D0, 2, 1)>(vb), l3 = tr_read<v_rd_off(D0, 3, 0)>(vb), h3 = tr_read<v_rd_off(D0, 3, 1)>(vb);
  asm volatile("s_waitcnt lgkmcnt(0)" ::: "memory"); SBAR();
#define PK(L, H) (bf16x8){L[0], L[1], L[2], L[3], H[0], H[1], H[2], H[3]}
  od = __builtin_amdgcn_mfma_f32_32x32x16_bf16(pa0, PK(l0, h0), od, 0, 0, 0);
  od = __builtin_amdgcn_mfma_f32_32x32x16_bf16(pa1, PK(l1, h1), od, 0, 0, 0);
  od = __builtin_amdgcn_mfma_f32_32x32x16_bf16(pa2, PK(l2, h2), od, 0, 0, 0);
  od = __builtin_amdgcn_mfma_f32_32x32x16_bf16(pa3, PK(l3, h3), od, 0, 0, 0);
#undef PK
}
__device__ __forceinline__ void pv_d0(f32x16* o, int vb, bf16x8 pa0, bf16x8 pa1, bf16x8 pa2, bf16x8 pa3) {
  pv_one<0>(o[0], vb, pa0, pa1, pa2, pa3); pv_one<1>(o[1], vb, pa0, pa1, pa2, pa3); pv_one<2>(o[2], vb, pa0, pa1, pa2, pa3); pv_one<3>(o[3], vb, pa0, pa1, pa2, pa3);
}
__device__ __forceinline__ void bmask(f32x16& p0, f32x16& p1, int dq0, int kj0, int hw, int L) {
  const float ninf = -__builtin_inff();
#pragma unroll
  for (int r = 0; r < 16; ++r) { const int c = (r & 3) + 8 * (r >> 2);
    const bool ok0 = ((unsigned)(dq0 + c + hw) <= (unsigned)(2 * hw)) && ((unsigned)(kj0 + c) < (unsigned)L);
    const bool ok1 = ((unsigned)(dq0 + c + 32 + hw) <= (unsigned)(2 * hw)) && ((unsigned)(kj0 + c + 32) < (unsigned)L);
    p0[r] = ok0 ? p0[r] : ninf; p1[r] = ok1 ? p1[r] : ninf; }
}
struct Band { int i0, L, hw, tlo; float m0, l0; float* lse; long lse_ld; };

template <bool BAND>
__device__ __forceinline__ void attn_body(const bf16_t* __restrict__ Qb, const bf16_t* __restrict__ Kh, const bf16_t* __restrict__ Vh, bf16_t* __restrict__ Ob,
                                          const long ldq, const long ldk, const long ldo, const int NT, const Band bd, char* lds) {
  int tid = threadIdx.x; asm volatile("" : "+v"(tid));
  const int wid = tid >> 6, lane = tid & 63, r32 = lane & 31, hi = lane >> 5;
  char* V_lds = lds; char* K_lds = lds + 2 * SHM_V;
  float* ws = (float*)(lds + 2 * SHM_V + 2 * SHM_K) + wid * 64; float* li_l = ws; float* al_l = ws + 32;
  float m_reg = BAND ? bd.m0 : -1e30f, l_reg = BAND ? bd.l0 : 0.f; f32x16 o[4] = {}; bf16x8 qr[8];
  const bf16_t* Qw = Qb + (long)(wid * QBLK + r32) * ldq + hi * 8;
#pragma unroll
  for (int d0 = 0; d0 < 8; ++d0) qr[d0] = *reinterpret_cast<const bf16x8*>(Qw + d0 * 16);
  const int sr = tid >> 4, sc = (tid & 15) * 8, vst0 = v_st(sr, sc), vst1 = v_st(32 + sr, sc);
  const int vb0 = (int)(uintptr_t)V_lds + v_rd_base(lane);
  const int qi = BAND ? bd.i0 + wid * QBLK + r32 : 0;
  struct { bf16x8 vs0, vs1, ks0, ks1; } sr_[2];
#define KROW(k) (BAND ? (long)min(max((k), 0), bd.L - 1) : (long)(k))
#define SLOAD(i, jt) do { const int k0_ = (BAND ? bd.tlo + (jt) : (jt)) * KVBLK; const long ra_ = KROW(k0_ + sr) * ldk + sc, rb_ = KROW(k0_ + 32 + sr) * ldk + sc; \
    sr_[i].vs0 = *reinterpret_cast<const bf16x8*>(Vh + ra_); sr_[i].vs1 = *reinterpret_cast<const bf16x8*>(Vh + rb_); \
    sr_[i].ks0 = *reinterpret_cast<const bf16x8*>(Kh + ra_); sr_[i].ks1 = *reinterpret_cast<const bf16x8*>(Kh + rb_); } while (0)
#define SWRITE(b, i) do { *(bf16x8*)(V_lds + (b) * SHM_V + vst0) = sr_[i].vs0;          \
    *(bf16x8*)(V_lds + (b) * SHM_V + vst1) = sr_[i].vs1; int kc = sc * 2;               \
    *(bf16x8*)(K_lds + (b) * SHM_K + KSWZ(sr, kc)) = sr_[i].ks0;                       \
    *(bf16x8*)(K_lds + (b) * SHM_K + KSWZ(32 + sr, kc)) = sr_[i].ks1; } while (0)
#define SWAIT() asm volatile("s_waitcnt vmcnt(4)" ::: "memory")
#define RESC(a) do { if (__any((a) < 1.f)) { if (hi == 0) al_l[r32] = (a); asm volatile("s_waitcnt lgkmcnt(0)" ::: "memory"); \
    _Pragma("unroll") for (int d = 0; d < 4; ++d) _Pragma("unroll") for (int r = 0; r < 16; ++r) o[d][r] *= al_l[crow(r, hi)]; } } while (0)
#define BMASK(P0, P1, jt) do { if (BAND) { const int kt_ = (bd.tlo + (jt)) * KVBLK + 4 * hi; bmask(P0, P1, kt_ - qi, kt_, bd.hw, bd.L); } } while (0)
  f32x16 pA0, pA1, pB0, pB1; float mnA, mnB, alA, alB; bf16x8 pa0, pa1, pa2, pa3;
  constexpr int SE = 0, SO = 1;
  SLOAD(SE, 0); asm volatile("s_waitcnt vmcnt(0)" ::: "memory"); SWRITE(0, SE); __syncthreads();
  qkt(pA0, pA1, K_lds, qr, r32, hi); BMASK(pA0, pA1, 0); partialSM(pA0, pA1, m_reg, mnA, alA);
  SLOAD(SO, 1); if (2 < NT) SLOAD(SE, 2);
  SWAIT(); SWRITE(1, SO); __syncthreads();
  for (int j = 1; j + 1 < NT; j += 2) {
    SBAR(); qkt(pB0, pB1, K_lds + SHM_K, qr, r32, hi);
    finishSM(pA0, pA1, alA, l_reg, pa0, pa1, pa2, pa3); SBAR();
    SLOAD(SO, j + 2); SBAR();
    pv_d0(o, vb0, pa0, pa1, pa2, pa3); BMASK(pB0, pB1, j); partialSM(pB0, pB1, m_reg, mnB, alB);
    __syncthreads(); SWAIT(); SWRITE(0, SE);
    RESC(alB); __syncthreads();
    SBAR(); qkt(pA0, pA1, K_lds, qr, r32, hi);
    finishSM(pB0, pB1, alB, l_reg, pa0, pa1, pa2, pa3); SBAR();
    if (j + 3 < NT) SLOAD(SE, j + 3); SBAR();
    pv_d0(o, vb0 + (int)SHM_V, pa0, pa1, pa2, pa3); BMASK(pA0, pA1, j + 1); partialSM(pA0, pA1, m_reg, mnA, alA);
    __syncthreads(); SWAIT(); SWRITE(1, SO);
    RESC(alA); __syncthreads();
  }
  SBAR(); qkt(pB0, pB1, K_lds + SHM_K, qr, r32, hi);
  finishSM(pA0, pA1, alA, l_reg, pa0, pa1, pa2, pa3); SBAR();
  pv_d0(o, vb0, pa0, pa1, pa2, pa3); BMASK(pB0, pB1, NT - 1); partialSM(pB0, pB1, m_reg, mnB, alB);
  __syncthreads(); RESC(alB);
  finishSM(pB0, pB1, alB, l_reg, pa0, pa1, pa2, pa3); SBAR();
  pv_d0(o, vb0 + (int)SHM_V, pa0, pa1, pa2, pa3);
  if (hi == 0) li_l[r32] = l_reg; asm volatile("s_waitcnt lgkmcnt(0)" ::: "memory");
  float rli[16];
#pragma unroll
  for (int r = 0; r < 16; ++r) rli[r] = __builtin_amdgcn_rcpf(li_l[crow(r, hi)]);
  bf16_t* Ow = Ob + (long)(wid * QBLK) * ldo;
  const int odd = lane & 1;
#pragma unroll
  for (int r = 0; r < 16; r += 2) { const long orow = crow(r, hi) + odd;
#pragma unroll
    for (int d0 = 0; d0 < 4; ++d0) { const float a = o[d0][r] * rli[r], b = o[d0][r + 1] * rli[r + 1];
      const float snd = odd ? a : b;
      const float rcv = __int_as_float(__builtin_amdgcn_mov_dpp(__float_as_int(snd), 0xB1, 0xF, 0xF, true));
      const unsigned pk = odd ? cvtpk(rcv, b) : cvtpk(a, rcv);
      *(unsigned*)(Ow + orow * ldo + d0 * 32 + (r32 & ~1)) = pk; } }
  if (BAND) { if (bd.lse != nullptr && hi == 0) bd.lse[(long)(wid * QBLK + r32) * bd.lse_ld] = m_reg * SCALE + __logf(l_reg); }
  __syncthreads();
#undef KROW
#undef SLOAD
#undef SWRITE
#undef SWAIT
#undef RESC
#undef BMASK
}
}

constexpr size_t MiB = 1u << 20;
constexpr size_t WS_CTL = 0, CTL_ZERO_BYTES = 1 * MiB;
constexpr size_t WS_ROPE = 1 * MiB;
constexpr size_t WS_ROPEX = 9 * MiB;
constexpr size_t WS_LSE = 10 * MiB;
constexpr size_t WS_W = 12 * MiB;
constexpr size_t WO_F1IN = 0, WO_F1OUT = WO_F1IN + (size_t)NFF2 * DM * 2, WO_PG = WO_F1OUT + (size_t)DM * DFF * 2, WO_BR = WO_PG + (size_t)PGW * DM * 2,
                 WO_WO = WO_BR + (size_t)DM * DM * 2, WO_F2IN = WO_WO + (size_t)DM * DM * 2, WO_F2OUT = WO_F2IN + (size_t)NFF2 * DM * 2, W_BYTES = WO_F2OUT + (size_t)DM * DFF * 2;
constexpr size_t WS_U = WS_W + ((W_BYTES + MiB - 1) / MiB) * MiB;
constexpr size_t WS_Y = WS_U + (size_t)M * DM * 2;
constexpr size_t WS_BIG = WS_Y + (size_t)M * DM * 2;
constexpr size_t WS_PROJ = WS_BIG, WS_GATES = WS_BIG + (size_t)M * INW * 2;
constexpr size_t WS_END = WS_GATES + (size_t)M * GATEW * 2;
static_assert((size_t)M * DFF * 2 <= WS_END - WS_BIG, "act fits the overlay");
constexpr int CW_BAR = 4096;

constexpr int RING_OFF = 0, RING_BYTES = 131072;
constexpr int LDSCTL_OFF = RING_BYTES, MISC_OFF = LDSCTL_OFF + 320;
constexpr int LDS_BYTES = 147456;
constexpr int NWAVES = 8;

typedef GAS unsigned gu32;
#define RLX_AGENT __ATOMIC_RELAXED, __HIP_MEMORY_SCOPE_AGENT
#define LDS_WAIT() asm volatile("s_waitcnt lgkmcnt(0)" ::: "memory")

#define XB_TMO      128
#define XB_XCNT(j)  (256  + 64 * (j))
#define XB_XSUB(j)  (1280 + 64 * (j))
#define XB_XGEN(j)  (2304 + 64 * (j))
#define XB_TOP      3328
#define XB_TOPGEN   3392
#define XCD_BAR_WORDS 3456
#define XB_SPIN_CAP (1u << 22)
__device__ __forceinline__ unsigned xb_ld(unsigned* p)              { return __hip_atomic_load(p, __ATOMIC_RELAXED, __HIP_MEMORY_SCOPE_AGENT); }
__device__ __forceinline__ unsigned xb_add(unsigned* p, unsigned v) { return __hip_atomic_fetch_add(p, v, __ATOMIC_RELAXED, __HIP_MEMORY_SCOPE_AGENT); }
__device__ __forceinline__ unsigned xb_xcc_id() { return (unsigned)__builtin_amdgcn_s_getreg((3 << 11) | 20) & 0xFu; }
#define XB_SPIN(cond, bar) do { unsigned _sp = 0; while (cond) { __builtin_amdgcn_s_sleep(1); \
    if ((++_sp & 255u) == 0u) { if (xb_ld(&(bar)[XB_TMO])) break; if (_sp > XB_SPIN_CAP) { atomicAdd(&(bar)[XB_TMO], 1u); break; } } } } while (0)
struct XcdBarrier { unsigned* bar; unsigned x; volatile LAS unsigned* st; };
__device__ __forceinline__ XcdBarrier xcd_barrier_post(unsigned* bar, volatile LAS unsigned* st) {
    XcdBarrier b; b.bar = bar; b.x = xb_xcc_id(); b.st = st;
    if (threadIdx.x == 0) (void)xb_add(&bar[XB_XCNT(b.x)], 1u);
    return b;
}
__device__ __forceinline__ void xcd_barrier_complete(unsigned* bar, unsigned x, unsigned& nloc, unsigned& nx) {
    const unsigned G = gridDim.x * gridDim.y * gridDim.z;
    unsigned sum, cnt, mine, sp = 0u;
    for (;;) {
        sum = 0u; cnt = 0u; mine = 0u;
#pragma unroll
        for (unsigned j = 0; j < 16; ++j) { const unsigned c = xb_ld(&bar[XB_XCNT(j)]); sum += c; cnt += (c > 0u) ? 1u : 0u; mine = (j == x) ? c : mine; }
        if (sum == G) break;
        __builtin_amdgcn_s_sleep(1);
        if ((++sp & 255u) == 0u) { if (xb_ld(&bar[XB_TMO])) break; if (sp > XB_SPIN_CAP) { atomicAdd(&bar[XB_TMO], 1u); break; } }
    }
    nloc = mine > 0u ? mine : 1u; nx = cnt > 0u ? cnt : 1u;
}
__device__ __forceinline__ void xcd_barrier(const XcdBarrier& b) {
    asm volatile("s_waitcnt vmcnt(0)" ::: "memory");
    __syncthreads();
    if (threadIdx.x == 0) {
        unsigned* bar = b.bar;
        __builtin_amdgcn_s_waitcnt(0);
        unsigned nloc = b.st[0], nx = b.st[1];
        if (nloc == 0u) { xcd_barrier_complete(bar, b.x, nloc, nx); b.st[0] = nloc; b.st[1] = nx; }
        const unsigned old = xb_add(&bar[XB_XSUB(b.x)], 1u);
        const unsigned gen = old / nloc;
        if (old + 1u == (gen + 1u) * nloc) {
            __builtin_amdgcn_fence(__ATOMIC_RELEASE, "agent");
            asm volatile("s_waitcnt vmcnt(0)" ::: "memory");
            const unsigned og = xb_add(&bar[XB_TOP], 1u);
            const unsigned tg = og / nx;
            if (og + 1u == (tg + 1u) * nx) xb_add(&bar[XB_TOPGEN], 1u);
            else XB_SPIN(xb_ld(&bar[XB_TOPGEN]) == tg, bar);
            __builtin_amdgcn_fence(__ATOMIC_ACQUIRE, "agent");
            xb_add(&bar[XB_XGEN(b.x)], 1u);
            asm volatile("s_waitcnt vmcnt(0)" ::: "memory");
        } else {
            XB_SPIN(xb_ld(&bar[XB_XGEN(b.x)]) == gen, bar);
            __builtin_amdgcn_fence(__ATOMIC_ACQUIRE, "agent");
            asm volatile("s_waitcnt vmcnt(0)" ::: "memory");
        }
    }
    __syncthreads();
}

__device__ __forceinline__ float wave_sum(float v) {
#pragma unroll
    for (int o = 1; o < 64; o <<= 1) v += __shfl_xor(v, o);
    return v;
}
__device__ __forceinline__ void transpose_item(const float* W, int K, int N, bf16_t* WT, int k0, int n0, int drow, LAS float* scr, int lane) {
#pragma unroll 8
    for (int i = 0; i < 32; ++i) { const int kk = 2 * i + (lane >> 5); scr[kk * 33 + (lane & 31)] = W[(size_t)(k0 + kk) * N + n0 + (lane & 31)]; }
    LDS_WAIT(); asm volatile("" ::: "memory");
    const int c = lane & 7;
#pragma unroll
    for (int j = 0; j < 4; ++j) { const int n = (lane >> 3) + 8 * j; const LAS float* s = scr + (8 * c) * 33 + n;
        u32x4 o; o.x = pk2(s[0 * 33], s[1 * 33]); o.y = pk2(s[2 * 33], s[3 * 33]); o.z = pk2(s[4 * 33], s[5 * 33]); o.w = pk2(s[6 * 33], s[7 * 33]);
        *(GAS u32x4*)(WT + (size_t)(drow + n) * K + k0 + 8 * c) = o; }
    LDS_WAIT(); asm volatile("" ::: "memory");
}
__device__ __forceinline__ void sincos_d(double a, float& s, float& c) {
    const double q = rint(a * 0.63661977236758134308);
    double y = fma(-q, 1.5707963267948966192, a); y = fma(-q, 6.123233995736766e-17, y);
    const double y2 = y * y;
    double sp = 1.0 / 6227020800.0; sp = fma(sp, y2, -1.0 / 39916800.0); sp = fma(sp, y2, 1.0 / 362880.0); sp = fma(sp, y2, -1.0 / 5040.0); sp = fma(sp, y2, 1.0 / 120.0); sp = fma(sp, y2, -1.0 / 6.0); sp = fma(sp, y2, 1.0);
    const double sy = y * sp;
    double cp = -1.0 / 87178291200.0; cp = fma(cp, y2, 1.0 / 479001600.0); cp = fma(cp, y2, -1.0 / 3628800.0); cp = fma(cp, y2, 1.0 / 40320.0); cp = fma(cp, y2, -1.0 / 720.0); cp = fma(cp, y2, 1.0 / 24.0); cp = fma(cp, y2, -0.5); cp = fma(cp, y2, 1.0);
    const int k = (int)q & 3;
    const double ss = (k & 1) ? cp : sy, cc = (k & 1) ? sy : cp;
    s = (float)((k & 2) ? -ss : ss); c = (float)(((k + 1) & 2) ? -cc : cc);
}

struct Args { const float* in[18]; float* out; unsigned char* ws; int ph_lo, ph_hi; };
constexpr int PH_PER_STEP = 10, PH_FINAL = NSTEP * PH_PER_STEP, PH_END = PH_FINAL + 1;

__global__ void __launch_bounds__(NWAVES * 64, 2) fwd_kernel(Args args) {
    extern __shared__ __attribute__((aligned(16))) unsigned char lds[];
    LAS unsigned char* ldsl = (LAS unsigned char*)lds;
    volatile LAS unsigned* MISC = (volatile LAS unsigned*)(ldsl + MISC_OFF);
    const int G = gridDim.x; const int bx = blockIdx.x;
    const int vcu = (G % 8 == 0) ? (bx % 8) * (G / 8) + bx / 8 : bx;
    unsigned char* ws = args.ws;
    gu32* ctl = (gu32*)(ws + WS_CTL);
    for (int u = threadIdx.x; u < (LDS_BYTES - LDSCTL_OFF) / 4; u += NWAVES * 64) ((LAS unsigned*)(ldsl + LDSCTL_OFF))[u] = 0u;
    __syncthreads();
    const int lo = args.ph_lo, hi = args.ph_hi;
    const bool one_launch = (hi - lo) > 1;
    XcdBarrier bar; bar.bar = (unsigned*)(ctl + CW_BAR); bar.x = 0; bar.st = nullptr;
    if (one_launch) bar = xcd_barrier_post((unsigned*)(ctl + CW_BAR), MISC + 8);
    bool first = true;
#ifndef PH_MASK
#define PH_MASK 0xFFFF
#endif
#define PHASE_BEGIN(p) if (((PH_MASK >> ((p) == PH_FINAL ? 10 : (p) % PH_PER_STEP)) & 1) && lo <= (p) && (p) < hi) { if (!first) xcd_barrier(bar); first = false; \
    for (int rep_ = 0; rep_ <= ((REP_MASK >> ((p) == PH_FINAL ? 10 : (p) % PH_PER_STEP)) & 1); ++rep_) {
#define PHASE_END } }

    const float* xp = args.in[0]; const float* xs = args.in[1];
    float* out = args.out;
    f32x2* rope = (f32x2*)(ws + WS_ROPE); f32x2* ropex = (f32x2*)(ws + WS_ROPEX);
    float* lseb = (float*)(ws + WS_LSE);
    bf16_t* U = (bf16_t*)(ws + WS_U); bf16_t* Y = (bf16_t*)(ws + WS_Y);
    bf16_t* ACT = (bf16_t*)(ws + WS_BIG); bf16_t* PROJ = (bf16_t*)(ws + WS_PROJ); bf16_t* GATES = (bf16_t*)(ws + WS_GATES);
    bf16_t* Wb = (bf16_t*)(ws + WS_W);
    const int NGW = G * NWAVES;
#define LOCAL_IDS int tid = threadIdx.x; asm volatile("" : "+v"(tid)); const int lane = tid & 63, wave = __builtin_amdgcn_readfirstlane(tid >> 6), gw = vcu * NWAVES + wave; (void)lane; (void)gw;

    if (lo == 0) {
        int tid = threadIdx.x; asm volatile("" : "+v"(tid));
        const int gt = vcu * NWAVES * 64 + tid, NGT = G * NWAVES * 64;
        for (int e = gt; e < S_P * 64 + 256 * 32; e += NGT) {
            const bool ax = e >= S_P * 64; const int ee = ax ? e - S_P * 64 : e; const int pos = ax ? ee >> 5 : ee >> 6, i = ax ? ee & 31 : ee & 63;
            const double base = ax ? 0.7498942093324559 : 0.8659643233600653; double inv = 1.0; double bp = base; int ii = i;
            for (int b = 0; b < 6; ++b) { if (ii & 1) inv *= bp; bp *= bp; ii >>= 1; }
            float sn, cs; sincos_d((double)pos * inv, sn, cs);
            (ax ? ropex : rope)[ee] = (f32x2){cs, sn};
        }
    }
    for (int s = 0; s < NSTEP; ++s) {
        const int l = s >> 1, which = s & 1, pb = s * PH_PER_STEP;
        PHASE_BEGIN(pb + 0)
            LOCAL_IDS
            if (which == 0) {
                LAS float* scr = (LAS float*)(ldsl + RING_OFF + wave * 16384);
                constexpr int I_FIN = (DM / 64) * (NFF2 / 32), I_FOUT = (DFF / 64) * (DM / 32), I_IN = (DM / 64) * (INW / 32), I_GT = (DM / 64) * (GATEW / 32), I_SQ = (DM / 64) * (DM / 32);
                constexpr int NITEMS = 2 * I_FIN + 2 * I_FOUT + I_IN + I_GT + 2 * I_SQ;
                const float* w_f1in = args.in[3] + (size_t)l * DM * NFF2; const float* w_f1out = args.in[4] + (size_t)l * DFF * DM;
                const float* w_in = args.in[6] + (size_t)l * DM * INW; const float* w_br = args.in[10] + (size_t)l * DM * DM;
                const float* w_gt = args.in[11] + (size_t)l * DM * GATEW; const float* w_o = args.in[13] + (size_t)l * DM * DM;
                const float* w_f2in = args.in[15] + (size_t)l * DM * NFF2; const float* w_f2out = args.in[16] + (size_t)l * DFF * DM;
                for (int it = gw; it < NITEMS; it += NGW) {
                    int r = it;
                    if (r < 2 * I_FIN) { const bool sec = r >= I_FIN; if (sec) r -= I_FIN; const int nblk = NFF2 / 32, kb = r / nblk, nb = r % nblk, n0 = nb * 32;
                        const int half = n0 >= DFF ? 1 : 0, rem = n0 - half * DFF, drow = (rem >> 7) * 256 + half * 128 + (rem & 127);
                        transpose_item(sec ? w_f2in : w_f1in, DM, NFF2, (bf16_t*)((char*)Wb + (sec ? WO_F2IN : WO_F1IN)), kb * 64, n0, drow, scr, lane); continue; }
                    r -= 2 * I_FIN;
                    if (r < 2 * I_FOUT) { const bool sec = r >= I_FOUT; if (sec) r -= I_FOUT; const int nblk = DM / 32, kb = r / nblk, nb = r % nblk;
                        transpose_item(sec ? w_f2out : w_f1out, DFF, DM, (bf16_t*)((char*)Wb + (sec ? WO_F2OUT : WO_F1OUT)), kb * 64, nb * 32, nb * 32, scr, lane); continue; }
                    r -= 2 * I_FOUT;
                    if (r < I_IN) { const int nblk = INW / 32, kb = r / nblk, nb = r % nblk;
                        transpose_item(w_in, DM, INW, (bf16_t*)((char*)Wb + WO_PG), kb * 64, nb * 32, nb * 32, scr, lane); continue; }
                    r -= I_IN;
                    if (r < I_GT) { const int nblk = GATEW / 32, kb = r / nblk, nb = r % nblk;
                        transpose_item(w_gt, DM, GATEW, (bf16_t*)((char*)Wb + WO_PG), kb * 64, nb * 32, INW + nb * 32, scr, lane); continue; }
                    r -= I_GT;
                    { const bool sec = r >= I_SQ; if (sec) r -= I_SQ; const int nblk = DM / 32, kb = r / nblk, nb = r % nblk;
                        transpose_item(sec ? w_o : w_br, DM, DM, (bf16_t*)((char*)Wb + (sec ? WO_WO : WO_BR)), kb * 64, nb * 32, nb * 32, scr, lane); }
                }
            }
            {
                const float* g = (which == 0 ? args.in[2] : args.in[14]) + (size_t)l * DM;
                f32x4 gv[8];
#pragma unroll
                for (int j = 0; j < 8; ++j) gv[j] = ((const f32x4*)g)[lane + 64 * j];
                for (int m = gw; m < M; m += NGW) {
                    const float* xrow = (s == 0) ? (m < S_P ? xp + (size_t)m * DM : xs + (size_t)(m - S_P) * DM) : out + (size_t)m * DM;
                    const GAS f32x4* xr = (const GAS f32x4*)xrow + lane; f32x4 v[8]; float ss = 0.f;
#pragma unroll
                    for (int j = 0; j < 8; ++j) { v[j] = xr[64 * j]; ss += (v[j].x * v[j].x + v[j].y * v[j].y) + (v[j].z * v[j].z + v[j].w * v[j].w); }
                    const float rstd = 1.0f / sqrtf(wave_sum(ss) * (1.0f / DM) + NORM_EPS);
                    GAS u32x2* o8 = (GAS u32x2*)(U + (size_t)m * DM) + lane;
#pragma unroll
                    for (int j = 0; j < 8; ++j) { const f32x4 y = v[j] * rstd * gv[j]; o8[64 * j] = (u32x2){cvt_pk_bf16(y.x, y.y), cvt_pk_bf16(y.z, y.w)}; }
                }
            }
        PHASE_END
        PHASE_BEGIN(pb + 1)
            pg8::PlainSched S; S.so.init(M, NFF2, G, bx, 8); S.nt = DM / 64;
            pg8::EpiSwiglu E{ACT};
            pg8::gemm_phase<pg8::EpiSwiglu, pg8::PlainSched>(ldsl + RING_OFF, U, (const bf16_t*)((char*)Wb + (which ? WO_F2IN : WO_F1IN)), DM, S, E);
        PHASE_END
        PHASE_BEGIN(pb + 2)
            pg8::PlainSched S; S.so.init(M, DM, G, bx, 4); S.nt = DFF / 64;
            pg8::EpiResid E{s == 0 ? xp : out, s == 0 ? xs : out + (size_t)S_P * DM, S_P, out, rep_ == ((REP_MASK >> 2) & 1) ? 0.5f : 0.f, rep_ == ((REP_MASK >> 2) & 1) ? 0 : PROBE_MODE, (float*)(ws + WS_BIG)};
            pg8::gemm_phase<pg8::EpiResid, pg8::PlainSched>(ldsl + RING_OFF, ACT, (const bf16_t*)((char*)Wb + (which ? WO_F2OUT : WO_F1OUT)), DFF, S, E);
        PHASE_END
        if (which == 0) {
        PHASE_BEGIN(pb + 3)
            LOCAL_IDS
            const float* g = args.in[5] + (size_t)l * DM;
            f32x4 gv[8];
#pragma unroll
            for (int j = 0; j < 8; ++j) gv[j] = ((const f32x4*)g)[lane + 64 * j];
            for (int m = gw; m < M; m += NGW) {
                const GAS f32x4* xr = (const GAS f32x4*)(out + (size_t)m * DM) + lane; f32x4 v[8]; float ss = 0.f;
#pragma unroll
                for (int j = 0; j < 8; ++j) { v[j] = xr[64 * j]; ss += (v[j].x * v[j].x + v[j].y * v[j].y) + (v[j].z * v[j].z + v[j].w * v[j].w); }
                const float rstd = 1.0f / sqrtf(wave_sum(ss) * (1.0f / DM) + NORM_EPS);
                GAS u32x2* o8 = (GAS u32x2*)(U + (size_t)m * DM) + lane;
#pragma unroll
                for (int j = 0; j < 8; ++j) { const f32x4 y = v[j] * rstd * gv[j]; o8[64 * j] = (u32x2){cvt_pk_bf16(y.x, y.y), cvt_pk_bf16(y.z, y.w)}; }
            }
        PHASE_END
        PHASE_BEGIN(pb + 4)
            pg8::PlainSched S; S.so.init(M, PGW, G, bx, 8); S.nt = DM / 64;
            pg8::EpiProjGate E{PROJ, GATES, args.in[12] + (size_t)l * GATEW};
            pg8::gemm_phase<pg8::EpiProjGate, pg8::PlainSched>(ldsl + RING_OFF, U, (const bf16_t*)((char*)Wb + WO_PG), DM, S, E);
        PHASE_END
        PHASE_BEGIN(pb + 5)
            LOCAL_IDS
            const float* gq = args.in[8] + (size_t)l * 128; const float* gk = args.in[9] + (size_t)l * 128;
            const int e1x = (lane >> 5) * 64 + (lane & 31), e2x = e1x + 32;
            const float gq1 = gq[e1x], gq2 = gq[e2x], gk1 = gk[e1x], gk2 = gk[e2x];
            const float pz = rep_ == ((REP_MASK >> 5) & 1) ? 1.f : 0.f, pk = 1.f - pz;
            for (int m = gw; m < M; m += NGW) {
                const int pos = m < S_P ? m : (m & (S_S - 1));
                const f32x2 cs = rope[pos * 64 + lane];
                const int idx = (lane >> 5) ? (pos & 63) : (pos >> 6);
                const f32x2 cx = ropex[idx * 32 + (lane & 31)];
                bf16_t* row = PROJ + (size_t)m * INW;
#pragma unroll 6
                for (int hh = 0; hh < 18; ++hh) {
                    bf16_t* hp = row + (hh < 6 ? hh * 128 : COL_QB + (hh - 6) * 128);
                    const float x1 = __uint_as_float((unsigned)hp[lane] << 16), x2 = __uint_as_float((unsigned)hp[lane + 64] << 16);
                    hp[lane] = (bf16_t)f2bf(REP_MASK ? pk * x1 + pz * (x1 * cs.x - x2 * cs.y) : x1 * cs.x - x2 * cs.y); hp[lane + 64] = (bf16_t)f2bf(REP_MASK ? pk * x2 + pz * (x2 * cs.x + x1 * cs.y) : x2 * cs.x + x1 * cs.y);
                }
#pragma unroll 4
                for (int hh = 0; hh < 8; ++hh) {
                    bf16_t* hp = row + COL_QC + hh * 128;
                    const float x1 = __uint_as_float((unsigned)hp[e1x] << 16), x2 = __uint_as_float((unsigned)hp[e2x] << 16);
                    const float rstd = 1.0f / sqrtf(wave_sum(x1 * x1 + x2 * x2) * (1.0f / 128.0f) + NORM_EPS);
                    const float y1 = x1 * rstd * (hh < 6 ? gq1 : gk1), y2 = x2 * rstd * (hh < 6 ? gq2 : gk2);
                    hp[e1x] = (bf16_t)f2bf(REP_MASK ? pk * x1 + pz * (y1 * cx.x - y2 * cx.y) : y1 * cx.x - y2 * cx.y); hp[e2x] = (bf16_t)f2bf(REP_MASK ? pk * x2 + pz * (y2 * cx.x + y1 * cx.y) : y2 * cx.x + y1 * cx.y);
                }
            }
        PHASE_END
        PHASE_BEGIN(pb + 6)
            char* alds = (char*)lds + RING_OFF;
            att::Band nob{0, 0, 0, 0, -1e30f, 0.f, nullptr, 0};
            for (int v = vcu; v < 256; v += G) {
                const bool pr = v < 128;
                const int nun = pr ? 3 : 6, x = (v - 128) >> 5, qb = pr ? (v & 63) : (v & 31);
                for (int r6 = 0; r6 < nun; ++r6) {
                    const int pair = x * 2 + r6 / 3, sq = pair >> 1, kvh = pr ? (v >> 6) : (pair & 1), h = kvh * 3 + (r6 % 3);
                    const size_t sb = pr ? 0 : (size_t)S_P + (size_t)sq * S_S, r0 = sb + (size_t)qb * 256;
                    att::attn_body<false>(PROJ + r0 * INW + COL_QC + h * 128, PROJ + sb * INW + COL_KC + kvh * 128, PROJ + sb * INW + COL_VC + kvh * 128, Y + r0 * DM + YCOL_C + h * 128, INW, INW, DM, pr ? S_P / 64 : S_S / 64, nob, alds);
                }
            }
            const float* sink = args.in[7] + (size_t)l * 4;
            for (int u = vcu; u < 768 + 1152; u += G) {
                const bool isA = u < 768; const int ub = u - 768;
                const int hh = isA ? (u & 3) : ub % 6, blk = isA ? (u >> 2) : ub / 6, dil = isA ? 1 : (hh < 2 ? 1 : (hh < 4 ? 4 : 16));
                const int R0 = blk * 256; const int sb = R0 < S_P ? 0 : S_P + ((R0 - S_P) / S_S) * S_S, Ls = R0 < S_P ? S_P : S_S;
                const int bis = (R0 - sb) / 256, L = Ls / dil, nbr = L / 256, res = bis / nbr, i0 = (bis - res * nbr) * 256;
                const size_t t0 = (size_t)sb + res + (size_t)i0 * dil;
                att::Band bd; bd.i0 = i0; bd.L = L; bd.hw = isA ? 128 : 64; bd.tlo = i0 / 64 - (isA ? 2 : 1); bd.m0 = isA ? sink[hh] * (1.0f / att::SCALE) : -1e30f; bd.l0 = isA ? 1.0f : 0.f;
                bd.lse = isA ? nullptr : lseb + t0 * 8 + hh; bd.lse_ld = (long)8 * dil;
                const bf16_t* pb_ = PROJ + ((size_t)sb + res) * INW;
                const int cq = isA ? COL_QA + hh * 128 : COL_QB + hh * 128, ck = isA ? COL_KA + (hh >> 1) * 128 : COL_KB + hh * 128, cv = isA ? COL_VA + (hh >> 1) * 128 : COL_VB + hh * 128;
                att::attn_body<true>(PROJ + t0 * INW + cq, pb_ + ck, pb_ + cv, Y + t0 * DM + (isA ? YCOL_A : YCOL_B) + hh * 128, (long)INW * dil, (long)INW * dil, (long)DM * dil, isA ? 8 : 6, bd, alds);
            }
        PHASE_END
        PHASE_BEGIN(pb + 7)
            LOCAL_IDS
            for (int m = gw; m < M; m += NGW) {
                const float* lp = lseb + (size_t)m * 8;
                const f32x4 l03 = *(const f32x4*)lp; const f32x2 l45 = *(const f32x2*)(lp + 4);
                const int j = lane >> 5;
                const float a = j ? l03.y : l03.x, b = j ? l03.w : l03.z, c = j ? l45.y : l45.x, mx = fmaxf(a, fmaxf(b, c));
                const float ea = __expf(a - mx), eb = __expf(b - mx), ec = __expf(c - mx), inv = 1.0f / (ea + eb + ec);
                const float w0 = ea * inv, w1 = eb * inv, w2 = ec * inv;
                GAS u32x2* yp = (GAS u32x2*)(Y + (size_t)m * DM + YCOL_B);
#pragma unroll
                for (int k = 0; k < 3; ++k) { const int uu = lane + 64 * k;
                    float sc = k == 0 ? w0 : (k == 1 ? w1 : w2); if (REP_MASK && rep_ != ((REP_MASK >> 7) & 1)) sc = 1.0f;
                    const u32x2 v = yp[uu]; yp[uu] = (u32x2){cvt_pk_bf16(bf_lo(v.x) * sc, bf_hi(v.x) * sc), cvt_pk_bf16(bf_lo(v.y) * sc, bf_hi(v.y) * sc)}; }
            }
        PHASE_END
        PHASE_BEGIN(pb + 8)
            pg8::ChainSched S; S.so.init(M, DM, G, bx, 4);
            pg8::EpiBranch E{GATES, U};
            pg8::gemm_phase<pg8::EpiBranch, pg8::ChainSched>(ldsl + RING_OFF, Y, (const bf16_t*)((char*)Wb + WO_BR), DM, S, E);
        PHASE_END
        PHASE_BEGIN(pb + 9)
            pg8::PlainSched S; S.so.init(M, DM, G, bx, 4); S.nt = DM / 64;
            pg8::EpiResid E{out, out + (size_t)S_P * DM, S_P, out, rep_ == ((REP_MASK >> 9) & 1) ? 1.0f : 0.f, rep_ == ((REP_MASK >> 9) & 1) ? 0 : PROBE_MODE, (float*)(ws + WS_BIG)};
            pg8::gemm_phase<pg8::EpiResid, pg8::PlainSched>(ldsl + RING_OFF, U, (const bf16_t*)((char*)Wb + WO_WO), DM, S, E);
        PHASE_END
        }
    }
    PHASE_BEGIN(PH_FINAL)
        LOCAL_IDS
        const float* g = args.in[17];
        f32x4 gv[8];
#pragma unroll
        for (int j = 0; j < 8; ++j) gv[j] = ((const f32x4*)g)[lane + 64 * j];
        for (int m = gw; m < M; m += NGW) {
            GAS f32x4* xr = (GAS f32x4*)(out + (size_t)m * DM) + lane; f32x4 v[8]; float ss = 0.f;
#pragma unroll
            for (int j = 0; j < 8; ++j) { v[j] = xr[64 * j]; ss += (v[j].x * v[j].x + v[j].y * v[j].y) + (v[j].z * v[j].z + v[j].w * v[j].w); }
            const float rstd = 1.0f / sqrtf(wave_sum(ss) * (1.0f / DM) + NORM_EPS);
#pragma unroll
            for (int j = 0; j < 8; ++j) xr[64 * j] = v[j] * rstd * gv[j];
        }
    PHASE_END
#undef PHASE_BEGIN
#undef PHASE_END
}

#ifndef N_LAUNCH_MODE
#define N_LAUNCH_MODE 1
#endif
extern "C" void kernel_launch(void* const* d_in, const int* in_sizes, int n_in, void* d_out, int out_size, void* d_ws, size_t ws_size, hipStream_t stream) {
    static int grid = 0;
    if (grid == 0) {
        if (n_in != 18 || out_size != M * DM || ws_size < WS_END) { fprintf(stderr, "kernel_launch: unexpected shapes: n_in %d out %d ws %zu (need %zu)\n", n_in, out_size, ws_size, (size_t)WS_END); grid = -1; return; }
        int dev = 0, cus = 0, per_cu = 0;
        if (hipGetDevice(&dev) != hipSuccess || hipDeviceGetAttribute(&cus, hipDeviceAttributeMultiprocessorCount, dev) != hipSuccess) { grid = -1; return; }
        if (hipFuncSetAttribute((const void*)fwd_kernel, hipFuncAttributeMaxDynamicSharedMemorySize, LDS_BYTES) != hipSuccess) { fprintf(stderr, "kernel_launch: hipFuncSetAttribute failed\n"); grid = -1; return; }
        if (hipOccupancyMaxActiveBlocksPerMultiprocessor(&per_cu, (const void*)fwd_kernel, NWAVES * 64, LDS_BYTES) != hipSuccess || per_cu < 1)
            fprintf(stderr, "kernel_launch: note: occupancy query reports %d workgroups per CU\n", per_cu);
        (void)hipGetLastError();
        grid = cus < 256 ? cus : 256;
    }
    if (grid < 0) return;
    if (hipMemsetAsync((char*)d_ws + WS_CTL, 0, CTL_ZERO_BYTES, stream) != hipSuccess) return;
    Args a{};
    for (int i = 0; i < 18; ++i) a.in[i] = (const float*)d_in[i];
    a.out = (float*)d_out; a.ws = (unsigned char*)d_ws;
#if N_LAUNCH_MODE == 1
    a.ph_lo = 0; a.ph_hi = PH_END;
    hipLaunchKernelGGL(fwd_kernel, dim3(grid), dim3(NWAVES * 64), LDS_BYTES, stream, a);
#else
    for (int s = 0; s < NSTEP; ++s)
        for (int p = 0; p < PH_PER_STEP; ++p) { if ((s & 1) && p >= 3) continue; a.ph_lo = s * PH_PER_STEP + p; a.ph_hi = a.ph_lo + 1;
            hipLaunchKernelGGL(fwd_kernel, dim3(grid), dim3(NWAVES * 64), LDS_BYTES, stream, a); }
    a.ph_lo = PH_FINAL; a.ph_hi = PH_END;
    hipLaunchKernelGGL(fwd_kernel, dim3(grid), dim3(NWAVES * 64), LDS_BYTES, stream, a);
#endif
    const hipError_t le = hipPeekAtLastError();
    if (le != hipSuccess) fprintf(stderr, "kernel_launch: launch failed: %s\n", hipGetErrorName(le));
}
```

```cpp
#include <hip/hip_runtime.h>
#include <cstdio>
#include <cstdint>
#define PROBE_MODE 3
#define FUSE_PREP 1
#ifndef REP_MASK
#define REP_MASK 0
#endif

#define LAS __attribute__((address_space(3)))
#define GAS __attribute__((address_space(1)))
typedef unsigned short bf16_t;
typedef short bf16x8 __attribute__((ext_vector_type(8)));
typedef short s16x4 __attribute__((ext_vector_type(4)));
typedef float f32x2 __attribute__((ext_vector_type(2)));
typedef float f32x4 __attribute__((ext_vector_type(4)));
typedef float f32x16 __attribute__((ext_vector_type(16)));
typedef unsigned u32x2 __attribute__((ext_vector_type(2)));
typedef unsigned u32x4 __attribute__((ext_vector_type(4)));

constexpr int DM = 2048, DFF = 5632, DEPTH = 4, NSTEP = 2 * DEPTH;
constexpr int S_P = 16384, S_S = 8192;
constexpr int M = 49152;
constexpr int INW = 4608, GATEW = 6144, PGW = INW + GATEW, NFF2 = 2 * DFF;
constexpr int COL_QA = 0, COL_KA = 512, COL_VA = 768, COL_QB = 1024, COL_KB = 1792, COL_VB = 2560, COL_QC = 3328, COL_KC = 4096, COL_VC = 4352;
constexpr int YCOL_A = 0, YCOL_B = 512, YCOL_C = 1280;
constexpr float NORM_EPS = 1e-6f;

typedef __bf16 bf16x2_t __attribute__((ext_vector_type(2)));
__device__ __forceinline__ unsigned cvt_pk_bf16(float lo, float hi) { const f32x2 v = {lo, hi}; const bf16x2_t b = __builtin_convertvector(v, bf16x2_t); return __builtin_bit_cast(unsigned, b); }
__device__ __forceinline__ float bf_lo(unsigned w) { return __uint_as_float(w << 16); }
__device__ __forceinline__ float bf_hi(unsigned w) { return __uint_as_float(w & 0xffff0000u); }
__device__ __forceinline__ unsigned f2bf(float f) { unsigned u = __float_as_uint(f); return (u + 0x7fffu + ((u >> 16) & 1u)) >> 16; }
__device__ __forceinline__ unsigned pk2(float lo, float hi) { return f2bf(lo) | (f2bf(hi) << 16); }

__device__ __forceinline__ float row_ssq(const float* ssp, int row) { const f32x4* p = (const f32x4*)(ssp + (size_t)row * 8); const f32x4 a = p[0], b = p[1]; return ((a[0] + a[1]) + (a[2] + a[3])) + ((b[0] + b[1]) + (b[2] + b[3])); }
namespace pg8 {
constexpr int BM = 256, BK = 64, HALF = 128, HTB = HALF * BK * 2, STAGE_BYTES = 8 * HTB, NXCD = 8;
__host__ __device__ __forceinline__ int lds_byte(int r, int c) { const int st = (r >> 4) * 2 + (c >> 5), rr = r & 15, cc = c & 31, ob = rr * 64 + cc * 2; return st * 1024 + (ob ^ (((ob >> 9) & 1) << 5)); }
__host__ __device__ __forceinline__ void stage_rc(int b, int& R, int& C) { const int st = b / 1024, sb = b % 1024, swz = sb ^ (((sb >> 9) & 1) << 5); R = (st >> 1) * 16 + swz / 64; C = (st & 1) * 32 + (swz % 64) / 2; }
__host__ __device__ __forceinline__ int perm32(int rho) { const int n = rho >> 4, i = rho & 15; return 8 * (i >> 2) + 4 * n + (i & 3); }

struct Unit { int pm, pn, k0, nt, seg; };
struct StaticOrder {
    int nM, nN, nwg, G, c, WGM;
    __device__ void init(int M_, int N_, int G_, int c_, int wgm) { nM = M_ / BM; nN = N_ / BM; nwg = nM * nN; G = G_; c = c_; WGM = wgm; }
    __device__ bool next(int i, int& pm, int& pn) const {
        const long L = (long)i * G + c; if (L >= nwg) return false;
        int wgid = (int)L; { const int q = nwg / NXCD, r = nwg % NXCD, xcd = wgid % NXCD, off = wgid / NXCD; wgid = (xcd < r ? xcd * (q + 1) : r * (q + 1) + (xcd - r) * q) + off; }
        const int nig = WGM * nN, gid = wgid / nig, fm = gid * WGM, gsz = (nM - fm) < WGM ? (nM - fm) : WGM;
        pm = fm + ((wgid % nig) % gsz); pn = (wgid % nig) / gsz; return true;
    }
};
struct PlainSched { StaticOrder so; int nt;
    __device__ __forceinline__ bool next(int i, Unit& u) const { u.k0 = 0; u.nt = nt; u.seg = 0; return so.next(i, u.pm, u.pn); } };
struct ChainSched { StaticOrder so;
    __device__ __forceinline__ bool next(int i, Unit& u) const { const int t = i / 3, sg = i - 3 * t; u.seg = sg; u.k0 = sg == 0 ? 0 : (sg == 1 ? 512 : 1280); u.nt = sg == 0 ? 8 : 12; return so.next(t, u.pm, u.pn); } };

typedef f32x4 Acc[2][2][4][2];

struct EpiSwiglu { static constexpr bool PERM = true, CHAIN = false; bf16_t* O; const float* ss;
    __device__ __forceinline__ void operator()(Acc& acc, const Unit& u, int wr, int wc, int fr, int fq) const {
        const int row0 = u.pm * BM + wr * 64 + fr, col0 = u.pn * HALF + wc * 32 + 8 * fq;
        float rs[2][4];
#pragma unroll
        for (int ai = 0; ai < 2; ++ai)
#pragma unroll
            for (int m = 0; m < 4; ++m) rs[ai][m] = row_ssq(ss, row0 + ai * HALF + m * 16);
#pragma unroll
        for (int ai = 0; ai < 2; ++ai)
#pragma unroll
            for (int m = 0; m < 4; ++m) { bf16_t* rowp = O + (size_t)(row0 + ai * HALF + m * 16) * DFF + col0; float v[8];
                const float r = __builtin_amdgcn_rsqf(rs[ai][m] * (1.0f / DM) + NORM_EPS);
#pragma unroll
                for (int n = 0; n < 2; ++n)
#pragma unroll
                    for (int j = 0; j < 4; ++j) { const float g = acc[ai][0][m][n][j] * r, up = acc[ai][1][m][n][j] * r;
                        const float e = __builtin_amdgcn_exp2f(g * -1.4426950408889634f); v[4 * n + j] = g * up * __builtin_amdgcn_rcpf(1.0f + e); }
                u32x4 w; w.x = cvt_pk_bf16(v[0], v[1]); w.y = cvt_pk_bf16(v[2], v[3]); w.z = cvt_pk_bf16(v[4], v[5]); w.w = cvt_pk_bf16(v[6], v[7]);
                *(u32x4*)rowp = w; }
    }
};
struct EpiStream { static constexpr bool PERM = true, CHAIN = false; bf16_t* hi; bf16_t* lo; float* ssq; float alpha; LAS float* tab;
    __device__ __forceinline__ void operator()(Acc& acc, const Unit& u, int wr, int wc, int fr, int fq) const {
        const unsigned loff = (unsigned)(fr * DM + 8 * fq);
        const size_t ub = (size_t)(u.pm * BM + wr * 64) * DM + u.pn * BM + wc * 32;
#pragma unroll
        for (int ai = 0; ai < 2; ++ai) {
            u32x4 H[4][2], L[4][2];
#pragma unroll
            for (int m = 0; m < 4; ++m)
#pragma unroll
                for (int bj = 0; bj < 2; ++bj) { const size_t uo = ub + (size_t)(ai * HALF + m * 16) * DM + bj * HALF;
                    H[m][bj] = *(const u32x4*)(hi + uo + loff); L[m][bj] = *(const u32x4*)(lo + uo + loff); }
#pragma unroll
            for (int m = 0; m < 4; ++m) { float sq = 0.f;
#pragma unroll
                for (int bj = 0; bj < 2; ++bj) { const size_t uo = ub + (size_t)(ai * HALF + m * 16) * DM + bj * HALF; const u32x4 h = H[m][bj], l = L[m][bj]; float x[8];
                    x[0] = bf_lo(h.x) + bf_lo(l.x); x[1] = bf_hi(h.x) + bf_hi(l.x); x[2] = bf_lo(h.y) + bf_lo(l.y); x[3] = bf_hi(h.y) + bf_hi(l.y);
                    x[4] = bf_lo(h.z) + bf_lo(l.z); x[5] = bf_hi(h.z) + bf_hi(l.z); x[6] = bf_lo(h.w) + bf_lo(l.w); x[7] = bf_hi(h.w) + bf_hi(l.w);
#pragma unroll
                    for (int j = 0; j < 4; ++j) { x[j] = fmaf(acc[ai][bj][m][0][j], alpha, x[j]); x[4 + j] = fmaf(acc[ai][bj][m][1][j], alpha, x[4 + j]); }
#pragma unroll
                    for (int j = 0; j < 8; ++j) sq = fmaf(x[j], x[j], sq);
                    u32x4 nh, nl; nh.x = cvt_pk_bf16(x[0], x[1]); nh.y = cvt_pk_bf16(x[2], x[3]); nh.z = cvt_pk_bf16(x[4], x[5]); nh.w = cvt_pk_bf16(x[6], x[7]);
                    nl.x = cvt_pk_bf16(x[0] - bf_lo(nh.x), x[1] - bf_hi(nh.x)); nl.y = cvt_pk_bf16(x[2] - bf_lo(nh.y), x[3] - bf_hi(nh.y));
                    nl.z = cvt_pk_bf16(x[4] - bf_lo(nh.z), x[5] - bf_hi(nh.z)); nl.w = cvt_pk_bf16(x[6] - bf_lo(nh.w), x[7] - bf_hi(nh.w));
                    *(u32x4*)(hi + uo + loff) = nh; *(u32x4*)(lo + uo + loff) = nl; }
                sq += __shfl_xor(sq, 16); sq += __shfl_xor(sq, 32);
                if (fq == 0) tab[(wr * 64 + ai * HALF + m * 16 + fr) * 4 + wc] = sq; }
            asm volatile("" ::: "memory"); }
        asm volatile("s_waitcnt lgkmcnt(0)" ::: "memory"); __builtin_amdgcn_s_barrier(); asm volatile("" ::: "memory");
        const int t = (wr * 4 + wc) * 64 + fq * 16 + fr;
        if (t < BM) { const f32x4 p = *(const LAS f32x4*)(tab + t * 4); ssq[(size_t)(u.pm * BM + t) * 8 + u.pn] = (p[0] + p[1]) + (p[2] + p[3]); }
    }
};
struct EpiProjGate { static constexpr bool PERM = true, CHAIN = false; bf16_t* proj; bf16_t* gates; const float* bias; const float* ss; const f32x2* rope; const f32x2* ropex; const float* gq; const float* gk; LAS float* tab;
    __device__ __forceinline__ void store8(bf16_t* p, const float (&v)[8]) const { u32x4 w; w.x = cvt_pk_bf16(v[0], v[1]); w.y = cvt_pk_bf16(v[2], v[3]); w.z = cvt_pk_bf16(v[4], v[5]); w.w = cvt_pk_bf16(v[6], v[7]); *(u32x4*)p = w; }
    __device__ __forceinline__ void operator()(Acc& acc, const Unit& u, int wr, int wc, int fr, int fq) const {
        const int pn = u.pn, rl0 = wr * 64 + fr, row0 = u.pm * BM + rl0;
        float rs[2][4];
#pragma unroll
        for (int ai = 0; ai < 2; ++ai)
#pragma unroll
            for (int m = 0; m < 4; ++m) rs[ai][m] = row_ssq(ss, row0 + ai * HALF + m * 16);
#pragma unroll
        for (int ai = 0; ai < 2; ++ai)
#pragma unroll
            for (int m = 0; m < 4; ++m) { const float r = __builtin_amdgcn_rsqf(rs[ai][m] * (1.0f / DM) + NORM_EPS);
#pragma unroll
                for (int bj = 0; bj < 2; ++bj) { acc[ai][bj][m][0] *= r; acc[ai][bj][m][1] *= r; } }
        if (pn >= INW / BM) {
            const int col0 = (pn - INW / BM) * BM + wc * 32 + 8 * fq;
            f32x4 bv[2][2];
#pragma unroll
            for (int bj = 0; bj < 2; ++bj)
#pragma unroll
                for (int n = 0; n < 2; ++n) bv[bj][n] = *(const f32x4*)(bias + col0 + bj * HALF + 4 * n);
#pragma unroll
            for (int ai = 0; ai < 2; ++ai)
#pragma unroll
                for (int m = 0; m < 4; ++m) { bf16_t* rowp = gates + (size_t)(row0 + ai * HALF + m * 16) * GATEW + col0;
#pragma unroll
                    for (int bj = 0; bj < 2; ++bj) { float v[8];
#pragma unroll
                        for (int j = 0; j < 4; ++j) { v[j] = __builtin_amdgcn_rcpf(1.0f + __builtin_amdgcn_exp2f((acc[ai][bj][m][0][j] + bv[bj][0][j]) * -1.4426950408889634f));
                                                      v[4 + j] = __builtin_amdgcn_rcpf(1.0f + __builtin_amdgcn_exp2f((acc[ai][bj][m][1][j] + bv[bj][1][j]) * -1.4426950408889634f)); }
                        store8(rowp + bj * HALF, v); } }
            return;
        }
        const int col0 = pn * BM + wc * 32 + 8 * fq;
        const bool plain = !FUSE_PREP || (pn == 3) || (pn >= 10 && pn <= 12) || (pn == 17), axial = FUSE_PREP && (pn >= 13 && pn <= 16);
        if (plain) {
#pragma unroll
            for (int ai = 0; ai < 2; ++ai)
#pragma unroll
                for (int m = 0; m < 4; ++m) { bf16_t* rowp = proj + (size_t)(row0 + ai * HALF + m * 16) * INW + col0;
#pragma unroll
                    for (int bj = 0; bj < 2; ++bj) { float v[8];
#pragma unroll
                        for (int j = 0; j < 4; ++j) { v[j] = acc[ai][bj][m][0][j]; v[4 + j] = acc[ai][bj][m][1][j]; }
                        store8(rowp + bj * HALF, v); } }
        } else if (!axial) {
#pragma unroll
            for (int ai = 0; ai < 2; ++ai)
#pragma unroll
                for (int m = 0; m < 4; ++m) { const int row = row0 + ai * HALF + m * 16, pos = row < S_P ? row : (row & (S_S - 1));
                    const f32x4* cp = (const f32x4*)(rope + (size_t)pos * 64 + 16 * wc + 4 * fq); const f32x4 c01 = cp[0], c23 = cp[1];
                    const float cs[4] = {c01[0], c01[2], c23[0], c23[2]}, sn[4] = {c01[1], c01[3], c23[1], c23[3]};
                    bf16_t* rowp = proj + (size_t)row * INW + col0;
#pragma unroll
                    for (int bj = 0; bj < 2; ++bj) { float v[8];
#pragma unroll
                        for (int k = 0; k < 4; ++k) { const float x1 = acc[ai][bj][m][k >> 1][(2 * k) & 3], x2 = acc[ai][bj][m][k >> 1][((2 * k) & 3) + 1];
                            v[2 * k] = x1 * cs[k] - x2 * sn[k]; v[2 * k + 1] = x2 * cs[k] + x1 * sn[k]; }
                        store8(rowp + bj * HALF, v); } }
        } else {
            const float* g = (pn == 16 ? gk : gq) + 64 * (wc >> 1) + 16 * (wc & 1) + 4 * fq;
            const f32x4 gA = *(const f32x4*)g, gB = *(const f32x4*)(g + 32);
#pragma unroll
            for (int ai = 0; ai < 2; ++ai)
#pragma unroll
                for (int m = 0; m < 4; ++m)
#pragma unroll
                    for (int bj = 0; bj < 2; ++bj) { float sq = 0.f;
#pragma unroll
                        for (int j = 0; j < 4; ++j) { sq = fmaf(acc[ai][bj][m][0][j], acc[ai][bj][m][0][j], sq); sq = fmaf(acc[ai][bj][m][1][j], acc[ai][bj][m][1][j], sq); }
                        sq += __shfl_xor(sq, 16); sq += __shfl_xor(sq, 32);
                        if (fq == 0) tab[((rl0 + ai * HALF + m * 16) * 2 + bj) * 4 + wc] = sq; }
            asm volatile("s_waitcnt lgkmcnt(0)" ::: "memory"); __builtin_amdgcn_s_barrier(); asm volatile("" ::: "memory");
#pragma unroll
            for (int ai = 0; ai < 2; ++ai)
#pragma unroll
                for (int m = 0; m < 4; ++m) { const int rl = rl0 + ai * HALF + m * 16, row = u.pm * BM + rl, pos = row < S_P ? row : (row & (S_S - 1));
                    const int id = (wc >> 1) ? (pos & 63) : (pos >> 6);
                    const f32x4* cp = (const f32x4*)(ropex + (size_t)id * 32 + 16 * (wc & 1) + 4 * fq); const f32x4 c01 = cp[0], c23 = cp[1];
                    const float cs[4] = {c01[0], c01[2], c23[0], c23[2]}, sn[4] = {c01[1], c01[3], c23[1], c23[3]};
                    bf16_t* rowp = proj + (size_t)row * INW + col0;
#pragma unroll
                    for (int bj = 0; bj < 2; ++bj) { const f32x4 t = *(const LAS f32x4*)(tab + (rl * 2 + bj) * 4);
                        const float rh = __builtin_amdgcn_rsqf(((t[0] + t[1]) + (t[2] + t[3])) * (1.0f / 128.0f) + NORM_EPS); float v[8];
#pragma unroll
                        for (int k = 0; k < 4; ++k) { const float x1 = acc[ai][bj][m][k >> 1][(2 * k) & 3] * rh * gA[k], x2 = acc[ai][bj][m][k >> 1][((2 * k) & 3) + 1] * rh * gB[k];
                            v[2 * k] = x1 * cs[k] - x2 * sn[k]; v[2 * k + 1] = x2 * cs[k] + x1 * sn[k]; }
                        store8(rowp + bj * HALF, v); } }
        }
    }
};
struct EpiBranch { static constexpr bool PERM = true, CHAIN = true; const bf16_t* gates; bf16_t* O;
    __device__ __forceinline__ void operator()(Acc& acc, const Unit& u, int wr, int wc, int fr, int fq) const {
        const int row0 = u.pm * BM + wr * 64 + fr, col0 = u.pn * BM + wc * 32 + 8 * fq; const int seg = u.seg;
        const int no = seg == 0 ? 0 : (seg == 1 ? DM : 2 * DM), dofs = seg == 2 ? 2 * DM : no + DM;
#pragma unroll
        for (int ai = 0; ai < 2; ++ai) {
            u32x4 gn[4][2], gd[4][2];
#pragma unroll
            for (int m = 0; m < 4; ++m)
#pragma unroll
                for (int bj = 0; bj < 2; ++bj) { const bf16_t* gp = gates + (size_t)(row0 + ai * HALF + m * 16) * GATEW + col0 + bj * HALF;
                    gn[m][bj] = *(const u32x4*)(gp + no); if (seg != 2) gd[m][bj] = *(const u32x4*)(gp + dofs); else gd[m][bj] = (u32x4){0u, 0u, 0u, 0u}; }
#pragma unroll
            for (int m = 0; m < 4; ++m) { const size_t row = (size_t)(row0 + ai * HALF + m * 16);
#pragma unroll
                for (int bj = 0; bj < 2; ++bj) { const u32x4 a = gn[m][bj]; float s[8];
                    s[0] = bf_lo(a.x); s[1] = bf_hi(a.x); s[2] = bf_lo(a.y); s[3] = bf_hi(a.y); s[4] = bf_lo(a.z); s[5] = bf_hi(a.z); s[6] = bf_lo(a.w); s[7] = bf_hi(a.w);
                    if (seg != 2) { const u32x4 b = gd[m][bj]; float d[8];
                        d[0] = bf_lo(b.x); d[1] = bf_hi(b.x); d[2] = bf_lo(b.y); d[3] = bf_hi(b.y); d[4] = bf_lo(b.z); d[5] = bf_hi(b.z); d[6] = bf_lo(b.w); d[7] = bf_hi(b.w);
#pragma unroll
                        for (int j = 0; j < 8; ++j) s[j] = s[j] * __builtin_amdgcn_rcpf(fmaxf(d[j], 1e-30f));
                    }
#pragma unroll
                    for (int j = 0; j < 4; ++j) { acc[ai][bj][m][0][j] *= s[j]; acc[ai][bj][m][1][j] *= s[4 + j]; }
                    if (seg == 2) { const f32x4 v0 = acc[ai][bj][m][0], v1 = acc[ai][bj][m][1];
                        u32x4 w; w.x = cvt_pk_bf16(v0[0], v0[1]); w.y = cvt_pk_bf16(v0[2], v0[3]); w.z = cvt_pk_bf16(v1[0], v1[1]); w.w = cvt_pk_bf16(v1[2], v1[3]);
                        *(u32x4*)(O + row * DM + col0 + bj * HALF) = w; } } }
            asm volatile("" ::: "memory"); }
    }
};

template <class Epi, class Sched>
__device__ __forceinline__ void gemm_phase(LAS unsigned char* lds, const bf16_t* Ag, const bf16_t* Btg, const int Kp, const Sched& S, const Epi& E) {
    int tid = threadIdx.x; asm volatile("" : "+v"(tid));
    const int wid = __builtin_amdgcn_readfirstlane(tid >> 6), lane = tid & 63, wr = wid >> 2, wc = wid & 3, fr = lane & 15, fq = lane >> 4;
    unsigned voffA[2], voffB[2];
#pragma unroll
    for (int i = 0; i < 2; ++i) { int R, C; stage_rc(tid * 16 + i * 8192, R, C); const int Rb = Epi::PERM ? ((R & ~31) + perm32(R & 31)) : R;
        voffA[i] = (unsigned)(R * Kp + C) * 2u; voffB[i] = (unsigned)(Rb * Kp + C) * 2u; }
    const size_t kstep = (size_t)(BK * 2);
    const size_t hstep = (size_t)HALF * Kp * 2;
    const size_t tstep = 2 * hstep;
    const unsigned ldsw = (unsigned)wid * 1024u;
    const int aoff = lds_byte(wr * 64 + fr, fq * 8), boff = lds_byte(wc * 32 + fr, fq * 8);
#define PG8_SA(b, h) (((b) * 2 + (h)) * HTB)
#define PG8_SB(b, h) ((4 + (b) * 2 + (h)) * HTB)
#define PG8_STAGE(bufoff, gbase, voff) do { _Pragma("unroll") for (int _i = 0; _i < 2; ++_i) \
        __builtin_amdgcn_global_load_lds((const unsigned*)((const char*)(gbase) + (voff)[_i]), (LAS unsigned*)(lds + (bufoff) + ldsw + _i * 8192), 16, 0, 0); } while (0)
#define PG8_LDA(dst, b, h) do { _Pragma("unroll") for (int m = 0; m < 4; ++m) _Pragma("unroll") for (int k = 0; k < 2; ++k) dst[m][k] = *(const LAS bf16x8*)(lds + PG8_SA(b, h) + aoff + m * 2048 + k * 1024); } while (0)
#define PG8_LDB(dst, b, h) do { _Pragma("unroll") for (int n = 0; n < 2; ++n) _Pragma("unroll") for (int k = 0; k < 2; ++k) dst[n][k] = *(const LAS bf16x8*)(lds + PG8_SB(b, h) + boff + n * 2048 + k * 1024); } while (0)
#define PG8_MMA(ai, bj, At, Bt) do { __builtin_amdgcn_s_setprio(1); _Pragma("unroll") for (int m = 0; m < 4; ++m) _Pragma("unroll") for (int n = 0; n < 2; ++n) _Pragma("unroll") for (int k = 0; k < 2; ++k) \
        acc[ai][bj][m][n] = __builtin_amdgcn_mfma_f32_16x16x32_bf16(Bt[n][k], At[m][k], acc[ai][bj][m][n], 0, 0, 0); __builtin_amdgcn_s_setprio(0); } while (0)
#define PG8_WAIT_V(n) asm volatile("s_waitcnt vmcnt(" #n ")" ::: "memory")
#define PG8_WAIT_L(n) asm volatile("s_waitcnt lgkmcnt(" #n ")" ::: "memory")
#define PG8_BAR __builtin_amdgcn_s_barrier()
#define PG8_SCHED __builtin_amdgcn_sched_barrier(0)
    Unit cur, nxt; int ui = 0;
    if (!S.next(0, cur)) return;
    Acc acc;
#pragma unroll
    for (int a = 0; a < 2; ++a)
#pragma unroll
        for (int b = 0; b < 2; ++b)
#pragma unroll
            for (int m = 0; m < 4; ++m)
#pragma unroll
                for (int n = 0; n < 2; ++n) acc[a][b][m][n] = (f32x4){0.f, 0.f, 0.f, 0.f};
    bf16x8 At[4][2], B0[2][2], B1[2][2];
    const char* cA = (const char*)Ag + (size_t)cur.pm * tstep + (size_t)cur.k0 * 2; const char* cB = (const char*)Btg + (size_t)cur.pn * tstep + (size_t)cur.k0 * 2;
    PG8_STAGE(PG8_SB(0, 0), cB, voffB); PG8_STAGE(PG8_SB(0, 1), cB + hstep, voffB); PG8_STAGE(PG8_SA(0, 0), cA, voffA); PG8_STAGE(PG8_SA(0, 1), cA + hstep, voffA);
    if (wr == 1) PG8_BAR;
    PG8_WAIT_V(2); PG8_BAR;
    PG8_STAGE(PG8_SB(1, 0), cB + kstep, voffB); PG8_STAGE(PG8_SA(1, 0), cA + kstep, voffA); PG8_STAGE(PG8_SB(1, 1), cB + hstep + kstep, voffB);
    PG8_WAIT_V(6); PG8_BAR;
    for (;;) {
        const bool has_next = S.next(ui + 1, nxt);
        const char* nA = has_next ? (const char*)Ag + (size_t)nxt.pm * tstep + (size_t)nxt.k0 * 2 : cA; const char* nB = has_next ? (const char*)Btg + (size_t)nxt.pn * tstep + (size_t)nxt.k0 * 2 : cB;
        const int nt = cur.nt;
        for (int t = 0; t < nt; t += 2) {
            const bool last = (t == nt - 2);
            const char* a1 = cA + (size_t)(t + 1) * kstep;
            const char* a2 = last ? nA : cA + (size_t)(t + 2) * kstep; const char* b2 = last ? nB : cB + (size_t)(t + 2) * kstep;
            const char* a3 = a2 + kstep; const char* b3 = b2 + kstep;
            PG8_LDB(B0, 0, 0); PG8_LDB(B1, 0, 1); PG8_SCHED; PG8_LDA(At, 0, 0); PG8_STAGE(PG8_SA(1, 1), a1 + hstep, voffA);
            PG8_WAIT_V(8); PG8_WAIT_L(0); PG8_BAR; PG8_MMA(0, 0, At, B0); PG8_MMA(0, 1, At, B1); PG8_BAR; PG8_SCHED;
            PG8_LDA(At, 0, 1); PG8_STAGE(PG8_SB(0, 0), b2, voffB); PG8_STAGE(PG8_SB(0, 1), b2 + hstep, voffB); PG8_STAGE(PG8_SA(0, 0), a2, voffA);
            PG8_WAIT_V(8); PG8_WAIT_L(0); PG8_BAR; PG8_MMA(1, 0, At, B0); PG8_MMA(1, 1, At, B1); PG8_BAR; PG8_SCHED;
            PG8_LDB(B0, 1, 0); PG8_LDB(B1, 1, 1); PG8_SCHED; PG8_LDA(At, 1, 0); PG8_STAGE(PG8_SA(0, 1), a2 + hstep, voffA);
            PG8_WAIT_V(8); PG8_WAIT_L(0); PG8_BAR; PG8_MMA(0, 0, At, B0); PG8_MMA(0, 1, At, B1); PG8_BAR; PG8_SCHED;
            PG8_LDA(At, 1, 1); PG8_STAGE(PG8_SB(1, 0), b3, voffB); PG8_STAGE(PG8_SB(1, 1), b3 + hstep, voffB); PG8_STAGE(PG8_SA(1, 0), a3, voffA);
            PG8_WAIT_V(8); PG8_WAIT_L(0); PG8_BAR; PG8_MMA(1, 0, At, B0); PG8_MMA(1, 1, At, B1); PG8_BAR; PG8_SCHED;
        }
        if (wr == 0) PG8_BAR;
        E(acc, cur, wr, wc, fr, fq);
        if (!has_next) break;
        if (!Epi::CHAIN || cur.seg == 2) {
#pragma unroll
            for (int a = 0; a < 2; ++a)
#pragma unroll
                for (int b = 0; b < 2; ++b)
#pragma unroll
                    for (int m = 0; m < 4; ++m)
#pragma unroll
                        for (int n = 0; n < 2; ++n) acc[a][b][m][n] = (f32x4){0.f, 0.f, 0.f, 0.f};
        }
        cur = nxt; cA = nA; cB = nB; ++ui;
        if (wr == 1) PG8_BAR;
    }
    PG8_WAIT_V(0);
    PG8_BAR;
#undef PG8_SA
#undef PG8_SB
#undef PG8_STAGE
#undef PG8_LDA
#undef PG8_LDB
#undef PG8_MMA
#undef PG8_WAIT_V
#undef PG8_WAIT_L
#undef PG8_BAR
#undef PG8_SCHED
}
}

namespace att {
constexpr int D = 128, NW = 8, QBLK = 32, KVBLK = 64;
constexpr float SCALE = 0.088388347648318440f;
constexpr float THR = 8.f;
constexpr size_t SHM_V = KVBLK * D * 2, SHM_K = KVBLK * D * 2, SHM_ATTN = 2 * SHM_V + 2 * SHM_K + NW * 64 * 4;
#define KSWZ(row, colB) ((row) * 256 + ((colB) ^ (((row) & 7) << 4)))
#define SBAR() __builtin_amdgcn_sched_barrier(0)
__device__ __forceinline__ int crow(int r, int hi) { return (r & 3) + 8 * (r >> 2) + 4 * hi; }
__device__ __forceinline__ unsigned cvtpk(float lo, float hi) { return cvt_pk_bf16(lo, hi); }

__device__ __forceinline__ void partialSM(f32x16& p0, f32x16& p1, float& m_reg, float& mn, float& alpha) {
  constexpr float C = SCALE * 1.4426950408889634f;
  float pmax = p0[0];
#pragma unroll
  for (int r = 1; r < 16; ++r) pmax = fmaxf(pmax, p0[r]);
#pragma unroll
  for (int r = 0; r < 16; ++r) pmax = fmaxf(pmax, p1[r]);
  { auto rr = __builtin_amdgcn_permlane32_swap(__float_as_uint(pmax), __float_as_uint(pmax), false, false);
    pmax = fmaxf(__uint_as_float(rr[0]), __uint_as_float(rr[1])); }
  if (__builtin_expect(__all(pmax - m_reg <= THR / SCALE), 1)) { mn = m_reg; alpha = 1.f; }
  else { mn = fmaxf(m_reg, pmax); alpha = __builtin_amdgcn_exp2f((m_reg - mn) * C); m_reg = mn; }
  float mnC = -mn * C;
#pragma unroll
  for (int r = 0; r < 16; ++r) p0[r] = fmaf(p0[r], C, mnC);
#pragma unroll
  for (int r = 0; r < 16; ++r) p1[r] = fmaf(p1[r], C, mnC);
#pragma unroll
  for (int r = 0; r < 16; ++r) p0[r] = __builtin_amdgcn_exp2f(p0[r]);
}
__device__ __forceinline__ void finishSM(f32x16& p0, f32x16& p1, float alpha, float& l_reg, bf16x8& pa0, bf16x8& pa1, bf16x8& pa2, bf16x8& pa3) {
#pragma unroll
  for (int r = 0; r < 16; ++r) p1[r] = __builtin_amdgcn_exp2f(p1[r]);
  float ps = 0;
#pragma unroll
  for (int r = 0; r < 16; ++r) ps += p0[r];
#pragma unroll
  for (int r = 0; r < 16; ++r) ps += p1[r];
  { auto rr = __builtin_amdgcn_permlane32_swap(__float_as_uint(ps), __float_as_uint(ps), false, false);
    ps = __uint_as_float(rr[0]) + __uint_as_float(rr[1]); }
  l_reg = l_reg * alpha + ps;
#define PK4(P, BASE, OUT) do { unsigned a0 = cvtpk(P[BASE + 0], P[BASE + 1]), a1 = cvtpk(P[BASE + 2], P[BASE + 3]);   \
    unsigned b0 = cvtpk(P[BASE + 4], P[BASE + 5]), b1 = cvtpk(P[BASE + 6], P[BASE + 7]);                              \
    auto r0 = __builtin_amdgcn_permlane32_swap(a0, b0, false, false); auto r1 = __builtin_amdgcn_permlane32_swap(a1, b1, false, false); \
    u32x4 w = {r0[0], r1[0], r0[1], r1[1]}; OUT = *reinterpret_cast<bf16x8*>(&w); } while (0)
  PK4(p0, 0, pa0); PK4(p0, 8, pa1); PK4(p1, 0, pa2); PK4(p1, 8, pa3);
#undef PK4
}
__device__ __forceinline__ void qkt(f32x16& p0, f32x16& p1, const char* Ks, const bf16x8* qr, int r32, int hi) {
  p0 = f32x16{}; p1 = f32x16{};
#pragma unroll
  for (int d0 = 0; d0 < 8; ++d0) { int cb = (d0 * 16 + hi * 8) * 2;
    bf16x8 b0 = *reinterpret_cast<const bf16x8*>(Ks + KSWZ(r32, cb));
    bf16x8 b1 = *reinterpret_cast<const bf16x8*>(Ks + KSWZ(32 + r32, cb));
    p0 = __builtin_amdgcn_mfma_f32_32x32x16_bf16(b0, qr[d0], p0, 0, 0, 0);
    p1 = __builtin_amdgcn_mfma_f32_32x32x16_bf16(b1, qr[d0], p1, 0, 0, 0); }
}
__device__ __forceinline__ int v_st(int k, int c) { const int kk = (k & ~0xC) | ((k & 4) << 1) | ((k & 8) >> 1); return ((kk >> 3) * 4 + (c >> 5)) * 512 + ((kk & 7) * 32 + (c & 31)) * 2; }
__device__ __forceinline__ int v_rd_base(int lane) { return ((lane & 3) << 3) | (((lane >> 2) & 3) << 6) | (((lane >> 4) & 1) << 5) | (((lane >> 5) & 1) << 8); }
constexpr int v_rd_off(int d0, int ks, int half) { return d0 * 512 + ks * 4096 + half * 2048; }
template <int OFF> __device__ __forceinline__ s16x4 tr_read(int vb) {
  s16x4 r; asm volatile("ds_read_b64_tr_b16 %0, %1 offset:%2" : "=&v"(r) : "v"(vb), "i"(OFF) : "memory"); return r;
}
template <int D0> __device__ __forceinline__ void pv_one(f32x16& od, int vb, bf16x8 pa0, bf16x8 pa1, bf16x8 pa2, bf16x8 pa3) {
  const s16x4 l0 = tr_read<v_rd_off(D0, 0, 0)>(vb), h0 = tr_read<v_rd_off(D0, 0, 1)>(vb), l1 = tr_read<v_rd_off(D0, 1, 0)>(vb), h1 = tr_read<v_rd_off(D0, 1, 1)>(vb);
  const s16x4 l2 = tr_read<v_rd_off(D0, 2, 0)>(vb), h2 = tr_read<v_rd_off(D0, 2, 1)>(vb), l3 = tr_read<v_rd_off(D0, 3, 0)>(vb), h3 = tr_read<v_rd_off(D0, 3, 1)>(vb);
  asm volatile("s_waitcnt lgkmcnt(0)" ::: "memory"); SBAR();
#define PK(L, H) (bf16x8){L[0], L[1], L[2], L[3], H[0], H[1], H[2], H[3]}
  od = __builtin_amdgcn_mfma_f32_32x32x16_bf16(pa0, PK(l0, h0), od, 0, 0, 0);
  od = __builtin_amdgcn_mfma_f32_32x32x16_bf16(pa1, PK(l1, h1), od, 0, 0, 0);
  od = __builtin_amdgcn_mfma_f32_32x32x16_bf16(pa2, PK(l2, h2), od, 0, 0, 0);
  od = __builtin_amdgcn_mfma_f32_32x32x16_bf16(pa3, PK(l3, h3), od, 0, 0, 0);
#undef PK
}
__device__ __forceinline__ void pv_d0(f32x16* o, int vb, bf16x8 pa0, bf16x8 pa1, bf16x8 pa2, bf16x8 pa3) {
  pv_one<0>(o[0], vb, pa0, pa1, pa2, pa3); pv_one<1>(o[1], vb, pa0, pa1, pa2, pa3); pv_one<2>(o[2], vb, pa0, pa1, pa2, pa3); pv_one<3>(o[3], vb, pa0, pa1, pa2, pa3);
}
__device__ __forceinline__ void bmask(f32x16& p0, f32x16& p1, int dq0, int kj0, int hw, int L) {
  const float ninf = -__builtin_inff();
#pragma unroll
  for (int r = 0; r < 16; ++r) { const int c = (r & 3) + 8 * (r >> 2);
    const bool ok0 = ((unsigned)(dq0 + c + hw) <= (unsigned)(2 * hw)) && ((unsigned)(kj0 + c) < (unsigned)L);
    const bool ok1 = ((unsigned)(dq0 + c + 32 + hw) <= (unsigned)(2 * hw)) && ((unsigned)(kj0 + c + 32) < (unsigned)L);
    p0[r] = ok0 ? p0[r] : ninf; p1[r] = ok1 ? p1[r] : ninf; }
}
struct Band { int i0, L, hw, tlo; float m0, l0; float* lse; long lse_ld; };

template <bool BAND>
__device__ __forceinline__ void attn_body(const bf16_t* __restrict__ Qb, const bf16_t* __restrict__ Kh, const bf16_t* __restrict__ Vh, bf16_t* __restrict__ Ob,
                                          const long ldq, const long ldk, const long ldo, const int NT, const Band bd, char* lds) {
  int tid = threadIdx.x; asm volatile("" : "+v"(tid));
  const int wid = tid >> 6, lane = tid & 63, r32 = lane & 31, hi = lane >> 5;
  char* V_lds = lds; char* K_lds = lds + 2 * SHM_V;
  float* ws = (float*)(lds + 2 * SHM_V + 2 * SHM_K) + wid * 64; float* li_l = ws; float* al_l = ws + 32;
  float m_reg = BAND ? bd.m0 : -1e30f, l_reg = BAND ? bd.l0 : 0.f; f32x16 o[4] = {}; bf16x8 qr[8];
  const bf16_t* Qw = Qb + (long)(wid * QBLK + r32) * ldq + hi * 8;
#pragma unroll
  for (int d0 = 0; d0 < 8; ++d0) qr[d0] = *reinterpret_cast<const bf16x8*>(Qw + d0 * 16);
  const int sr = tid >> 4, sc = (tid & 15) * 8, vst0 = v_st(sr, sc), vst1 = v_st(32 + sr, sc);
  const int vb0 = (int)(uintptr_t)V_lds + v_rd_base(lane);
  const int qi = BAND ? bd.i0 + wid * QBLK + r32 : 0;
  struct { bf16x8 vs0, vs1, ks0, ks1; } sr_[2];
#define KROW(k) (BAND ? (long)min(max((k), 0), bd.L - 1) : (long)(k))
#define SLOAD(i, jt) do { const int k0_ = (BAND ? bd.tlo + (jt) : (jt)) * KVBLK; const long ra_ = KROW(k0_ + sr) * ldk + sc, rb_ = KROW(k0_ + 32 + sr) * ldk + sc; \
    sr_[i].vs0 = *reinterpret_cast<const bf16x8*>(Vh + ra_); sr_[i].vs1 = *reinterpret_cast<const bf16x8*>(Vh + rb_); \
    sr_[i].ks0 = *reinterpret_cast<const bf16x8*>(Kh + ra_); sr_[i].ks1 = *reinterpret_cast<const bf16x8*>(Kh + rb_); } while (0)
#define SWRITE(b, i) do { *(bf16x8*)(V_lds + (b) * SHM_V + vst0) = sr_[i].vs0;          \
    *(bf16x8*)(V_lds + (b) * SHM_V + vst1) = sr_[i].vs1; int kc = sc * 2;               \
    *(bf16x8*)(K_lds + (b) * SHM_K + KSWZ(sr, kc)) = sr_[i].ks0;                       \
    *(bf16x8*)(K_lds + (b) * SHM_K + KSWZ(32 + sr, kc)) = sr_[i].ks1; } while (0)
#define SWAIT() asm volatile("s_waitcnt vmcnt(4)" ::: "memory")
#define RESC(a) do { if (__any((a) < 1.f)) { if (hi == 0) al_l[r32] = (a); asm volatile("s_waitcnt lgkmcnt(0)" ::: "memory"); \
    _Pragma("unroll") for (int d = 0; d < 4; ++d) _Pragma("unroll") for (int r = 0; r < 16; ++r) o[d][r] *= al_l[crow(r, hi)]; } } while (0)
#define BMASK(P0, P1, jt) do { if (BAND) { const int kt_ = (bd.tlo + (jt)) * KVBLK + 4 * hi; bmask(P0, P1, kt_ - qi, kt_, bd.hw, bd.L); } } while (0)
  f32x16 pA0, pA1, pB0, pB1; float mnA, mnB, alA, alB; bf16x8 pa0, pa1, pa2, pa3;
  constexpr int SE = 0, SO = 1;
  SLOAD(SE, 0); asm volatile("s_waitcnt vmcnt(0)" ::: "memory"); SWRITE(0, SE); __syncthreads();
  qkt(pA0, pA1, K_lds, qr, r32, hi); BMASK(pA0, pA1, 0); partialSM(pA0, pA1, m_reg, mnA, alA);
  SLOAD(SO, 1); if (2 < NT) SLOAD(SE, 2);
  SWAIT(); SWRITE(1, SO); __syncthreads();
  for (int j = 1; j + 1 < NT; j += 2) {
    SBAR(); qkt(pB0, pB1, K_lds + SHM_K, qr, r32, hi);
    finishSM(pA0, pA1, alA, l_reg, pa0, pa1, pa2, pa3); SBAR();
    SLOAD(SO, j + 2); SBAR();
    pv_d0(o, vb0, pa0, pa1, pa2, pa3); BMASK(pB0, pB1, j); partialSM(pB0, pB1, m_reg, mnB, alB);
    __syncthreads(); SWAIT(); SWRITE(0, SE);
    RESC(alB); __syncthreads();
    SBAR(); qkt(pA0, pA1, K_lds, qr, r32, hi);
    finishSM(pB0, pB1, alB, l_reg, pa0, pa1, pa2, pa3); SBAR();
    if (j + 3 < NT) SLOAD(SE, j + 3); SBAR();
    pv_d0(o, vb0 + (int)SHM_V, pa0, pa1, pa2, pa3); BMASK(pA0, pA1, j + 1); partialSM(pA0, pA1, m_reg, mnA, alA);
    __syncthreads(); SWAIT(); SWRITE(1, SO);
    RESC(alA); __syncthreads();
  }
  SBAR(); qkt(pB0, pB1, K_lds + SHM_K, qr, r32, hi);
  finishSM(pA0, pA1, alA, l_reg, pa0, pa1, pa2, pa3); SBAR();
  pv_d0(o, vb0, pa0, pa1, pa2, pa3); BMASK(pB0, pB1, NT - 1); partialSM(pB0, pB1, m_reg, mnB, alB);
  __syncthreads(); RESC(alB);
  finishSM(pB0, pB1, alB, l_reg, pa0, pa1, pa2, pa3); SBAR();
  pv_d0(o, vb0 + (int)SHM_V, pa0, pa1, pa2, pa3);
  if (hi == 0) li_l[r32] = l_reg; asm volatile("s_waitcnt lgkmcnt(0)" ::: "memory");
  float rli[16];
#pragma unroll
  for (int r = 0; r < 16; ++r) rli[r] = __builtin_amdgcn_rcpf(li_l[crow(r, hi)]);
  bf16_t* Ow = Ob + (long)(wid * QBLK) * ldo;
  const int odd = lane & 1;
#pragma unroll
  for (int r = 0; r < 16; r += 2) { const long orow = crow(r, hi) + odd;
#pragma unroll
    for (int d0 = 0; d0 < 4; ++d0) { const float a = o[d0][r] * rli[r], b = o[d0][r + 1] * rli[r + 1];
      const float snd = odd ? a : b;
      const float rcv = __int_as_float(__builtin_amdgcn_mov_dpp(__float_as_int(snd), 0xB1, 0xF, 0xF, true));
      const unsigned pk = odd ? cvtpk(rcv, b) : cvtpk(a, rcv);
      *(unsigned*)(Ow + orow * ldo + d0 * 32 + (r32 & ~1)) = pk; } }
  if (BAND) { if (bd.lse != nullptr && hi == 0) bd.lse[(long)(wid * QBLK + r32) * bd.lse_ld] = m_reg * SCALE + __logf(l_reg); }
  __syncthreads();
#undef KROW
#undef SLOAD
#undef SWRITE
#undef SWAIT
#undef RESC
#undef BMASK
}
}

constexpr size_t MiB = 1u << 20;
constexpr size_t WS_CTL = 0;
constexpr int NSS = 3 * DEPTH + 1;
constexpr size_t CTL_ZERO_BYTES = 1 * MiB;
constexpr size_t WS_ROPE = 1 * MiB;
constexpr size_t WS_ROPEX = 9 * MiB;
constexpr size_t WS_LSE = 10 * MiB;
constexpr size_t WS_SS = 12 * MiB;
constexpr size_t WS_W = 32 * MiB;
static_assert(WS_SS + (size_t)NSS * M * 8 * 4 <= WS_W, "ssq buffers");
constexpr size_t WO_F1IN = 0, WO_F1OUT = WO_F1IN + (size_t)NFF2 * DM * 2, WO_PG = WO_F1OUT + (size_t)DM * DFF * 2, WO_BR = WO_PG + (size_t)PGW * DM * 2,
                 WO_WO = WO_BR + (size_t)DM * DM * 2, WO_F2IN = WO_WO + (size_t)DM * DM * 2, WO_F2OUT = WO_F2IN + (size_t)NFF2 * DM * 2, W_BYTES = WO_F2OUT + (size_t)DM * DFF * 2;
constexpr size_t WS_HI = WS_W + ((W_BYTES + MiB - 1) / MiB) * MiB;
constexpr size_t WS_LO = WS_HI + (size_t)M * DM * 2;
constexpr size_t WS_Y = WS_LO + (size_t)M * DM * 2;
constexpr size_t WS_BIG = WS_Y + (size_t)M * DM * 2;
constexpr size_t WS_PROJ = WS_BIG, WS_GATES = WS_BIG + (size_t)M * INW * 2, WS_MERGED = WS_PROJ;
constexpr size_t WS_END = WS_GATES + (size_t)M * GATEW * 2;
static_assert((size_t)M * DFF * 2 <= WS_END - WS_BIG, "act fits the overlay");
constexpr int CW_BAR = 4096;

constexpr int RING_OFF = 0, RING_BYTES = 131072;
constexpr int LDSCTL_OFF = RING_BYTES, MISC_OFF = LDSCTL_OFF + 320, HTAB_OFF = LDSCTL_OFF + 1024;
constexpr int LDS_BYTES = 147456;
constexpr int NWAVES = 8;

typedef GAS unsigned gu32;
#define RLX_AGENT __ATOMIC_RELAXED, __HIP_MEMORY_SCOPE_AGENT
#define LDS_WAIT() asm volatile("s_waitcnt lgkmcnt(0)" ::: "memory")

#define XB_TMO      128
#define XB_XCNT(j)  (256  + 64 * (j))
#define XB_XSUB(j)  (1280 + 64 * (j))
#define XB_XGEN(j)  (2304 + 64 * (j))
#define XB_TOP      3328
#define XB_TOPGEN   3392
#define XCD_BAR_WORDS 3456
#define XB_SPIN_CAP (1u << 22)
__device__ __forceinline__ unsigned xb_ld(unsigned* p)              { return __hip_atomic_load(p, __ATOMIC_RELAXED, __HIP_MEMORY_SCOPE_AGENT); }
__device__ __forceinline__ unsigned xb_add(unsigned* p, unsigned v) { return __hip_atomic_fetch_add(p, v, __ATOMIC_RELAXED, __HIP_MEMORY_SCOPE_AGENT); }
__device__ __forceinline__ unsigned xb_xcc_id() { return (unsigned)__builtin_amdgcn_s_getreg((3 << 11) | 20) & 0xFu; }
#define XB_SPIN(cond, bar) do { unsigned _sp = 0; while (cond) { __builtin_amdgcn_s_sleep(1); \
    if ((++_sp & 255u) == 0u) { if (xb_ld(&(bar)[XB_TMO])) break; if (_sp > XB_SPIN_CAP) { atomicAdd(&(bar)[XB_TMO], 1u); break; } } } } while (0)
struct XcdBarrier { unsigned* bar; unsigned x; volatile LAS unsigned* st; };
__device__ __forceinline__ XcdBarrier xcd_barrier_post(unsigned* bar, volatile LAS unsigned* st) {
    XcdBarrier b; b.bar = bar; b.x = xb_xcc_id(); b.st = st;
    if (threadIdx.x == 0) (void)xb_add(&bar[XB_XCNT(b.x)], 1u);
    return b;
}
__device__ __forceinline__ void xcd_barrier_complete(unsigned* bar, unsigned x, unsigned& nloc, unsigned& nx) {
    const unsigned G = gridDim.x * gridDim.y * gridDim.z;
    unsigned sum, cnt, mine, sp = 0u;
    for (;;) {
        sum = 0u; cnt = 0u; mine = 0u;
#pragma unroll
        for (unsigned j = 0; j < 16; ++j) { const unsigned c = xb_ld(&bar[XB_XCNT(j)]); sum += c; cnt += (c > 0u) ? 1u : 0u; mine = (j == x) ? c : mine; }
        if (sum == G) break;
        __builtin_amdgcn_s_sleep(1);
        if ((++sp & 255u) == 0u) { if (xb_ld(&bar[XB_TMO])) break; if (sp > XB_SPIN_CAP) { atomicAdd(&bar[XB_TMO], 1u); break; } }
    }
    nloc = mine > 0u ? mine : 1u; nx = cnt > 0u ? cnt : 1u;
}
__device__ __forceinline__ void xcd_barrier(const XcdBarrier& b) {
    asm volatile("s_waitcnt vmcnt(0)" ::: "memory");
    __syncthreads();
    if (threadIdx.x == 0) {
        unsigned* bar = b.bar;
        __builtin_amdgcn_s_waitcnt(0);
        unsigned nloc = b.st[0], nx = b.st[1];
        if (nloc == 0u) { xcd_barrier_complete(bar, b.x, nloc, nx); b.st[0] = nloc; b.st[1] = nx; }
        const unsigned old = xb_add(&bar[XB_XSUB(b.x)], 1u);
        const unsigned gen = old / nloc;
        if (old + 1u == (gen + 1u) * nloc) {
            __builtin_amdgcn_fence(__ATOMIC_RELEASE, "agent");
            asm volatile("s_waitcnt vmcnt(0)" ::: "memory");
            const unsigned og = xb_add(&bar[XB_TOP], 1u);
            const unsigned tg = og / nx;
            if (og + 1u == (tg + 1u) * nx) xb_add(&bar[XB_TOPGEN], 1u);
            else XB_SPIN(xb_ld(&bar[XB_TOPGEN]) == tg, bar);
            __builtin_amdgcn_fence(__ATOMIC_ACQUIRE, "agent");
            xb_add(&bar[XB_XGEN(b.x)], 1u);
            asm volatile("s_waitcnt vmcnt(0)" ::: "memory");
        } else {
            XB_SPIN(xb_ld(&bar[XB_XGEN(b.x)]) == gen, bar);
            __builtin_amdgcn_fence(__ATOMIC_ACQUIRE, "agent");
            asm volatile("s_waitcnt vmcnt(0)" ::: "memory");
        }
    }
    __syncthreads();
}

__device__ __forceinline__ float wave_sum(float v) {
#pragma unroll
    for (int o = 1; o < 64; o <<= 1) v += __shfl_xor(v, o);
    return v;
}
__device__ __forceinline__ int w_in_row(int n) {
    const int d = n & 127, hb = n & ~127;
    const bool plain = (n >= COL_VA && n < COL_QB) || (n >= COL_VB && n < COL_QC) || (n >= COL_VC), axial = (n >= COL_QC && n < COL_VC);
    const int cs = 2 * (d & 63) + (d >> 6), ca = 2 * ((d & 31) + 32 * (d >> 6)) + ((d >> 5) & 1);
    return FUSE_PREP ? hb + (plain ? d : (axial ? ca : cs)) : n;
}
template <bool MAPIN>
__device__ __forceinline__ void transpose_item(const float* W, int K, int N, bf16_t* WT, int k0, int n0, int drow, const float* gain, LAS float* scr, int lane) {
#pragma unroll 8
    for (int i = 0; i < 32; ++i) { const int kk = 2 * i + (lane >> 5); float w = W[(size_t)(k0 + kk) * N + n0 + (lane & 31)]; if (gain) w *= gain[k0 + kk]; scr[kk * 33 + (lane & 31)] = w; }
    LDS_WAIT(); asm volatile("" ::: "memory");
    const int c = lane & 7;
#pragma unroll
    for (int j = 0; j < 4; ++j) { const int n = (lane >> 3) + 8 * j; const LAS float* s = scr + (8 * c) * 33 + n;
        u32x4 o; o.x = pk2(s[0 * 33], s[1 * 33]); o.y = pk2(s[2 * 33], s[3 * 33]); o.z = pk2(s[4 * 33], s[5 * 33]); o.w = pk2(s[6 * 33], s[7 * 33]);
        const int dr = MAPIN ? w_in_row(n0 + n) : drow + n;
        *(GAS u32x4*)(WT + (size_t)dr * K + k0 + 8 * c) = o; }
    LDS_WAIT(); asm volatile("" ::: "memory");
}
__device__ __forceinline__ void sincos_d(double a, float& s, float& c) {
    const double q = rint(a * 0.63661977236758134308);
    double y = fma(-q, 1.5707963267948966192, a); y = fma(-q, 6.123233995736766e-17, y);
    const double y2 = y * y;
    double sp = 1.0 / 6227020800.0; sp = fma(sp, y2, -1.0 / 39916800.0); sp = fma(sp, y2, 1.0 / 362880.0); sp = fma(sp, y2, -1.0 / 5040.0); sp = fma(sp, y2, 1.0 / 120.0); sp = fma(sp, y2, -1.0 / 6.0); sp = fma(sp, y2, 1.0);
    const double sy = y * sp;
    double cp = -1.0 / 87178291200.0; cp = fma(cp, y2, 1.0 / 479001600.0); cp = fma(cp, y2, -1.0 / 3628800.0); cp = fma(cp, y2, 1.0 / 40320.0); cp = fma(cp, y2, -1.0 / 720.0); cp = fma(cp, y2, 1.0 / 24.0); cp = fma(cp, y2, -0.5); cp = fma(cp, y2, 1.0);
    const int k = (int)q & 3;
    const double ss = (k & 1) ? cp : sy, cc = (k & 1) ? sy : cp;
    s = (float)((k & 2) ? -ss : ss); c = (float)(((k + 1) & 2) ? -cc : cc);
}

struct Args { const float* in[18]; float* out; unsigned char* ws; int ph_lo, ph_hi; };
constexpr int PH_PER_STEP = 10, PH_FINAL = NSTEP * PH_PER_STEP, PH_END = PH_FINAL + 1;

__global__ void __launch_bounds__(NWAVES * 64, 2) fwd_kernel(Args args) {
    extern __shared__ __attribute__((aligned(16))) unsigned char lds[];
    LAS unsigned char* ldsl = (LAS unsigned char*)lds;
    volatile LAS unsigned* MISC = (volatile LAS unsigned*)(ldsl + MISC_OFF);
    const int G = gridDim.x; const int bx = blockIdx.x;
    const int vcu = (G % 8 == 0) ? (bx % 8) * (G / 8) + bx / 8 : bx;
    unsigned char* ws = args.ws;
    gu32* ctl = (gu32*)(ws + WS_CTL);
    for (int u = threadIdx.x; u < (LDS_BYTES - LDSCTL_OFF) / 4; u += NWAVES * 64) ((LAS unsigned*)(ldsl + LDSCTL_OFF))[u] = 0u;
    __syncthreads();
    const int lo = args.ph_lo, hi = args.ph_hi;
    const bool one_launch = (hi - lo) > 1;
    XcdBarrier bar; bar.bar = (unsigned*)(ctl + CW_BAR); bar.x = 0; bar.st = nullptr;
    if (one_launch) bar = xcd_barrier_post((unsigned*)(ctl + CW_BAR), MISC + 8);
    bool first = true;
#ifndef PH_MASK
#define PH_MASK 0xFFFF
#endif
#define PHASE_BEGIN(p) if (((PH_MASK >> ((p) == PH_FINAL ? 10 : (p) % PH_PER_STEP)) & 1) && lo <= (p) && (p) < hi) { if (!first) xcd_barrier(bar); first = false; \
    for (int rep_ = 0; rep_ <= ((REP_MASK >> ((p) == PH_FINAL ? 10 : (p) % PH_PER_STEP)) & 1); ++rep_) {
#define PHASE_END } }

    const float* xp = args.in[0]; const float* xs = args.in[1];
    float* out = args.out;
    f32x2* rope = (f32x2*)(ws + WS_ROPE); f32x2* ropex = (f32x2*)(ws + WS_ROPEX);
    float* lseb = (float*)(ws + WS_LSE); float* ssb = (float*)(ws + WS_SS);
    bf16_t* HI = (bf16_t*)(ws + WS_HI); bf16_t* LO = (bf16_t*)(ws + WS_LO); bf16_t* Y = (bf16_t*)(ws + WS_Y); bf16_t* MERGED = (bf16_t*)(ws + WS_MERGED);
    bf16_t* ACT = (bf16_t*)(ws + WS_BIG); bf16_t* PROJ = (bf16_t*)(ws + WS_PROJ); bf16_t* GATES = (bf16_t*)(ws + WS_GATES);
    bf16_t* Wb = (bf16_t*)(ws + WS_W);
    const int NGW = G * NWAVES;
#define LOCAL_IDS int tid = threadIdx.x; asm volatile("" : "+v"(tid)); const int lane = tid & 63, wave = __builtin_amdgcn_readfirstlane(tid >> 6), gw = vcu * NWAVES + wave; (void)lane; (void)gw;
    if (lo == 0) {
        int tid = threadIdx.x; asm volatile("" : "+v"(tid));
        const int gt = vcu * NWAVES * 64 + tid, NGT = G * NWAVES * 64;
        for (int e = gt; e < S_P * 64 + 256 * 32; e += NGT) {
            const bool ax = e >= S_P * 64; const int ee = ax ? e - S_P * 64 : e; const int pos = ax ? ee >> 5 : ee >> 6, i = ax ? ee & 31 : ee & 63;
            const double base = ax ? 0.7498942093324559 : 0.8659643233600653; double inv = 1.0; double bp = base; int ii = i;
            for (int b = 0; b < 6; ++b) { if (ii & 1) inv *= bp; bp *= bp; ii >>= 1; }
            float sn, cs; sincos_d((double)pos * inv, sn, cs);
            (ax ? ropex : rope)[ee] = (f32x2){cs, sn};
        }
    }

    for (int s = 0; s < NSTEP; ++s) {
        const int l = s >> 1, which = s & 1, pb = s * PH_PER_STEP;
        if (which == 0) {
        PHASE_BEGIN(pb + 0)
            LOCAL_IDS
            {
                LAS float* scr = (LAS float*)(ldsl + RING_OFF + wave * 16384);
                constexpr int I_FIN = (DM / 64) * (NFF2 / 32), I_FOUT = (DFF / 64) * (DM / 32), I_IN = (DM / 64) * (INW / 32), I_GT = (DM / 64) * (GATEW / 32), I_SQ = (DM / 64) * (DM / 32);
                constexpr int NITEMS = 2 * I_FIN + 2 * I_FOUT + I_IN + I_GT + 2 * I_SQ;
                const float* w_f1in = args.in[3] + (size_t)l * DM * NFF2; const float* w_f1out = args.in[4] + (size_t)l * DFF * DM;
                const float* w_in = args.in[6] + (size_t)l * DM * INW; const float* w_br = args.in[10] + (size_t)l * DM * DM;
                const float* w_gt = args.in[11] + (size_t)l * DM * GATEW; const float* w_o = args.in[13] + (size_t)l * DM * DM;
                const float* w_f2in = args.in[15] + (size_t)l * DM * NFF2; const float* w_f2out = args.in[16] + (size_t)l * DFF * DM;
                const float* g1 = args.in[2] + (size_t)l * DM; const float* gm = args.in[5] + (size_t)l * DM; const float* g2 = args.in[14] + (size_t)l * DM;
                for (int it = gw; it < NITEMS; it += NGW) {
                    int r = it;
                    if (r < 2 * I_FIN) { const bool sec = r >= I_FIN; if (sec) r -= I_FIN; const int nblk = NFF2 / 32, kb = r / nblk, nb = r % nblk, n0 = nb * 32;
                        const int half = n0 >= DFF ? 1 : 0, rem = n0 - half * DFF, drow = (rem >> 7) * 256 + half * 128 + (rem & 127);
                        transpose_item<false>(sec ? w_f2in : w_f1in, DM, NFF2, (bf16_t*)((char*)Wb + (sec ? WO_F2IN : WO_F1IN)), kb * 64, n0, drow, sec ? g2 : g1, scr, lane); continue; }
                    r -= 2 * I_FIN;
                    if (r < 2 * I_FOUT) { const bool sec = r >= I_FOUT; if (sec) r -= I_FOUT; const int nblk = DM / 32, kb = r / nblk, nb = r % nblk;
                        transpose_item<false>(sec ? w_f2out : w_f1out, DFF, DM, (bf16_t*)((char*)Wb + (sec ? WO_F2OUT : WO_F1OUT)), kb * 64, nb * 32, nb * 32, nullptr, scr, lane); continue; }
                    r -= 2 * I_FOUT;
                    if (r < I_IN) { const int nblk = INW / 32, kb = r / nblk, nb = r % nblk;
                        transpose_item<true>(w_in, DM, INW, (bf16_t*)((char*)Wb + WO_PG), kb * 64, nb * 32, 0, gm, scr, lane); continue; }
                    r -= I_IN;
                    if (r < I_GT) { const int nblk = GATEW / 32, kb = r / nblk, nb = r % nblk;
                        transpose_item<false>(w_gt, DM, GATEW, (bf16_t*)((char*)Wb + WO_PG), kb * 64, nb * 32, INW + nb * 32, gm, scr, lane); continue; }
                    r -= I_GT;
                    { const bool sec = r >= I_SQ; if (sec) r -= I_SQ; const int nblk = DM / 32, kb = r / nblk, nb = r % nblk;
                        transpose_item<false>(sec ? w_o : w_br, DM, DM, (bf16_t*)((char*)Wb + (sec ? WO_WO : WO_BR)), kb * 64, nb * 32, nb * 32, nullptr, scr, lane); }
                }
            }
            if (s == 0) {
                for (int m = gw; m < M; m += NGW) {
                    const float* xrow = m < S_P ? xp + (size_t)m * DM : xs + (size_t)(m - S_P) * DM;
                    const GAS f32x4* xr = (const GAS f32x4*)xrow + lane; f32x4 v[8]; float sq = 0.f;
#pragma unroll
                    for (int j = 0; j < 8; ++j) { v[j] = xr[64 * j]; sq += (v[j].x * v[j].x + v[j].y * v[j].y) + (v[j].z * v[j].z + v[j].w * v[j].w); }
                    sq = wave_sum(sq); if (lane == 0) { *(f32x4*)(ssb + (size_t)m * 8) = (f32x4){sq, 0.f, 0.f, 0.f}; *(f32x4*)(ssb + (size_t)m * 8 + 4) = (f32x4){0.f, 0.f, 0.f, 0.f}; }
                    GAS u32x2* oh = (GAS u32x2*)(HI + (size_t)m * DM) + lane; GAS u32x2* ol = (GAS u32x2*)(LO + (size_t)m * DM) + lane;
#pragma unroll
                    for (int j = 0; j < 8; ++j) { const u32x2 h = (u32x2){cvt_pk_bf16(v[j].x, v[j].y), cvt_pk_bf16(v[j].z, v[j].w)};
                        oh[64 * j] = h; ol[64 * j] = (u32x2){cvt_pk_bf16(v[j].x - bf_lo(h.x), v[j].y - bf_hi(h.x)), cvt_pk_bf16(v[j].z - bf_lo(h.y), v[j].w - bf_hi(h.y))}; }
                }
            }
        PHASE_END
        }
        PHASE_BEGIN(pb + 1)
            pg8::PlainSched S; S.so.init(M, NFF2, G, bx, 8); S.nt = DM / 64;
            pg8::EpiSwiglu E{ACT, ssb + (size_t)(3 * l + 2 * which) * M * 8};
            pg8::gemm_phase<pg8::EpiSwiglu, pg8::PlainSched>(ldsl + RING_OFF, HI, (const bf16_t*)((char*)Wb + (which ? WO_F2IN : WO_F1IN)), DM, S, E);
        PHASE_END
        PHASE_BEGIN(pb + 2)
            pg8::PlainSched S; S.so.init(M, DM, G, bx, 4); S.nt = DFF / 64;
            pg8::EpiStream E{HI, LO, ssb + (size_t)(3 * l + 1 + 2 * which) * M * 8, rep_ == ((REP_MASK >> 2) & 1) ? 0.5f : 0.f, (LAS float*)(ldsl + HTAB_OFF)};
            pg8::gemm_phase<pg8::EpiStream, pg8::PlainSched>(ldsl + RING_OFF, ACT, (const bf16_t*)((char*)Wb + (which ? WO_F2OUT : WO_F1OUT)), DFF, S, E);
        PHASE_END
        if (which == 0) {
        PHASE_BEGIN(pb + 4)
            pg8::PlainSched S; S.so.init(M, PGW, G, bx, 8); S.nt = DM / 64;
            pg8::EpiProjGate E{PROJ, GATES, args.in[12] + (size_t)l * GATEW, ssb + (size_t)(3 * l + 1) * M * 8, rope, ropex, args.in[8] + (size_t)l * 128, args.in[9] + (size_t)l * 128, (LAS float*)(ldsl + HTAB_OFF)};
            pg8::gemm_phase<pg8::EpiProjGate, pg8::PlainSched>(ldsl + RING_OFF, HI, (const bf16_t*)((char*)Wb + WO_PG), DM, S, E);
        PHASE_END
        if (!FUSE_PREP) { PHASE_BEGIN(pb + 5)
            LOCAL_IDS
            const float* gq = args.in[8] + (size_t)l * 128; const float* gk = args.in[9] + (size_t)l * 128;
            const int e1x = (lane >> 5) * 64 + (lane & 31), e2x = e1x + 32;
            const float gq1 = gq[e1x], gq2 = gq[e2x], gk1 = gk[e1x], gk2 = gk[e2x];
            const float pz = rep_ == ((REP_MASK >> 5) & 1) ? 1.f : 0.f, pk = 1.f - pz;
            for (int m = gw; m < M; m += NGW) {
                const int pos = m < S_P ? m : (m & (S_S - 1));
                const f32x2 cs = rope[pos * 64 + lane];
                const int idx = (lane >> 5) ? (pos & 63) : (pos >> 6);
                const f32x2 cx = ropex[idx * 32 + (lane & 31)];
                bf16_t* row = PROJ + (size_t)m * INW;
#pragma unroll 6
                for (int hh = 0; hh < 18; ++hh) {
                    bf16_t* hp = row + (hh < 6 ? hh * 128 : COL_QB + (hh - 6) * 128);
                    const float x1 = __uint_as_float((unsigned)hp[lane] << 16), x2 = __uint_as_float((unsigned)hp[lane + 64] << 16);
                    hp[lane] = (bf16_t)f2bf(REP_MASK ? pk * x1 + pz * (x1 * cs.x - x2 * cs.y) : x1 * cs.x - x2 * cs.y); hp[lane + 64] = (bf16_t)f2bf(REP_MASK ? pk * x2 + pz * (x2 * cs.x + x1 * cs.y) : x2 * cs.x + x1 * cs.y);
                }
#pragma unroll 4
                for (int hh = 0; hh < 8; ++hh) {
                    bf16_t* hp = row + COL_QC + hh * 128;
                    const float x1 = __uint_as_float((unsigned)hp[e1x] << 16), x2 = __uint_as_float((unsigned)hp[e2x] << 16);
                    const float rstd = 1.0f / sqrtf(wave_sum(x1 * x1 + x2 * x2) * (1.0f / 128.0f) + NORM_EPS);
                    const float y1 = x1 * rstd * (hh < 6 ? gq1 : gk1), y2 = x2 * rstd * (hh < 6 ? gq2 : gk2);
                    hp[e1x] = (bf16_t)f2bf(REP_MASK ? pk * x1 + pz * (y1 * cx.x - y2 * cx.y) : y1 * cx.x - y2 * cx.y); hp[e2x] = (bf16_t)f2bf(REP_MASK ? pk * x2 + pz * (y2 * cx.x + y1 * cx.y) : y2 * cx.x + y1 * cx.y);
                }
            }
        PHASE_END }
        PHASE_BEGIN(pb + 6)
            char* alds = (char*)lds + RING_OFF;
            att::Band nob{0, 0, 0, 0, -1e30f, 0.f, nullptr, 0};
            for (int v = vcu; v < 256; v += G) {
                const bool pr = v < 128;
                const int nun = pr ? 3 : 6, x = (v - 128) >> 5, qb = pr ? (v & 63) : (v & 31);
                for (int r6 = 0; r6 < nun; ++r6) {
                    const int pair = x * 2 + r6 / 3, sq = pair >> 1, kvh = pr ? (v >> 6) : (pair & 1), h = kvh * 3 + (r6 % 3);
                    const size_t sb = pr ? 0 : (size_t)S_P + (size_t)sq * S_S, r0 = sb + (size_t)qb * 256;
                    att::attn_body<false>(PROJ + r0 * INW + COL_QC + h * 128, PROJ + sb * INW + COL_KC + kvh * 128, PROJ + sb * INW + COL_VC + kvh * 128, Y + r0 * DM + YCOL_C + h * 128, INW, INW, DM, pr ? S_P / 64 : S_S / 64, nob, alds);
                }
            }
            const float* sink = args.in[7] + (size_t)l * 4;
            for (int u = vcu; u < 768 + 1152; u += G) {
                const bool isA = u < 768; const int ub = u - 768;
                const int hh = isA ? (u & 3) : ub % 6, blk = isA ? (u >> 2) : ub / 6, dil = isA ? 1 : (hh < 2 ? 1 : (hh < 4 ? 4 : 16));
                const int R0 = blk * 256; const int sb = R0 < S_P ? 0 : S_P + ((R0 - S_P) / S_S) * S_S, Ls = R0 < S_P ? S_P : S_S;
                const int bis = (R0 - sb) / 256, L = Ls / dil, nbr = L / 256, res = bis / nbr, i0 = (bis - res * nbr) * 256;
                const size_t t0 = (size_t)sb + res + (size_t)i0 * dil;
                att::Band bd; bd.i0 = i0; bd.L = L; bd.hw = isA ? 128 : 64; bd.tlo = i0 / 64 - (isA ? 2 : 1); bd.m0 = isA ? sink[hh] * (1.0f / att::SCALE) : -1e30f; bd.l0 = isA ? 1.0f : 0.f;
                bd.lse = isA ? nullptr : lseb + t0 * 8 + hh; bd.lse_ld = (long)8 * dil;
                const bf16_t* pb_ = PROJ + ((size_t)sb + res) * INW;
                const int cq = isA ? COL_QA + hh * 128 : COL_QB + hh * 128, ck = isA ? COL_KA + (hh >> 1) * 128 : COL_KB + hh * 128, cv = isA ? COL_VA + (hh >> 1) * 128 : COL_VB + hh * 128;
                att::attn_body<true>(PROJ + t0 * INW + cq, pb_ + ck, pb_ + cv, Y + t0 * DM + (isA ? YCOL_A : YCOL_B) + hh * 128, (long)INW * dil, (long)INW * dil, (long)DM * dil, isA ? 8 : 6, bd, alds);
            }
        PHASE_END
        PHASE_BEGIN(pb + 7)
            LOCAL_IDS
            for (int m = gw; m < M; m += NGW) {
                const float* lp = lseb + (size_t)m * 8;
                const f32x4 l03 = *(const f32x4*)lp; const f32x2 l45 = *(const f32x2*)(lp + 4);
                const int j = lane >> 5;
                const float a = j ? l03.y : l03.x, b = j ? l03.w : l03.z, c = j ? l45.y : l45.x, mx = fmaxf(a, fmaxf(b, c));
                const float ea = __expf(a - mx), eb = __expf(b - mx), ec = __expf(c - mx), inv = 1.0f / (ea + eb + ec);
                const float w0 = ea * inv, w1 = eb * inv, w2 = ec * inv;
                GAS u32x2* yp = (GAS u32x2*)(Y + (size_t)m * DM + YCOL_B);
#pragma unroll
                for (int k = 0; k < 3; ++k) { const int uu = lane + 64 * k;
                    float sc = k == 0 ? w0 : (k == 1 ? w1 : w2); if (REP_MASK && rep_ != ((REP_MASK >> 7) & 1)) sc = 1.0f;
                    const u32x2 v = yp[uu]; yp[uu] = (u32x2){cvt_pk_bf16(bf_lo(v.x) * sc, bf_hi(v.x) * sc), cvt_pk_bf16(bf_lo(v.y) * sc, bf_hi(v.y) * sc)}; }
            }
        PHASE_END
        PHASE_BEGIN(pb + 8)
            pg8::ChainSched S; S.so.init(M, DM, G, bx, 4);
            pg8::EpiBranch E{GATES, MERGED};
            pg8::gemm_phase<pg8::EpiBranch, pg8::ChainSched>(ldsl + RING_OFF, Y, (const bf16_t*)((char*)Wb + WO_BR), DM, S, E);
        PHASE_END
        PHASE_BEGIN(pb + 9)
            pg8::PlainSched S; S.so.init(M, DM, G, bx, 4); S.nt = DM / 64;
            pg8::EpiStream E{HI, LO, ssb + (size_t)(3 * l + 2) * M * 8, rep_ == ((REP_MASK >> 9) & 1) ? 1.0f : 0.f, (LAS float*)(ldsl + HTAB_OFF)};
            pg8::gemm_phase<pg8::EpiStream, pg8::PlainSched>(ldsl + RING_OFF, MERGED, (const bf16_t*)((char*)Wb + WO_WO), DM, S, E);
        PHASE_END
        }
    }
    PHASE_BEGIN(PH_FINAL)
        LOCAL_IDS
        const float* g = args.in[17]; const float* ssf = ssb + (size_t)(NSS - 1) * M * 8;
        f32x4 gv[8];
#pragma unroll
        for (int j = 0; j < 8; ++j) gv[j] = ((const f32x4*)g)[lane + 64 * j];
        for (int m = gw; m < M; m += NGW) {
            const float rstd = 1.0f / sqrtf(row_ssq(ssf, m) * (1.0f / DM) + NORM_EPS);
            const GAS u32x2* ph = (const GAS u32x2*)(HI + (size_t)m * DM) + lane; const GAS u32x2* pl = (const GAS u32x2*)(LO + (size_t)m * DM) + lane;
            GAS f32x4* xr = (GAS f32x4*)(out + (size_t)m * DM) + lane;
#pragma unroll
            for (int j = 0; j < 8; ++j) { const u32x2 h = ph[64 * j], w = pl[64 * j];
                const f32x4 x = (f32x4){bf_lo(h.x) + bf_lo(w.x), bf_hi(h.x) + bf_hi(w.x), bf_lo(h.y) + bf_lo(w.y), bf_hi(h.y) + bf_hi(w.y)};
                xr[64 * j] = x * rstd * gv[j]; }
        }
    PHASE_END
#undef PHASE_BEGIN
#undef PHASE_END
}

#ifndef N_LAUNCH_MODE
#define N_LAUNCH_MODE 1
#endif
extern "C" void kernel_launch(void* const* d_in, const int* in_sizes, int n_in, void* d_out, int out_size, void* d_ws, size_t ws_size, hipStream_t stream) {
    static int grid = 0;
    if (grid == 0) {
        if (n_in != 18 || out_size != M * DM || ws_size < WS_END) { fprintf(stderr, "kernel_launch: unexpected shapes: n_in %d out %d ws %zu (need %zu)\n", n_in, out_size, ws_size, (size_t)WS_END); grid = -1; return; }
        int dev = 0, cus = 0, per_cu = 0;
        if (hipGetDevice(&dev) != hipSuccess || hipDeviceGetAttribute(&cus, hipDeviceAttributeMultiprocessorCount, dev) != hipSuccess) { grid = -1; return; }
        if (hipFuncSetAttribute((const void*)fwd_kernel, hipFuncAttributeMaxDynamicSharedMemorySize, LDS_BYTES) != hipSuccess) { fprintf(stderr, "kernel_launch: hipFuncSetAttribute failed\n"); grid = -1; return; }
        if (hipOccupancyMaxActiveBlocksPerMultiprocessor(&per_cu, (const void*)fwd_kernel, NWAVES * 64, LDS_BYTES) != hipSuccess || per_cu < 1)
            fprintf(stderr, "kernel_launch: note: occupancy query reports %d workgroups per CU\n", per_cu);
        (void)hipGetLastError();
        grid = cus < 256 ? cus : 256;
    }
    if (grid < 0) return;
    if (hipMemsetAsync((char*)d_ws + WS_CTL, 0, CTL_ZERO_BYTES, stream) != hipSuccess) return;
    Args a{};
    for (int i = 0; i < 18; ++i) a.in[i] = (const float*)d_in[i];
    a.out = (float*)d_out; a.ws = (unsigned char*)d_ws;
#if N_LAUNCH_MODE == 1
    a.ph_lo = 0; a.ph_hi = PH_END;
    hipLaunchKernelGGL(fwd_kernel, dim3(grid), dim3(NWAVES * 64), LDS_BYTES, stream, a);
#ifdef RUN_TWICE
    (void)hipMemsetAsync((char*)d_ws + WS_CTL, 0, CTL_ZERO_BYTES, stream);
    hipLaunchKernelGGL(fwd_kernel, dim3(grid), dim3(NWAVES * 64), LDS_BYTES, stream, a);
#endif
#else
    for (int s = 0; s < NSTEP; ++s)
        for (int p = 0; p < PH_PER_STEP; ++p) { if (p == 3 || p == 5 || ((s & 1) && (p == 0 || p >= 3))) continue; a.ph_lo = s * PH_PER_STEP + p; a.ph_hi = a.ph_lo + 1;
            hipLaunchKernelGGL(fwd_kernel, dim3(grid), dim3(NWAVES * 64), LDS_BYTES, stream, a); }
    a.ph_lo = PH_FINAL; a.ph_hi = PH_END;
    hipLaunchKernelGGL(fwd_kernel, dim3(grid), dim3(NWAVES * 64), LDS_BYTES, stream, a);
#endif
    const hipError_t le = hipPeekAtLastError();
    if (le != hipSuccess) fprintf(stderr, "kernel_launch: launch failed: %s\n", hipGetErrorName(le));
}
```

```cpp
#include <hip/hip_runtime.h>
#include <cstdio>
#include <cstdint>
#define PROBE_MODE 3
#define STREAM_LO 0
#define FUSE_PREP 1
#ifndef REP_MASK
#define REP_MASK 0
#endif

#define LAS __attribute__((address_space(3)))
#define GAS __attribute__((address_space(1)))
#define GAS __attribute__((address_space(1)))
typedef unsigned short bf16_t;
typedef short bf16x8 __attribute__((ext_vector_type(8)));
typedef short s16x4 __attribute__((ext_vector_type(4)));
typedef float f32x2 __attribute__((ext_vector_type(2)));
typedef float f32x4 __attribute__((ext_vector_type(4)));
typedef float f32x16 __attribute__((ext_vector_type(16)));
typedef unsigned u32x2 __attribute__((ext_vector_type(2)));
typedef unsigned u32x4 __attribute__((ext_vector_type(4)));

constexpr int DM = 2048, DFF = 5632, DEPTH = 4, NSTEP = 2 * DEPTH;
constexpr int S_P = 16384, S_S = 8192;
constexpr int M = 49152;
constexpr int INW = 4608, GATEW = 6144, PGW = INW + GATEW, NFF2 = 2 * DFF;
constexpr int COL_QA = 0, COL_KA = 512, COL_VA = 768, COL_QB = 1024, COL_KB = 1792, COL_VB = 2560, COL_QC = 3328, COL_KC = 4096, COL_VC = 4352;
constexpr int YCOL_A = 0, YCOL_B = 512, YCOL_C = 1280;
constexpr float NORM_EPS = 1e-6f;

typedef __bf16 bf16x2_t __attribute__((ext_vector_type(2)));
__device__ __forceinline__ unsigned cvt_pk_bf16(float lo, float hi) { const f32x2 v = {lo, hi}; const bf16x2_t b = __builtin_convertvector(v, bf16x2_t); return __builtin_bit_cast(unsigned, b); }
__device__ __forceinline__ float bf_lo(unsigned w) { return __uint_as_float(w << 16); }
__device__ __forceinline__ float bf_hi(unsigned w) { return __uint_as_float(w & 0xffff0000u); }
__device__ __forceinline__ unsigned f2bf(float f) { unsigned u = __float_as_uint(f); return (u + 0x7fffu + ((u >> 16) & 1u)) >> 16; }
__device__ __forceinline__ unsigned pk2(float lo, float hi) { return f2bf(lo) | (f2bf(hi) << 16); }

__device__ __forceinline__ float row_ssq(const float* ssp, int row) { const f32x4* p = (const f32x4*)(ssp + (size_t)row * 8); const f32x4 a = p[0], b = p[1]; return ((a[0] + a[1]) + (a[2] + a[3])) + ((b[0] + b[1]) + (b[2] + b[3])); }
__device__ __forceinline__ void panel_rstd(const float* ssp, LAS float* rt, int& cpm, int pm, int tid) {
    if (pm != cpm) {
        if (tid < 256) rt[tid] = __builtin_amdgcn_rsqf(row_ssq(ssp, pm * 256 + tid) * (1.0f / DM) + NORM_EPS);
        asm volatile("s_waitcnt lgkmcnt(0)" ::: "memory"); __builtin_amdgcn_s_barrier(); asm volatile("" ::: "memory");
        cpm = pm; }
}
namespace pg8 {
constexpr int BM = 256, BK = 64, HALF = 128, HTB = HALF * BK * 2, STAGE_BYTES = 8 * HTB, NXCD = 8;
__host__ __device__ __forceinline__ int lds_byte(int r, int c) { const int st = (r >> 4) * 2 + (c >> 5), rr = r & 15, cc = c & 31, ob = rr * 64 + cc * 2; return st * 1024 + (ob ^ (((ob >> 9) & 1) << 5)); }
__host__ __device__ __forceinline__ void stage_rc(int b, int& R, int& C) { const int st = b / 1024, sb = b % 1024, swz = sb ^ (((sb >> 9) & 1) << 5); R = (st >> 1) * 16 + swz / 64; C = (st & 1) * 32 + (swz % 64) / 2; }
__host__ __device__ __forceinline__ int perm32(int rho) { const int n = rho >> 4, i = rho & 15; return 8 * (i >> 2) + 4 * n + (i & 3); }

struct Unit { int pm, pn, k0, nt, seg; };
struct StaticOrder {
    int nM, nN, nwg, G, c, WGM;
    __device__ void init(int M_, int N_, int G_, int c_, int wgm) { nM = M_ / BM; nN = N_ / BM; nwg = nM * nN; G = G_; c = c_; WGM = wgm; }
    __device__ bool next(int i, int& pm, int& pn) const {
        const long L = (long)i * G + c; if (L >= nwg) return false;
        int wgid = (int)L; { const int q = nwg / NXCD, r = nwg % NXCD, xcd = wgid % NXCD, off = wgid / NXCD; wgid = (xcd < r ? xcd * (q + 1) : r * (q + 1) + (xcd - r) * q) + off; }
        const int nig = WGM * nN, gid = wgid / nig, fm = gid * WGM, gsz = (nM - fm) < WGM ? (nM - fm) : WGM;
        pm = fm + ((wgid % nig) % gsz); pn = (wgid % nig) / gsz; return true;
    }
};
struct PlainSched { StaticOrder so; int nt;
    __device__ __forceinline__ bool next(int i, Unit& u) const { u.k0 = 0; u.nt = nt; u.seg = 0; return so.next(i, u.pm, u.pn); } };
struct ChainSched { StaticOrder so;
    __device__ __forceinline__ bool next(int i, Unit& u) const { const int t = i / 3, sg = i - 3 * t; u.seg = sg; u.k0 = sg == 0 ? 0 : (sg == 1 ? 512 : 1280); u.nt = sg == 0 ? 8 : 12; return so.next(t, u.pm, u.pn); } };

typedef f32x4 Acc[2][2][4][2];

struct EpiSwiglu { static constexpr bool PERM = true, CHAIN = false; bf16_t* O; const float* ss; LAS float* rt; mutable int cpm;
    __device__ __forceinline__ void operator()(Acc& acc, const Unit& u, int wr, int wc, int fr, int fq) const {
        const int row0 = u.pm * BM + wr * 64 + fr, col0 = u.pn * HALF + wc * 32 + 8 * fq;
        panel_rstd(ss, rt, cpm, u.pm, (wr * 4 + wc) * 64 + fq * 16 + fr);
#pragma unroll
        for (int ai = 0; ai < 2; ++ai)
#pragma unroll
            for (int m = 0; m < 4; ++m) { bf16_t* rowp = O + (size_t)(row0 + ai * HALF + m * 16) * DFF + col0; float v[8];
                const float r = rt[wr * 64 + ai * HALF + m * 16 + fr];
#pragma unroll
                for (int n = 0; n < 2; ++n)
#pragma unroll
                    for (int j = 0; j < 4; ++j) { const float g = acc[ai][0][m][n][j] * r, up = acc[ai][1][m][n][j] * r;
                        const float e = __builtin_amdgcn_exp2f(g * -1.4426950408889634f); v[4 * n + j] = g * up * __builtin_amdgcn_rcpf(1.0f + e); }
                u32x4 w; w.x = cvt_pk_bf16(v[0], v[1]); w.y = cvt_pk_bf16(v[2], v[3]); w.z = cvt_pk_bf16(v[4], v[5]); w.w = cvt_pk_bf16(v[6], v[7]);
                *(u32x4*)rowp = w; }
    }
};
struct EpiStream { static constexpr bool PERM = true, CHAIN = false; bf16_t* hi; bf16_t* lo; float* ssq; float alpha; LAS float* tab;
    __device__ __forceinline__ void operator()(Acc& acc, const Unit& u, int wr, int wc, int fr, int fq) const {
        const unsigned loff = (unsigned)(fr * DM + 8 * fq);
        const size_t ub = (size_t)(u.pm * BM + wr * 64) * DM + u.pn * BM + wc * 32;
#pragma unroll
        for (int ai = 0; ai < 2; ++ai) {
            u32x4 H[4][2], L[4][2];
#pragma unroll
            for (int m = 0; m < 4; ++m)
#pragma unroll
                for (int bj = 0; bj < 2; ++bj) { const size_t uo = ub + (size_t)(ai * HALF + m * 16) * DM + bj * HALF;
                    H[m][bj] = *(const u32x4*)(hi + uo + loff); L[m][bj] = STREAM_LO ? *(const u32x4*)(lo + uo + loff) : (u32x4){0u, 0u, 0u, 0u}; }
#pragma unroll
            for (int m = 0; m < 4; ++m) { float sq = 0.f;
#pragma unroll
                for (int bj = 0; bj < 2; ++bj) { const size_t uo = ub + (size_t)(ai * HALF + m * 16) * DM + bj * HALF; const u32x4 h = H[m][bj], l = L[m][bj]; float x[8];
                    x[0] = bf_lo(h.x) + bf_lo(l.x); x[1] = bf_hi(h.x) + bf_hi(l.x); x[2] = bf_lo(h.y) + bf_lo(l.y); x[3] = bf_hi(h.y) + bf_hi(l.y);
                    x[4] = bf_lo(h.z) + bf_lo(l.z); x[5] = bf_hi(h.z) + bf_hi(l.z); x[6] = bf_lo(h.w) + bf_lo(l.w); x[7] = bf_hi(h.w) + bf_hi(l.w);
#pragma unroll
                    for (int j = 0; j < 4; ++j) { x[j] = fmaf(acc[ai][bj][m][0][j], alpha, x[j]); x[4 + j] = fmaf(acc[ai][bj][m][1][j], alpha, x[4 + j]); }
#pragma unroll
                    for (int j = 0; j < 8; ++j) sq = fmaf(x[j], x[j], sq);
                    u32x4 nh, nl; nh.x = cvt_pk_bf16(x[0], x[1]); nh.y = cvt_pk_bf16(x[2], x[3]); nh.z = cvt_pk_bf16(x[4], x[5]); nh.w = cvt_pk_bf16(x[6], x[7]);
                    nl.x = cvt_pk_bf16(x[0] - bf_lo(nh.x), x[1] - bf_hi(nh.x)); nl.y = cvt_pk_bf16(x[2] - bf_lo(nh.y), x[3] - bf_hi(nh.y));
                    nl.z = cvt_pk_bf16(x[4] - bf_lo(nh.z), x[5] - bf_hi(nh.z)); nl.w = cvt_pk_bf16(x[6] - bf_lo(nh.w), x[7] - bf_hi(nh.w));
                    *(u32x4*)(hi + uo + loff) = nh; if (STREAM_LO) *(u32x4*)(lo + uo + loff) = nl; }
                sq += __shfl_xor(sq, 16); sq += __shfl_xor(sq, 32);
                if (fq == 0) tab[(wr * 64 + ai * HALF + m * 16 + fr) * 4 + wc] = sq; }
            asm volatile("" ::: "memory"); }
        asm volatile("s_waitcnt lgkmcnt(0)" ::: "memory"); __builtin_amdgcn_s_barrier(); asm volatile("" ::: "memory");
        const int t = (wr * 4 + wc) * 64 + fq * 16 + fr;
        if (t < BM) { const f32x4 p = *(const LAS f32x4*)(tab + t * 4); ssq[(size_t)(u.pm * BM + t) * 8 + u.pn] = (p[0] + p[1]) + (p[2] + p[3]); }
    }
};
struct EpiProjGate { static constexpr bool PERM = true, CHAIN = false; bf16_t* proj; bf16_t* gates; const float* bias; const float* ss; const f32x2* rope; const f32x2* ropex; const float* gq; const float* gk; LAS float* tab; LAS float* rt; mutable int cpm;
    __device__ __forceinline__ void store8(bf16_t* p, const float (&v)[8]) const { u32x4 w; w.x = cvt_pk_bf16(v[0], v[1]); w.y = cvt_pk_bf16(v[2], v[3]); w.z = cvt_pk_bf16(v[4], v[5]); w.w = cvt_pk_bf16(v[6], v[7]); *(u32x4*)p = w; }
    __device__ __forceinline__ void operator()(Acc& acc, const Unit& u, int wr, int wc, int fr, int fq) const {
        const int pn = u.pn, rb = u.pm * BM + wr * 64;
        panel_rstd(ss, rt, cpm, u.pm, (wr * 4 + wc) * 64 + fq * 16 + fr);
#pragma unroll
        for (int ai = 0; ai < 2; ++ai)
#pragma unroll
            for (int m = 0; m < 4; ++m) { const float r = rt[wr * 64 + ai * HALF + m * 16 + fr];
#pragma unroll
                for (int bj = 0; bj < 2; ++bj) { acc[ai][bj][m][0] *= r; acc[ai][bj][m][1] *= r; } }
        if (pn >= INW / BM) {
            const float* bp = bias + (pn - INW / BM) * BM + wc * 32 + 8 * fq;
            f32x4 bv[2][2];
#pragma unroll
            for (int bj = 0; bj < 2; ++bj)
#pragma unroll
                for (int n = 0; n < 2; ++n) bv[bj][n] = *(const f32x4*)(bp + bj * HALF + 4 * n);
            unsigned char* tb = (unsigned char*)gates + ((size_t)u.pm * (GATEW / BM) + (pn - INW / BM)) * (BM * BM) + (wr * 64) * BM + wc * 64;
            const unsigned lo8 = (unsigned)(fr * BM + fq * 16);
#pragma unroll
            for (int ai = 0; ai < 2; ++ai)
#pragma unroll
                for (int m = 0; m < 4; ++m) { u32x4 w;
#pragma unroll
                    for (int bj = 0; bj < 2; ++bj) { unsigned q[8];
#pragma unroll
                        for (int j = 0; j < 4; ++j) { q[j] = __float_as_uint(fmaf(__builtin_amdgcn_rcpf(1.0f + __builtin_amdgcn_exp2f((acc[ai][bj][m][0][j] + bv[bj][0][j]) * -1.4426950408889634f)), 255.0f, 8388608.0f));
                                                      q[4 + j] = __float_as_uint(fmaf(__builtin_amdgcn_rcpf(1.0f + __builtin_amdgcn_exp2f((acc[ai][bj][m][1][j] + bv[bj][1][j]) * -1.4426950408889634f)), 255.0f, 8388608.0f)); }
                        w[2 * bj] = __builtin_amdgcn_perm(q[1], q[0], 0x0c0c0400u) | (__builtin_amdgcn_perm(q[3], q[2], 0x0c0c0400u) << 16);
                        w[2 * bj + 1] = __builtin_amdgcn_perm(q[5], q[4], 0x0c0c0400u) | (__builtin_amdgcn_perm(q[7], q[6], 0x0c0c0400u) << 16); }
                    *(u32x4*)(tb + (ai * HALF + m * 16) * BM + lo8) = w; }
            return;
        }
        bf16_t* pb = proj + (size_t)rb * INW + pn * BM + wc * 32;
        const unsigned lop = (unsigned)(fr * INW + 8 * fq);
        const int posb = (rb < S_P ? rb : (rb & (S_S - 1)));
        const bool plain = (pn == 3) || (pn >= 10 && pn <= 12) || (pn == 17), axial = (pn >= 13 && pn <= 16);
        if (plain) {
#pragma unroll
            for (int ai = 0; ai < 2; ++ai)
#pragma unroll
                for (int m = 0; m < 4; ++m) { bf16_t* rowp = pb + (size_t)(ai * HALF + m * 16) * INW + lop;
#pragma unroll
                    for (int bj = 0; bj < 2; ++bj) { float v[8];
#pragma unroll
                        for (int j = 0; j < 4; ++j) { v[j] = acc[ai][bj][m][0][j]; v[4 + j] = acc[ai][bj][m][1][j]; }
                        store8(rowp + bj * HALF, v); } }
        } else if (!axial) {
            const f32x2* rp = rope + (size_t)posb * 64 + 16 * wc; const unsigned lor = (unsigned)(fr * 64 + 4 * fq);
#pragma unroll
            for (int ai = 0; ai < 2; ++ai) {
                f32x4 c01[4], c23[4];
#pragma unroll
                for (int m = 0; m < 4; ++m) { const f32x4* cp = (const f32x4*)(rp + (ai * HALF + m * 16) * 64 + lor); c01[m] = cp[0]; c23[m] = cp[1]; }
#pragma unroll
                for (int m = 0; m < 4; ++m) { const float cs[4] = {c01[m][0], c01[m][2], c23[m][0], c23[m][2]}, sn[4] = {c01[m][1], c01[m][3], c23[m][1], c23[m][3]};
                    bf16_t* rowp = pb + (size_t)(ai * HALF + m * 16) * INW + lop;
#pragma unroll
                    for (int bj = 0; bj < 2; ++bj) { float v[8];
#pragma unroll
                        for (int k = 0; k < 4; ++k) { const float x1 = acc[ai][bj][m][k >> 1][(2 * k) & 3], x2 = acc[ai][bj][m][k >> 1][((2 * k) & 3) + 1];
                            v[2 * k] = x1 * cs[k] - x2 * sn[k]; v[2 * k + 1] = x2 * cs[k] + x1 * sn[k]; }
                        store8(rowp + bj * HALF, v); } }
                asm volatile("" ::: "memory"); }
        } else {
            const float* g = (pn == 16 ? gk : gq) + 64 * (wc >> 1) + 16 * (wc & 1) + 4 * fq;
            const float qs = pn == 16 ? 1.0f : 0.088388347648318440f * 1.4426950408889634f;
            const f32x4 gA = *(const f32x4*)g * qs, gB = *(const f32x4*)(g + 32) * qs;
            const int rl0 = wr * 64 + fr;
#pragma unroll
            for (int ai = 0; ai < 2; ++ai)
#pragma unroll
                for (int m = 0; m < 4; ++m)
#pragma unroll
                    for (int bj = 0; bj < 2; ++bj) { float sq = 0.f;
#pragma unroll
                        for (int j = 0; j < 4; ++j) { sq = fmaf(acc[ai][bj][m][0][j], acc[ai][bj][m][0][j], sq); sq = fmaf(acc[ai][bj][m][1][j], acc[ai][bj][m][1][j], sq); }
                        sq += __shfl_xor(sq, 16); sq += __shfl_xor(sq, 32);
                        if (fq == 0) tab[((rl0 + ai * HALF + m * 16) * 2 + bj) * 4 + wc] = sq; }
            asm volatile("s_waitcnt lgkmcnt(0)" ::: "memory"); __builtin_amdgcn_s_barrier(); asm volatile("" ::: "memory");
#pragma unroll
            for (int ai = 0; ai < 2; ++ai)
#pragma unroll
                for (int m = 0; m < 4; ++m) { const int rl = rl0 + ai * HALF + m * 16, pos = posb + ai * HALF + m * 16 + fr;
                    const int id = (wc >> 1) ? (pos & 63) : (pos >> 6);
                    const f32x4* cp = (const f32x4*)(ropex + (size_t)id * 32 + 16 * (wc & 1) + 4 * fq); const f32x4 c01 = cp[0], c23 = cp[1];
                    const float cs[4] = {c01[0], c01[2], c23[0], c23[2]}, sn[4] = {c01[1], c01[3], c23[1], c23[3]};
                    bf16_t* rowp = pb + (size_t)(ai * HALF + m * 16) * INW + lop;
#pragma unroll
                    for (int bj = 0; bj < 2; ++bj) { const f32x4 t = *(const LAS f32x4*)(tab + (rl * 2 + bj) * 4);
                        const float rh = __builtin_amdgcn_rsqf(((t[0] + t[1]) + (t[2] + t[3])) * (1.0f / 128.0f) + NORM_EPS); float v[8];
#pragma unroll
                        for (int k = 0; k < 4; ++k) { const float x1 = acc[ai][bj][m][k >> 1][(2 * k) & 3] * rh * gA[k], x2 = acc[ai][bj][m][k >> 1][((2 * k) & 3) + 1] * rh * gB[k];
                            v[2 * k] = x1 * cs[k] - x2 * sn[k]; v[2 * k + 1] = x2 * cs[k] + x1 * sn[k]; }
                        store8(rowp + bj * HALF, v); } }
        }
    }
};
struct EpiBranch { static constexpr bool PERM = true, CHAIN = true; const bf16_t* gates; bf16_t* O;
    __device__ __forceinline__ void operator()(Acc& acc, const Unit& u, int wr, int wc, int fr, int fq) const {
        const int rl0 = wr * 64 + fr, row0 = u.pm * BM + rl0, col0 = u.pn * BM + wc * 32 + 8 * fq; const int seg = u.seg;
        const unsigned char* tn = (const unsigned char*)gates + ((size_t)u.pm * (GATEW / BM) + seg * (DM / BM) + u.pn) * (BM * BM) + (wc * 4 + fq) * 16;
        const unsigned char* td = tn + (size_t)(DM / BM) * (BM * BM);
#pragma unroll
        for (int ai = 0; ai < 2; ++ai) {
            u32x4 gn[4], gd[4];
#pragma unroll
            for (int m = 0; m < 4; ++m) { const size_t ro = (size_t)(rl0 + ai * HALF + m * 16) * BM;
                gn[m] = *(const u32x4*)(tn + ro); if (seg != 2) gd[m] = *(const u32x4*)(td + ro); else gd[m] = (u32x4){0u, 0u, 0u, 0u}; }
#pragma unroll
            for (int m = 0; m < 4; ++m) { const size_t row = (size_t)(row0 + ai * HALF + m * 16);
#pragma unroll
                for (int bj = 0; bj < 2; ++bj) { float s[8];
#pragma unroll
                    for (int j = 0; j < 8; ++j) s[j] = fmaxf((float)((gn[m][2 * bj + (j >> 2)] >> (8 * (j & 3))) & 0xffu), 0.5f);
                    if (seg != 2) {
#pragma unroll
                        for (int j = 0; j < 8; ++j) s[j] = s[j] * __builtin_amdgcn_rcpf(fmaxf((float)((gd[m][2 * bj + (j >> 2)] >> (8 * (j & 3))) & 0xffu), 0.5f));
                    } else {
#pragma unroll
                        for (int j = 0; j < 8; ++j) s[j] *= (1.0f / 255.0f);
                    }
#pragma unroll
                    for (int j = 0; j < 4; ++j) { acc[ai][bj][m][0][j] *= s[j]; acc[ai][bj][m][1][j] *= s[4 + j]; }
                    if (seg == 2) { const f32x4 v0 = acc[ai][bj][m][0], v1 = acc[ai][bj][m][1];
                        u32x4 w; w.x = cvt_pk_bf16(v0[0], v0[1]); w.y = cvt_pk_bf16(v0[2], v0[3]); w.z = cvt_pk_bf16(v1[0], v1[1]); w.w = cvt_pk_bf16(v1[2], v1[3]);
                        *(u32x4*)(O + row * DM + col0 + bj * HALF) = w; } } }
            asm volatile("" ::: "memory"); }
    }
};

template <class Epi, class Sched>
__device__ __forceinline__ void gemm_phase(LAS unsigned char* lds, const bf16_t* Ag, const bf16_t* Btg, const int Kp, const Sched& S, const Epi& E) {
    int tid = threadIdx.x; asm volatile("" : "+v"(tid));
    const int wid = __builtin_amdgcn_readfirstlane(tid >> 6), lane = tid & 63, wr = wid >> 2, wc = wid & 3, fr = lane & 15, fq = lane >> 4;
    unsigned voffA[2], voffB[2];
#pragma unroll
    for (int i = 0; i < 2; ++i) { int R, C; stage_rc(tid * 16 + i * 8192, R, C); const int Rb = Epi::PERM ? ((R & ~31) + perm32(R & 31)) : R;
        voffA[i] = (unsigned)(R * Kp + C) * 2u; voffB[i] = (unsigned)(Rb * Kp + C) * 2u; }
    const size_t kstep = (size_t)(BK * 2);
    const size_t hstep = (size_t)HALF * Kp * 2;
    const size_t tstep = 2 * hstep;
    const unsigned ldsw = (unsigned)wid * 1024u;
    const int aoff = lds_byte(wr * 64 + fr, fq * 8), boff = lds_byte(wc * 32 + fr, fq * 8);
#define PG8_SA(b, h) (((b) * 2 + (h)) * HTB)
#define PG8_SB(b, h) ((4 + (b) * 2 + (h)) * HTB)
#define PG8_STAGE(bufoff, gbase, voff) do { _Pragma("unroll") for (int _i = 0; _i < 2; ++_i) \
        __builtin_amdgcn_global_load_lds((const unsigned*)((const char*)(gbase) + (voff)[_i]), (LAS unsigned*)(lds + (bufoff) + ldsw + _i * 8192), 16, 0, 0); } while (0)
#define PG8_LDA(dst, b, h) do { _Pragma("unroll") for (int m = 0; m < 4; ++m) _Pragma("unroll") for (int k = 0; k < 2; ++k) dst[m][k] = *(const LAS bf16x8*)(lds + PG8_SA(b, h) + aoff + m * 2048 + k * 1024); } while (0)
#define PG8_LDB(dst, b, h) do { _Pragma("unroll") for (int n = 0; n < 2; ++n) _Pragma("unroll") for (int k = 0; k < 2; ++k) dst[n][k] = *(const LAS bf16x8*)(lds + PG8_SB(b, h) + boff + n * 2048 + k * 1024); } while (0)
#define PG8_MMA(ai, bj, At, Bt) do { __builtin_amdgcn_s_setprio(1); _Pragma("unroll") for (int m = 0; m < 4; ++m) _Pragma("unroll") for (int n = 0; n < 2; ++n) _Pragma("unroll") for (int k = 0; k < 2; ++k) \
        acc[ai][bj][m][n] = __builtin_amdgcn_mfma_f32_16x16x32_bf16(Bt[n][k], At[m][k], acc[ai][bj][m][n], 0, 0, 0); __builtin_amdgcn_s_setprio(0); } while (0)
#define PG8_WAIT_V(n) asm volatile("s_waitcnt vmcnt(" #n ")" ::: "memory")
#define PG8_WAIT_L(n) asm volatile("s_waitcnt lgkmcnt(" #n ")" ::: "memory")
#define PG8_BAR __builtin_amdgcn_s_barrier()
#define PG8_SCHED __builtin_amdgcn_sched_barrier(0)
    Unit cur, nxt; int ui = 0;
    if (!S.next(0, cur)) return;
    Acc acc;
#pragma unroll
    for (int a = 0; a < 2; ++a)
#pragma unroll
        for (int b = 0; b < 2; ++b)
#pragma unroll
            for (int m = 0; m < 4; ++m)
#pragma unroll
                for (int n = 0; n < 2; ++n) acc[a][b][m][n] = (f32x4){0.f, 0.f, 0.f, 0.f};
    bf16x8 At[4][2], B0[2][2], B1[2][2];
    const char* cA = (const char*)Ag + (size_t)cur.pm * tstep + (size_t)cur.k0 * 2; const char* cB = (const char*)Btg + (size_t)cur.pn * tstep + (size_t)cur.k0 * 2;
    PG8_STAGE(PG8_SB(0, 0), cB, voffB); PG8_STAGE(PG8_SB(0, 1), cB + hstep, voffB); PG8_STAGE(PG8_SA(0, 0), cA, voffA); PG8_STAGE(PG8_SA(0, 1), cA + hstep, voffA);
    if (wr == 1) PG8_BAR;
    PG8_WAIT_V(2); PG8_BAR;
    PG8_STAGE(PG8_SB(1, 0), cB + kstep, voffB); PG8_STAGE(PG8_SA(1, 0), cA + kstep, voffA); PG8_STAGE(PG8_SB(1, 1), cB + hstep + kstep, voffB);
    PG8_WAIT_V(6); PG8_BAR;
    for (;;) {
        const bool has_next = S.next(ui + 1, nxt);
        const char* nA = has_next ? (const char*)Ag + (size_t)nxt.pm * tstep + (size_t)nxt.k0 * 2 : cA; const char* nB = has_next ? (const char*)Btg + (size_t)nxt.pn * tstep + (size_t)nxt.k0 * 2 : cB;
        const int nt = cur.nt;
        for (int t = 0; t < nt; t += 2) {
            const bool last = (t == nt - 2);
            const char* a1 = cA + (size_t)(t + 1) * kstep;
            const char* a2 = last ? nA : cA + (size_t)(t + 2) * kstep; const char* b2 = last ? nB : cB + (size_t)(t + 2) * kstep;
            const char* a3 = a2 + kstep; const char* b3 = b2 + kstep;
            PG8_LDB(B0, 0, 0); PG8_LDB(B1, 0, 1); PG8_SCHED; PG8_LDA(At, 0, 0); PG8_STAGE(PG8_SA(1, 1), a1 + hstep, voffA);
            PG8_WAIT_V(8); PG8_WAIT_L(0); PG8_BAR; PG8_MMA(0, 0, At, B0); PG8_MMA(0, 1, At, B1); PG8_BAR; PG8_SCHED;
            PG8_LDA(At, 0, 1); PG8_STAGE(PG8_SB(0, 0), b2, voffB); PG8_STAGE(PG8_SB(0, 1), b2 + hstep, voffB); PG8_STAGE(PG8_SA(0, 0), a2, voffA);
            PG8_WAIT_V(8); PG8_WAIT_L(0); PG8_BAR; PG8_MMA(1, 0, At, B0); PG8_MMA(1, 1, At, B1); PG8_BAR; PG8_SCHED;
            PG8_LDB(B0, 1, 0); PG8_LDB(B1, 1, 1); PG8_SCHED; PG8_LDA(At, 1, 0); PG8_STAGE(PG8_SA(0, 1), a2 + hstep, voffA);
            PG8_WAIT_V(8); PG8_WAIT_L(0); PG8_BAR; PG8_MMA(0, 0, At, B0); PG8_MMA(0, 1, At, B1); PG8_BAR; PG8_SCHED;
            PG8_LDA(At, 1, 1); PG8_STAGE(PG8_SB(1, 0), b3, voffB); PG8_STAGE(PG8_SB(1, 1), b3 + hstep, voffB); PG8_STAGE(PG8_SA(1, 0), a3, voffA);
            PG8_WAIT_V(8); PG8_WAIT_L(0); PG8_BAR; PG8_MMA(1, 0, At, B0); PG8_MMA(1, 1, At, B1); PG8_BAR; PG8_SCHED;
        }
        if (wr == 0) PG8_BAR;
        E(acc, cur, wr, wc, fr, fq);
        if (!has_next) break;
        if (!Epi::CHAIN || cur.seg == 2) {
#pragma unroll
            for (int a = 0; a < 2; ++a)
#pragma unroll
                for (int b = 0; b < 2; ++b)
#pragma unroll
                    for (int m = 0; m < 4; ++m)
#pragma unroll
                        for (int n = 0; n < 2; ++n) acc[a][b][m][n] = (f32x4){0.f, 0.f, 0.f, 0.f};
        }
        cur = nxt; cA = nA; cB = nB; ++ui;
        if (wr == 1) PG8_BAR;
    }
    PG8_WAIT_V(0);
    PG8_BAR;
#undef PG8_SA
#undef PG8_SB
#undef PG8_STAGE
#undef PG8_LDA
#undef PG8_LDB
#undef PG8_MMA
#undef PG8_WAIT_V
#undef PG8_WAIT_L
#undef PG8_BAR
#undef PG8_SCHED
}
}

namespace att {
constexpr int D = 128, NW = 8, QBLK = 32, KVBLK = 64;
constexpr float SCALE = 0.088388347648318440f;
constexpr float THR = 8.f;
constexpr size_t SHM_V = KVBLK * D * 2, SHM_K = KVBLK * D * 2, SHM_ATTN = 2 * SHM_V + 2 * SHM_K + NW * 64 * 4;
#define KSWZ(row, colB) ((row) * 256 + ((colB) ^ (((row) & 15) << 4)))
#define SBAR() __builtin_amdgcn_sched_barrier(0)
__device__ __forceinline__ int crow(int r, int hi) { return (r & 3) + 8 * (r >> 2) + 4 * hi; }
__device__ __forceinline__ unsigned cvtpk(float lo, float hi) { return cvt_pk_bf16(lo, hi); }

template <int MODE>
__device__ __forceinline__ void partialSM(f32x16& p0, f32x16& p1, float& m_reg, float& mn, float& alpha) {
  if (MODE == 2) { mn = 0.f; alpha = 1.f;
#pragma unroll
    for (int r = 0; r < 16; ++r) p0[r] = __builtin_amdgcn_exp2f(p0[r]);
    return; }
  constexpr float C = MODE == 0 ? SCALE * 1.4426950408889634f : 1.0f, TH = MODE == 0 ? THR / SCALE : THR * 1.4426950408889634f;
  float pmax = p0[0];
#pragma unroll
  for (int r = 1; r < 16; ++r) pmax = fmaxf(pmax, p0[r]);
#pragma unroll
  for (int r = 0; r < 16; ++r) pmax = fmaxf(pmax, p1[r]);
  { auto rr = __builtin_amdgcn_permlane32_swap(__float_as_uint(pmax), __float_as_uint(pmax), false, false);
    pmax = fmaxf(__uint_as_float(rr[0]), __uint_as_float(rr[1])); }
  if (__builtin_expect(__all(pmax - m_reg <= TH), 1)) { mn = m_reg; alpha = 1.f; }
  else { mn = fmaxf(m_reg, pmax); alpha = __builtin_amdgcn_exp2f((m_reg - mn) * C); m_reg = mn; }
  float mnC = -mn * C;
#pragma unroll
  for (int r = 0; r < 16; ++r) p0[r] = fmaf(p0[r], C, mnC);
#pragma unroll
  for (int r = 0; r < 16; ++r) p1[r] = fmaf(p1[r], C, mnC);
#pragma unroll
  for (int r = 0; r < 16; ++r) p0[r] = __builtin_amdgcn_exp2f(p0[r]);
}
__device__ __forceinline__ void finishSM(f32x16& p0, f32x16& p1, float alpha, float& l_reg, bf16x8& pa0, bf16x8& pa1, bf16x8& pa2, bf16x8& pa3) {
#pragma unroll
  for (int r = 0; r < 16; ++r) p1[r] = __builtin_amdgcn_exp2f(p1[r]);
  float ps = 0;
#pragma unroll
  for (int r = 0; r < 16; ++r) ps += p0[r];
#pragma unroll
  for (int r = 0; r < 16; ++r) ps += p1[r];
  { auto rr = __builtin_amdgcn_permlane32_swap(__float_as_uint(ps), __float_as_uint(ps), false, false);
    ps = __uint_as_float(rr[0]) + __uint_as_float(rr[1]); }
  l_reg = l_reg * alpha + ps;
#define PK4(P, BASE, OUT) do { unsigned a0 = cvtpk(P[BASE + 0], P[BASE + 1]), a1 = cvtpk(P[BASE + 2], P[BASE + 3]);   \
    unsigned b0 = cvtpk(P[BASE + 4], P[BASE + 5]), b1 = cvtpk(P[BASE + 6], P[BASE + 7]);                              \
    auto r0 = __builtin_amdgcn_permlane32_swap(a0, b0, false, false); auto r1 = __builtin_amdgcn_permlane32_swap(a1, b1, false, false); \
    u32x4 w = {r0[0], r1[0], r0[1], r1[1]}; OUT = *reinterpret_cast<bf16x8*>(&w); } while (0)
  PK4(p0, 0, pa0); PK4(p0, 8, pa1); PK4(p1, 0, pa2); PK4(p1, 8, pa3);
#undef PK4
}
__device__ __forceinline__ void qkt(f32x16& p0, f32x16& p1, const char* Ks, const bf16x8* qr, int r32, int hi) {
  p0 = f32x16{}; p1 = f32x16{};
#pragma unroll
  for (int d0 = 0; d0 < 8; ++d0) { int cb = (d0 * 16 + hi * 8) * 2;
    bf16x8 b0 = *reinterpret_cast<const bf16x8*>(Ks + KSWZ(r32, cb));
    bf16x8 b1 = *reinterpret_cast<const bf16x8*>(Ks + KSWZ(32 + r32, cb));
    p0 = __builtin_amdgcn_mfma_f32_32x32x16_bf16(b0, qr[d0], p0, 0, 0, 0);
    p1 = __builtin_amdgcn_mfma_f32_32x32x16_bf16(b1, qr[d0], p1, 0, 0, 0); }
}
__device__ __forceinline__ int v_st(int k, int c) { const int kk = (k & ~0xC) | ((k & 4) << 1) | ((k & 8) >> 1); return ((kk >> 3) * 4 + (c >> 5)) * 512 + ((kk & 7) * 32 + (c & 31)) * 2; }
__device__ __forceinline__ int v_rd_base(int lane) { return ((lane & 3) << 3) | (((lane >> 2) & 3) << 6) | (((lane >> 4) & 1) << 5) | (((lane >> 5) & 1) << 8); }
constexpr int v_rd_off(int d0, int ks, int half) { return d0 * 512 + ks * 4096 + half * 2048; }
template <int OFF> __device__ __forceinline__ s16x4 tr_read(int vb) {
  s16x4 r; asm volatile("ds_read_b64_tr_b16 %0, %1 offset:%2" : "=&v"(r) : "v"(vb), "i"(OFF) : "memory"); return r;
}
__device__ __forceinline__ float fadd_s(float a, float b) { float r; asm volatile("v_add_f32_e32 %0, %1, %2" : "=v"(r) : "v"(a), "v"(b)); return r; }
template <bool VPRE, bool KW, bool VW>
__device__ __forceinline__ void qkt_fin(f32x16& q0, f32x16& q1, const char* Ks, const bf16x8* qr, int r32, int hi,
                                        f32x16& p0, f32x16& p1, float alpha, float& l_reg, bf16x8& pa0, bf16x8& pa1, bf16x8& pa2, bf16x8& pa3, int vb, s16x4* vp,
                                        char* kw0, char* kw1, bf16x8 kv0, bf16x8 kv1, char* vw0, char* vw1, bf16x8 vv0, bf16x8 vv1) {
  q0 = f32x16{}; q1 = f32x16{};
  float psA = 0.f, psB = 0.f; unsigned c[8], d[8];
  int kof = KSWZ(r32, (hi * 8) * 2); asm volatile("" : "+v"(kof));
  bf16x8 kb0 = *reinterpret_cast<const bf16x8*>(Ks + kof), kb1 = *reinterpret_cast<const bf16x8*>(Ks + kof + 8192);
#define QF_SWAP(OUT, U, B) do { auto r0_ = __builtin_amdgcn_permlane32_swap(U[B], U[B + 2], false, false); auto r1_ = __builtin_amdgcn_permlane32_swap(U[B + 1], U[B + 3], false, false); \
    u32x4 w_ = {r0_[0], r1_[0], r0_[1], r1_[1]}; OUT = *reinterpret_cast<bf16x8*>(&w_); } while (0)
#define QF_SLOT(i) do { p1[i] = __builtin_amdgcn_exp2f(p1[i]); \
    if ((i) < 8) { psA = fadd_s(psA, p0[2 * (i)]); psA = fadd_s(psA, p0[2 * (i) + 1]); c[i] = cvtpk(p0[2 * (i)], p0[2 * (i) + 1]); } \
    if ((i) == 3) QF_SWAP(pa0, c, 0);  if ((i) == 7) QF_SWAP(pa1, c, 4); \
    if ((i) >= 2) psB = fadd_s(psB, p1[(i) - 2]); \
    if ((i) >= 3 && (((i) - 3) & 1) == 0) d[((i) - 3) / 2] = cvtpk(p1[(i) - 3], p1[(i) - 2]); \
    if ((i) == 10) QF_SWAP(pa2, d, 0); } while (0)
#pragma unroll
  for (int d0 = 0; d0 < 8; ++d0) { const int cn = kof ^ ((d0 + 1) << 5);
    q0 = __builtin_amdgcn_mfma_f32_32x32x16_bf16(kb0, qr[d0], q0, 0, 0, 0); if (d0 < 7) kb0 = *reinterpret_cast<const bf16x8*>(Ks + cn); QF_SLOT(2 * d0);
    if (KW && d0 == 2) *(bf16x8*)kw0 = kv0;
    if (VW && d0 == 5) *(bf16x8*)vw0 = vv0;
    SBAR();
    q1 = __builtin_amdgcn_mfma_f32_32x32x16_bf16(kb1, qr[d0], q1, 0, 0, 0); if (d0 < 7) kb1 = *reinterpret_cast<const bf16x8*>(Ks + cn + 8192); QF_SLOT(2 * d0 + 1);
    if (KW && d0 == 4) *(bf16x8*)kw1 = kv1;
    if (VW && d0 == 6) *(bf16x8*)vw1 = vv1;
    SBAR(); }
  if (VPRE) {
    vp[0] = tr_read<v_rd_off(0, 0, 0)>(vb); vp[1] = tr_read<v_rd_off(0, 0, 1)>(vb); vp[2] = tr_read<v_rd_off(0, 1, 0)>(vb); vp[3] = tr_read<v_rd_off(0, 1, 1)>(vb);
    vp[4] = tr_read<v_rd_off(0, 2, 0)>(vb); vp[5] = tr_read<v_rd_off(0, 2, 1)>(vb); vp[6] = tr_read<v_rd_off(0, 3, 0)>(vb); vp[7] = tr_read<v_rd_off(0, 3, 1)>(vb); }
  psB += p1[14]; psB += p1[15];
  d[7] = cvtpk(p1[14], p1[15]); QF_SWAP(pa3, d, 4);
  float ps = psA + psB;
  { auto rr = __builtin_amdgcn_permlane32_swap(__float_as_uint(ps), __float_as_uint(ps), false, false);
    ps = __uint_as_float(rr[0]) + __uint_as_float(rr[1]); }
  l_reg = l_reg * alpha + ps;
#undef QF_SLOT
#undef QF_SWAP
}
template <int D0> __device__ __forceinline__ void pv_one(f32x16& od, int vb, bf16x8 pa0, bf16x8 pa1, bf16x8 pa2, bf16x8 pa3) {
  const s16x4 l0 = tr_read<v_rd_off(D0, 0, 0)>(vb), h0 = tr_read<v_rd_off(D0, 0, 1)>(vb), l1 = tr_read<v_rd_off(D0, 1, 0)>(vb), h1 = tr_read<v_rd_off(D0, 1, 1)>(vb);
  const s16x4 l2 = tr_read<v_rd_off(D0, 2, 0)>(vb), h2 = tr_read<v_rd_off(D0, 2, 1)>(vb), l3 = tr_read<v_rd_off(D0, 3, 0)>(vb), h3 = tr_read<v_rd_off(D0, 3, 1)>(vb);
  asm volatile("s_waitcnt lgkmcnt(0)" ::: "memory"); SBAR();
#define PK(L, H) (bf16x8){L[0], L[1], L[2], L[3], H[0], H[1], H[2], H[3]}
  od = __builtin_amdgcn_mfma_f32_32x32x16_bf16(pa0, PK(l0, h0), od, 0, 0, 0);
  od = __builtin_amdgcn_mfma_f32_32x32x16_bf16(pa1, PK(l1, h1), od, 0, 0, 0);
  od = __builtin_amdgcn_mfma_f32_32x32x16_bf16(pa2, PK(l2, h2), od, 0, 0, 0);
  od = __builtin_amdgcn_mfma_f32_32x32x16_bf16(pa3, PK(l3, h3), od, 0, 0, 0);
#undef PK
}
__device__ __forceinline__ void pv_d0(f32x16* o, int vb, bf16x8 pa0, bf16x8 pa1, bf16x8 pa2, bf16x8 pa3) {
  pv_one<0>(o[0], vb, pa0, pa1, pa2, pa3); pv_one<1>(o[1], vb, pa0, pa1, pa2, pa3); pv_one<2>(o[2], vb, pa0, pa1, pa2, pa3); pv_one<3>(o[3], vb, pa0, pa1, pa2, pa3);
}
__device__ __forceinline__ void pv_d0_exp(f32x16* o, int vb, bf16x8 pa0, bf16x8 pa1, bf16x8 pa2, bf16x8 pa3, f32x16& pn, const s16x4* vp) {
  asm volatile("s_waitcnt lgkmcnt(0)" ::: "memory"); SBAR();
#define PK(L, H) (bf16x8){L[0], L[1], L[2], L[3], H[0], H[1], H[2], H[3]}
  o[0] = __builtin_amdgcn_mfma_f32_32x32x16_bf16(pa0, PK(vp[0], vp[1]), o[0], 0, 0, 0);
  o[0] = __builtin_amdgcn_mfma_f32_32x32x16_bf16(pa1, PK(vp[2], vp[3]), o[0], 0, 0, 0);
  o[0] = __builtin_amdgcn_mfma_f32_32x32x16_bf16(pa2, PK(vp[4], vp[5]), o[0], 0, 0, 0);
  o[0] = __builtin_amdgcn_mfma_f32_32x32x16_bf16(pa3, PK(vp[6], vp[7]), o[0], 0, 0, 0);
#undef PK
#pragma unroll
  for (int r = 0; r < 4; ++r) pn[r] = __builtin_amdgcn_exp2f(pn[r]);
  pv_one<1>(o[1], vb, pa0, pa1, pa2, pa3);
#pragma unroll
  for (int r = 4; r < 8; ++r) pn[r] = __builtin_amdgcn_exp2f(pn[r]);
  pv_one<2>(o[2], vb, pa0, pa1, pa2, pa3);
#pragma unroll
  for (int r = 8; r < 12; ++r) pn[r] = __builtin_amdgcn_exp2f(pn[r]);
  pv_one<3>(o[3], vb, pa0, pa1, pa2, pa3);
#pragma unroll
  for (int r = 12; r < 16; ++r) pn[r] = __builtin_amdgcn_exp2f(pn[r]);
}
__device__ __forceinline__ void bmask(f32x16& p0, f32x16& p1, int dq0, int kj0, int hw, int L) {
  const float ninf = -__builtin_inff();
#pragma unroll
  for (int r = 0; r < 16; ++r) { const int c = (r & 3) + 8 * (r >> 2);
    const bool ok0 = ((unsigned)(dq0 + c + hw) <= (unsigned)(2 * hw)) && ((unsigned)(kj0 + c) < (unsigned)L);
    const bool ok1 = ((unsigned)(dq0 + c + 32 + hw) <= (unsigned)(2 * hw)) && ((unsigned)(kj0 + c + 32) < (unsigned)L);
    p0[r] = ok0 ? p0[r] : ninf; p1[r] = ok1 ? p1[r] : ninf; }
}
struct Band { int i0, L, hw, tlo; float m0, l0; float* lse; long lse_ld; };

template <bool BAND, int MODE>
__device__ __forceinline__ void attn_body(const bf16_t* __restrict__ Qb, const bf16_t* __restrict__ Kh, const bf16_t* __restrict__ Vh, bf16_t* __restrict__ Ob,
                                          const long ldq, const long ldk, const long ldo, const int NT, const Band bd, char* lds) {
  int tid = threadIdx.x; asm volatile("" : "+v"(tid));
  const int wid = tid >> 6, lane = tid & 63, r32 = lane & 31, hi = lane >> 5;
  char* V_lds = lds; char* K_lds = lds + 2 * SHM_V;
  float* ws = (float*)(lds + 2 * SHM_V + 2 * SHM_K) + wid * 64; float* li_l = ws; float* al_l = ws + 32;
  float m_reg = BAND ? bd.m0 : -1e30f, l_reg = BAND ? bd.l0 : 0.f; f32x16 o[4] = {}; bf16x8 qr[8];
  const bf16_t* Qw = Qb + (long)(wid * QBLK + r32) * ldq + hi * 8;
#pragma unroll
  for (int d0 = 0; d0 < 8; ++d0) qr[d0] = *reinterpret_cast<const bf16x8*>(Qw + d0 * 16);
  const int sr = tid >> 4, sc = (tid & 15) * 8, vst0 = v_st(sr, sc), vst1 = v_st(32 + sr, sc);
  const int vb0 = (int)(uintptr_t)V_lds + v_rd_base(lane);
  const int qi = BAND ? bd.i0 + wid * QBLK + r32 : 0;
  struct { bf16x8 vs0, vs1, ks0, ks1; } sr_[2];
#define KROW(k) (BAND ? (long)min(max((k), 0), bd.L - 1) : (long)(k))
  const long vkoff = (long)__builtin_amdgcn_readfirstlane((int)(Vh - Kh));
  const unsigned lofA = (unsigned)(sr * ldk + sc), lofB = (unsigned)((32 + sr) * ldk + sc);
#define SLOAD(i, jt) do { const int k0_ = (BAND ? bd.tlo + (jt) : (jt)) * KVBLK; \
    if (BAND) { const long ra_ = KROW(k0_ + sr) * ldk + sc, rb_ = KROW(k0_ + 32 + sr) * ldk + sc; \
      sr_[i].ks0 = *reinterpret_cast<const bf16x8*>(Kh + ra_); sr_[i].ks1 = *reinterpret_cast<const bf16x8*>(Kh + rb_); \
      sr_[i].vs0 = *reinterpret_cast<const bf16x8*>(Vh + ra_); sr_[i].vs1 = *reinterpret_cast<const bf16x8*>(Vh + rb_); } \
    else { const unsigned long long kb_ = (unsigned long long)(Kh + (long)k0_ * ldk); \
      const GAS bf16_t* kt_ = (const GAS bf16_t*)(((unsigned long long)(unsigned)__builtin_amdgcn_readfirstlane((unsigned)(kb_ >> 32)) << 32) | (unsigned long long)(unsigned)__builtin_amdgcn_readfirstlane((unsigned)kb_)); \
      const GAS bf16_t* vt_ = kt_ + vkoff; \
      sr_[i].ks0 = *(const GAS bf16x8*)(kt_ + lofA); sr_[i].ks1 = *(const GAS bf16x8*)(kt_ + lofB); \
      sr_[i].vs0 = *(const GAS bf16x8*)(vt_ + lofA); sr_[i].vs1 = *(const GAS bf16x8*)(vt_ + lofB); } } while (0)
#define SWRITE(b, i) do { *(bf16x8*)(V_lds + (b) * SHM_V + vst0) = sr_[i].vs0;          \
    *(bf16x8*)(V_lds + (b) * SHM_V + vst1) = sr_[i].vs1; int kc = sc * 2;               \
    *(bf16x8*)(K_lds + (b) * SHM_K + KSWZ(sr, kc)) = sr_[i].ks0;                       \
    *(bf16x8*)(K_lds + (b) * SHM_K + KSWZ(32 + sr, kc)) = sr_[i].ks1; } while (0)
#define SWRITE_V(b, i) do { *(bf16x8*)(V_lds + (b) * SHM_V + vst0) = sr_[i].vs0; *(bf16x8*)(V_lds + (b) * SHM_V + vst1) = sr_[i].vs1; } while (0)
#define SWAIT() asm volatile("s_waitcnt vmcnt(4)" ::: "memory")
#define RESC(a) do { if (MODE != 2 && __any((a) < 1.f)) { if (hi == 0) al_l[r32] = (a); asm volatile("s_waitcnt lgkmcnt(0)" ::: "memory"); \
    _Pragma("unroll") for (int d = 0; d < 4; ++d) _Pragma("unroll") for (int r = 0; r < 16; ++r) o[d][r] *= al_l[crow(r, hi)]; } } while (0)
#define BMASK(P0, P1, jt) do { if (BAND) { const int kt_ = (bd.tlo + (jt)) * KVBLK + 4 * hi; bmask(P0, P1, kt_ - qi, kt_, bd.hw, bd.L); } } while (0)
  f32x16 pA0, pA1, pB0, pB1; float mnA, mnB, alA, alB; bf16x8 pa0, pa1, pa2, pa3; s16x4 vpre[8];
  constexpr int SE = 0, SO = 1;
  SLOAD(SE, 0); asm volatile("s_waitcnt vmcnt(0)" ::: "memory"); SWRITE(0, SE); __syncthreads();
  qkt(pA0, pA1, K_lds, qr, r32, hi); BMASK(pA0, pA1, 0); partialSM<MODE>(pA0, pA1, m_reg, mnA, alA);
  SLOAD(SO, 1); if (2 < NT) SLOAD(SE, 2);
  SWAIT(); SWRITE(1, SO); __syncthreads();
  for (int j = 1; j + 1 < NT; j += 2) {
    SBAR(); qkt_fin<MODE == 2, true, true>(pB0, pB1, K_lds + SHM_K, qr, r32, hi, pA0, pA1, alA, l_reg, pa0, pa1, pa2, pa3, vb0, vpre,
                                           K_lds + KSWZ(sr, sc * 2), K_lds + KSWZ(32 + sr, sc * 2), sr_[SE].ks0, sr_[SE].ks1, V_lds + SHM_V + vst0, V_lds + SHM_V + vst1, sr_[SO].vs0, sr_[SO].vs1); SBAR();
    SLOAD(SO, j + 2); SBAR();
    if (MODE == 2) { pv_d0_exp(o, vb0, pa0, pa1, pa2, pa3, pB0, vpre); mnB = 0.f; alB = 1.f; }
    else { pv_d0(o, vb0, pa0, pa1, pa2, pa3); BMASK(pB0, pB1, j); partialSM<MODE>(pB0, pB1, m_reg, mnB, alB); }
    RESC(alB); __syncthreads();
    SBAR(); qkt_fin<MODE == 2, true, true>(pA0, pA1, K_lds, qr, r32, hi, pB0, pB1, alB, l_reg, pa0, pa1, pa2, pa3, vb0 + (int)SHM_V, vpre,
                                           K_lds + SHM_K + KSWZ(sr, sc * 2), K_lds + SHM_K + KSWZ(32 + sr, sc * 2), sr_[SO].ks0, sr_[SO].ks1, V_lds + vst0, V_lds + vst1, sr_[SE].vs0, sr_[SE].vs1); SBAR();
    if (j + 3 < NT) SLOAD(SE, j + 3); SBAR();
    if (MODE == 2) { pv_d0_exp(o, vb0 + (int)SHM_V, pa0, pa1, pa2, pa3, pA0, vpre); mnA = 0.f; alA = 1.f; }
    else { pv_d0(o, vb0 + (int)SHM_V, pa0, pa1, pa2, pa3); BMASK(pA0, pA1, j + 1); partialSM<MODE>(pA0, pA1, m_reg, mnA, alA); }
    RESC(alA); __syncthreads();
  }
  SBAR(); qkt_fin<false, false, true>(pB0, pB1, K_lds + SHM_K, qr, r32, hi, pA0, pA1, alA, l_reg, pa0, pa1, pa2, pa3, 0, vpre,
                                      nullptr, nullptr, sr_[SE].ks0, sr_[SE].ks1, V_lds + SHM_V + vst0, V_lds + SHM_V + vst1, sr_[SO].vs0, sr_[SO].vs1); SBAR();
  pv_d0(o, vb0, pa0, pa1, pa2, pa3); BMASK(pB0, pB1, NT - 1); partialSM<MODE>(pB0, pB1, m_reg, mnB, alB);
  __syncthreads(); RESC(alB);
  finishSM(pB0, pB1, alB, l_reg, pa0, pa1, pa2, pa3); SBAR();
  pv_d0(o, vb0 + (int)SHM_V, pa0, pa1, pa2, pa3);
  if (hi == 0) li_l[r32] = l_reg; asm volatile("s_waitcnt lgkmcnt(0)" ::: "memory");
  float rli[16];
#pragma unroll
  for (int r = 0; r < 16; ++r) rli[r] = __builtin_amdgcn_rcpf(li_l[crow(r, hi)]);
  bf16_t* Ow = Ob + (long)(wid * QBLK) * ldo;
  const int odd = lane & 1;
#pragma unroll
  for (int r = 0; r < 16; r += 2) { const long orow = crow(r, hi) + odd;
#pragma unroll
    for (int d0 = 0; d0 < 4; ++d0) { const float a = o[d0][r] * rli[r], b = o[d0][r + 1] * rli[r + 1];
      const float snd = odd ? a : b;
      const float rcv = __int_as_float(__builtin_amdgcn_mov_dpp(__float_as_int(snd), 0xB1, 0xF, 0xF, true));
      const unsigned pk = odd ? cvtpk(rcv, b) : cvtpk(a, rcv);
      *(unsigned*)(Ow + orow * ldo + d0 * 32 + (r32 & ~1)) = pk; } }
  if (BAND) { if (bd.lse != nullptr && hi == 0) bd.lse[(long)(wid * QBLK + r32) * bd.lse_ld] = m_reg * SCALE + __logf(l_reg); }
  __syncthreads();
#undef KROW
#undef SLOAD
#undef SWRITE
#undef SWAIT
#undef SWRITE_V
#undef RESC
#undef BMASK
}
}

constexpr size_t MiB = 1u << 20;
constexpr size_t WS_CTL = 0;
constexpr int NSS = 3 * DEPTH + 1;
constexpr size_t CTL_ZERO_BYTES = 1 * MiB;
constexpr size_t WS_ROPE = 1 * MiB;
constexpr size_t WS_ROPEX = 9 * MiB;
constexpr size_t WS_LSE = 10 * MiB;
constexpr size_t WS_SS = 12 * MiB;
constexpr size_t WS_W = 32 * MiB;
static_assert(WS_SS + (size_t)NSS * M * 8 * 4 <= WS_W, "ssq buffers");
constexpr size_t WO_F1IN = 0, WO_F1OUT = WO_F1IN + (size_t)NFF2 * DM * 2, WO_PG = WO_F1OUT + (size_t)DM * DFF * 2, WO_BR = WO_PG + (size_t)PGW * DM * 2,
                 WO_WO = WO_BR + (size_t)DM * DM * 2, WO_F2IN = WO_WO + (size_t)DM * DM * 2, WO_F2OUT = WO_F2IN + (size_t)NFF2 * DM * 2, W_BYTES = WO_F2OUT + (size_t)DM * DFF * 2;
constexpr size_t W_SLOT = ((W_BYTES + MiB - 1) / MiB) * MiB;
constexpr size_t WS_HI = WS_W + 2 * W_SLOT;
constexpr size_t WS_LO = WS_HI + (size_t)M * DM * 2;
constexpr size_t WS_Y = WS_LO + (STREAM_LO ? (size_t)M * DM * 2 : 0);
constexpr size_t WS_BIG = WS_Y + (size_t)M * DM * 2;
constexpr size_t WS_PROJ = WS_BIG, WS_GATES = WS_BIG + (size_t)M * INW * 2, WS_MERGED = WS_PROJ;
constexpr size_t WS_END = WS_GATES + (size_t)M * GATEW;
static_assert((size_t)M * DFF * 2 <= WS_END - WS_BIG, "act fits the overlay");
constexpr int CW_BAR = 4096;

constexpr int RING_OFF = 0, RING_BYTES = 131072;
constexpr int LDSCTL_OFF = RING_BYTES, MISC_OFF = LDSCTL_OFF + 320, HTAB_OFF = LDSCTL_OFF + 1024, RSTD_OFF = HTAB_OFF + 8192;
constexpr int LDS_BYTES = 147456;
constexpr int NWAVES = 8;

typedef GAS unsigned gu32;
#define RLX_AGENT __ATOMIC_RELAXED, __HIP_MEMORY_SCOPE_AGENT
#define LDS_WAIT() asm volatile("s_waitcnt lgkmcnt(0)" ::: "memory")

#define XB_TMO      128
#define XB_XCNT(j)  (256  + 64 * (j))
#define XB_XSUB(j)  (1280 + 64 * (j))
#define XB_XGEN(j)  (2304 + 64 * (j))
#define XB_TOP      3328
#define XB_TOPGEN   3392
#define XCD_BAR_WORDS 3456
#define XB_SPIN_CAP (1u << 22)
__device__ __forceinline__ unsigned xb_ld(unsigned* p)              { return __hip_atomic_load(p, __ATOMIC_RELAXED, __HIP_MEMORY_SCOPE_AGENT); }
__device__ __forceinline__ unsigned xb_add(unsigned* p, unsigned v) { return __hip_atomic_fetch_add(p, v, __ATOMIC_RELAXED, __HIP_MEMORY_SCOPE_AGENT); }
__device__ __forceinline__ unsigned xb_xcc_id() { return (unsigned)__builtin_amdgcn_s_getreg((3 << 11) | 20) & 0xFu; }
#define XB_SPIN(cond, bar) do { unsigned _sp = 0; while (cond) { __builtin_amdgcn_s_sleep(1); \
    if ((++_sp & 255u) == 0u) { if (xb_ld(&(bar)[XB_TMO])) break; if (_sp > XB_SPIN_CAP) { atomicAdd(&(bar)[XB_TMO], 1u); break; } } } } while (0)
struct XcdBarrier { unsigned* bar; unsigned x; volatile LAS unsigned* st; };
__device__ __forceinline__ XcdBarrier xcd_barrier_post(unsigned* bar, volatile LAS unsigned* st) {
    XcdBarrier b; b.bar = bar; b.x = xb_xcc_id(); b.st = st;
    if (threadIdx.x == 0) (void)xb_add(&bar[XB_XCNT(b.x)], 1u);
    return b;
}
__device__ __forceinline__ void xcd_barrier_complete(unsigned* bar, unsigned x, unsigned& nloc, unsigned& nx) {
    const unsigned G = gridDim.x * gridDim.y * gridDim.z;
    unsigned sum, cnt, mine, sp = 0u;
    for (;;) {
        sum = 0u; cnt = 0u; mine = 0u;
#pragma unroll
        for (unsigned j = 0; j < 16; ++j) { const unsigned c = xb_ld(&bar[XB_XCNT(j)]); sum += c; cnt += (c > 0u) ? 1u : 0u; mine = (j == x) ? c : mine; }
        if (sum == G) break;
        __builtin_amdgcn_s_sleep(1);
        if ((++sp & 255u) == 0u) { if (xb_ld(&bar[XB_TMO])) break; if (sp > XB_SPIN_CAP) { atomicAdd(&bar[XB_TMO], 1u); break; } }
    }
    nloc = mine > 0u ? mine : 1u; nx = cnt > 0u ? cnt : 1u;
}
__device__ __forceinline__ void xcd_barrier(const XcdBarrier& b) {
    asm volatile("s_waitcnt vmcnt(0)" ::: "memory");
    __syncthreads();
    if (threadIdx.x == 0) {
        unsigned* bar = b.bar;
        __builtin_amdgcn_s_waitcnt(0);
        unsigned nloc = b.st[0], nx = b.st[1];
        if (nloc == 0u) { xcd_barrier_complete(bar, b.x, nloc, nx); b.st[0] = nloc; b.st[1] = nx; }
        const unsigned old = xb_add(&bar[XB_XSUB(b.x)], 1u);
        const unsigned gen = old / nloc;
        if (old + 1u == (gen + 1u) * nloc) {
            __builtin_amdgcn_fence(__ATOMIC_RELEASE, "agent");
            asm volatile("s_waitcnt vmcnt(0)" ::: "memory");
            const unsigned og = xb_add(&bar[XB_TOP], 1u);
            const unsigned tg = og / nx;
            if (og + 1u == (tg + 1u) * nx) xb_add(&bar[XB_TOPGEN], 1u);
            else XB_SPIN(xb_ld(&bar[XB_TOPGEN]) == tg, bar);
            __builtin_amdgcn_fence(__ATOMIC_ACQUIRE, "agent");
            xb_add(&bar[XB_XGEN(b.x)], 1u);
            asm volatile("s_waitcnt vmcnt(0)" ::: "memory");
        } else {
            XB_SPIN(xb_ld(&bar[XB_XGEN(b.x)]) == gen, bar);
            __builtin_amdgcn_fence(__ATOMIC_ACQUIRE, "agent");
            asm volatile("s_waitcnt vmcnt(0)" ::: "memory");
        }
    }
    __syncthreads();
}

__device__ __forceinline__ float wave_sum(float v) {
#pragma unroll
    for (int o = 1; o < 64; o <<= 1) v += __shfl_xor(v, o);
    return v;
}
__device__ __forceinline__ int w_in_row(int n) {
    const int d = n & 127, hb = n & ~127;
    const bool plain = (n >= COL_VA && n < COL_QB) || (n >= COL_VB && n < COL_QC) || (n >= COL_VC), axial = (n >= COL_QC && n < COL_VC);
    const int cs = 2 * (d & 63) + (d >> 6), ca = 2 * ((d & 31) + 32 * (d >> 6)) + ((d >> 5) & 1);
    return FUSE_PREP ? hb + (plain ? d : (axial ? ca : cs)) : n;
}
template <bool MAPIN>
__device__ __forceinline__ void transpose_item(const float* W, int K, int N, bf16_t* WT, int k0, int n0, int drow, const float* gain, LAS float* scr, int lane) {
    float wv[32];
#pragma unroll
    for (int i = 0; i < 32; ++i) wv[i] = W[(size_t)(k0 + 2 * i + (lane >> 5)) * N + n0 + (lane & 31)];
    if (gain) {
#pragma unroll
        for (int i = 0; i < 32; ++i) wv[i] *= gain[k0 + 2 * i + (lane >> 5)];
    }
#pragma unroll
    for (int i = 0; i < 32; ++i) scr[(2 * i + (lane >> 5)) * 33 + (lane & 31)] = wv[i];
    LDS_WAIT(); asm volatile("" ::: "memory");
    const int c = lane & 7;
#pragma unroll
    for (int j = 0; j < 4; ++j) { const int n = (lane >> 3) + 8 * j; const LAS float* s = scr + (8 * c) * 33 + n;
        u32x4 o; o.x = pk2(s[0 * 33], s[1 * 33]); o.y = pk2(s[2 * 33], s[3 * 33]); o.z = pk2(s[4 * 33], s[5 * 33]); o.w = pk2(s[6 * 33], s[7 * 33]);
        const int dr = MAPIN ? w_in_row(n0 + n) : drow + n;
        *(GAS u32x4*)(WT + (size_t)dr * K + k0 + 8 * c) = o; }
    LDS_WAIT(); asm volatile("" ::: "memory");
}
__device__ __forceinline__ void sincos_d(double a, float& s, float& c) {
    const double q = rint(a * 0.63661977236758134308);
    double y = fma(-q, 1.5707963267948966192, a); y = fma(-q, 6.123233995736766e-17, y);
    const double y2 = y * y;
    double sp = 1.0 / 6227020800.0; sp = fma(sp, y2, -1.0 / 39916800.0); sp = fma(sp, y2, 1.0 / 362880.0); sp = fma(sp, y2, -1.0 / 5040.0); sp = fma(sp, y2, 1.0 / 120.0); sp = fma(sp, y2, -1.0 / 6.0); sp = fma(sp, y2, 1.0);
    const double sy = y * sp;
    double cp = -1.0 / 87178291200.0; cp = fma(cp, y2, 1.0 / 479001600.0); cp = fma(cp, y2, -1.0 / 3628800.0); cp = fma(cp, y2, 1.0 / 40320.0); cp = fma(cp, y2, -1.0 / 720.0); cp = fma(cp, y2, 1.0 / 24.0); cp = fma(cp, y2, -0.5); cp = fma(cp, y2, 1.0);
    const int k = (int)q & 3;
    const double ss = (k & 1) ? cp : sy, cc = (k & 1) ? sy : cp;
    s = (float)((k & 2) ? -ss : ss); c = (float)(((k + 1) & 2) ? -cc : cc);
}

__device__ __forceinline__ void convert_layer(const float* const* in, int l, bf16_t* Wb, LAS unsigned char* ldsl, int gw, int NGW, int lane, int wave) {

                LAS float* scr = (LAS float*)(ldsl + RING_OFF + wave * 16384);
                constexpr int I_FIN = (DM / 64) * (NFF2 / 32), I_FOUT = (DFF / 64) * (DM / 32), I_IN = (DM / 64) * (INW / 32), I_GT = (DM / 64) * (GATEW / 32), I_SQ = (DM / 64) * (DM / 32);
                constexpr int NITEMS = 2 * I_FIN + 2 * I_FOUT + I_IN + I_GT + 2 * I_SQ;
                const float* w_f1in = in[3] + (size_t)l * DM * NFF2; const float* w_f1out = in[4] + (size_t)l * DFF * DM;
                const float* w_in = in[6] + (size_t)l * DM * INW; const float* w_br = in[10] + (size_t)l * DM * DM;
                const float* w_gt = in[11] + (size_t)l * DM * GATEW; const float* w_o = in[13] + (size_t)l * DM * DM;
                const float* w_f2in = in[15] + (size_t)l * DM * NFF2; const float* w_f2out = in[16] + (size_t)l * DFF * DM;
                const float* g1 = in[2] + (size_t)l * DM; const float* gm = in[5] + (size_t)l * DM; const float* g2 = in[14] + (size_t)l * DM;
                for (int it = gw; it < NITEMS; it += NGW) {
                    int r = it;
                    if (r < 2 * I_FIN) { const bool sec = r >= I_FIN; if (sec) r -= I_FIN; const int nblk = NFF2 / 32, kb = r / nblk, nb = r % nblk, n0 = nb * 32;
                        const int half = n0 >= DFF ? 1 : 0, rem = n0 - half * DFF, drow = (rem >> 7) * 256 + half * 128 + (rem & 127);
                        transpose_item<false>(sec ? w_f2in : w_f1in, DM, NFF2, (bf16_t*)((char*)Wb + (sec ? WO_F2IN : WO_F1IN)), kb * 64, n0, drow, sec ? g2 : g1, scr, lane); continue; }
                    r -= 2 * I_FIN;
                    if (r < 2 * I_FOUT) { const bool sec = r >= I_FOUT; if (sec) r -= I_FOUT; const int nblk = DM / 32, kb = r / nblk, nb = r % nblk;
                        transpose_item<false>(sec ? w_f2out : w_f1out, DFF, DM, (bf16_t*)((char*)Wb + (sec ? WO_F2OUT : WO_F1OUT)), kb * 64, nb * 32, nb * 32, nullptr, scr, lane); continue; }
                    r -= 2 * I_FOUT;
                    if (r < I_IN) { const int nblk = INW / 32, kb = r / nblk, nb = r % nblk;
                        transpose_item<true>(w_in, DM, INW, (bf16_t*)((char*)Wb + WO_PG), kb * 64, nb * 32, 0, gm, scr, lane); continue; }
                    r -= I_IN;
                    if (r < I_GT) { const int nblk = GATEW / 32, kb = r / nblk, nb = r % nblk;
                        transpose_item<false>(w_gt, DM, GATEW, (bf16_t*)((char*)Wb + WO_PG), kb * 64, nb * 32, INW + nb * 32, gm, scr, lane); continue; }
                    r -= I_GT;
                    { const bool sec = r >= I_SQ; if (sec) r -= I_SQ; const int nblk = DM / 32, kb = r / nblk, nb = r % nblk;
                        transpose_item<false>(sec ? w_o : w_br, DM, DM, (bf16_t*)((char*)Wb + (sec ? WO_WO : WO_BR)), kb * 64, nb * 32, nb * 32, nullptr, scr, lane); }
                }
            }

struct Args { const float* in[18]; float* out; unsigned char* ws; int ph_lo, ph_hi; };
constexpr int PH_PER_STEP = 10, PH_FINAL = NSTEP * PH_PER_STEP, PH_END = PH_FINAL + 1;

__global__ void __launch_bounds__(NWAVES * 64, 2) fwd_kernel(Args args) {
    extern __shared__ __attribute__((aligned(16))) unsigned char lds[];
    LAS unsigned char* ldsl = (LAS unsigned char*)lds;
    volatile LAS unsigned* MISC = (volatile LAS unsigned*)(ldsl + MISC_OFF);
    const int G = gridDim.x; const int bx = blockIdx.x;
    const int vcu = (G % 8 == 0) ? (bx % 8) * (G / 8) + bx / 8 : bx;
    unsigned char* ws = args.ws;
    gu32* ctl = (gu32*)(ws + WS_CTL);
    for (int u = threadIdx.x; u < (LDS_BYTES - LDSCTL_OFF) / 4; u += NWAVES * 64) ((LAS unsigned*)(ldsl + LDSCTL_OFF))[u] = 0u;
    __syncthreads();
    const int lo = args.ph_lo, hi = args.ph_hi;
    const bool one_launch = (hi - lo) > 1;
    XcdBarrier bar; bar.bar = (unsigned*)(ctl + CW_BAR); bar.x = 0; bar.st = nullptr;
    if (one_launch) bar = xcd_barrier_post((unsigned*)(ctl + CW_BAR), MISC + 8);
    bool first = true;
#ifndef PH_MASK
#define PH_MASK 0xFFFF
#endif
#define PHASE_BEGIN(p) if (((PH_MASK >> ((p) == PH_FINAL ? 10 : (p) % PH_PER_STEP)) & 1) && lo <= (p) && (p) < hi) { if (!first) xcd_barrier(bar); first = false; \
    for (int rep_ = 0; rep_ <= ((REP_MASK >> ((p) == PH_FINAL ? 10 : (p) % PH_PER_STEP)) & 1); ++rep_) {
#define PHASE_END } }

    const float* xp = args.in[0]; const float* xs = args.in[1];
    float* out = args.out;
    f32x2* rope = (f32x2*)(ws + WS_ROPE); f32x2* ropex = (f32x2*)(ws + WS_ROPEX);
    float* lseb = (float*)(ws + WS_LSE); float* ssb = (float*)(ws + WS_SS);
    bf16_t* HI = (bf16_t*)(ws + WS_HI); bf16_t* LO = (bf16_t*)(ws + WS_LO); bf16_t* Y = (bf16_t*)(ws + WS_Y); bf16_t* MERGED = (bf16_t*)(ws + WS_MERGED);
    bf16_t* ACT = (bf16_t*)(ws + WS_BIG); bf16_t* PROJ = (bf16_t*)(ws + WS_PROJ); bf16_t* GATES = (bf16_t*)(ws + WS_GATES);
    const int NGW = G * NWAVES;
#define LOCAL_IDS int tid = threadIdx.x; asm volatile("" : "+v"(tid)); const int lane = tid & 63, wave = __builtin_amdgcn_readfirstlane(tid >> 6), gw = vcu * NWAVES + wave; (void)lane; (void)gw;
#define XCD_STAGGER(ticks) do { const unsigned long long t0_ = __builtin_amdgcn_s_memrealtime(), dl_ = (unsigned long long)((bx & 7) * (ticks)); \
        while (__builtin_amdgcn_s_memrealtime() - t0_ < dl_) __builtin_amdgcn_s_sleep(8); } while (0)
    if (lo == 0) {
        int tid = threadIdx.x; asm volatile("" : "+v"(tid));
        const int gt = vcu * NWAVES * 64 + tid, NGT = G * NWAVES * 64;
        for (int e = gt; e < S_P * 64 + 256 * 32; e += NGT) {
            const bool ax = e >= S_P * 64; const int ee = ax ? e - S_P * 64 : e; const int pos = ax ? ee >> 5 : ee >> 6, i = ax ? ee & 31 : ee & 63;
            const double base = ax ? 0.7498942093324559 : 0.8659643233600653; double inv = 1.0; double bp = base; int ii = i;
            for (int b = 0; b < 6; ++b) { if (ii & 1) inv *= bp; bp *= bp; ii >>= 1; }
            float sn, cs; sincos_d((double)pos * inv, sn, cs);
            (ax ? ropex : rope)[ee] = (f32x2){cs, sn};
        }
    }

    for (int s = 0; s < NSTEP; ++s) {
        const int l = s >> 1, which = s & 1, pb = s * PH_PER_STEP;
        bf16_t* Wb = (bf16_t*)(ws + WS_W + (size_t)(l & 1) * W_SLOT);
        if (s == 0) {
        PHASE_BEGIN(pb + 0)
            LOCAL_IDS
            convert_layer(args.in, l, Wb, ldsl, gw, NGW, lane, wave);
            if (s == 0) {
                for (int m = gw; m < M; m += NGW) {
                    const float* xrow = m < S_P ? xp + (size_t)m * DM : xs + (size_t)(m - S_P) * DM;
                    const GAS f32x4* xr = (const GAS f32x4*)xrow + lane; f32x4 v[8]; float sq = 0.f;
#pragma unroll
                    for (int j = 0; j < 8; ++j) { v[j] = xr[64 * j]; sq += (v[j].x * v[j].x + v[j].y * v[j].y) + (v[j].z * v[j].z + v[j].w * v[j].w); }
                    sq = wave_sum(sq); if (lane < 8) ssb[(size_t)m * 8 + lane] = lane == 0 ? sq : 0.f;
                    GAS u32x2* oh = (GAS u32x2*)(HI + (size_t)m * DM) + lane; GAS u32x2* ol = (GAS u32x2*)(LO + (size_t)m * DM) + lane;
#pragma unroll
                    for (int j = 0; j < 8; ++j) { const u32x2 h = (u32x2){cvt_pk_bf16(v[j].x, v[j].y), cvt_pk_bf16(v[j].z, v[j].w)};
                        oh[64 * j] = h; if (STREAM_LO) ol[64 * j] = (u32x2){cvt_pk_bf16(v[j].x - bf_lo(h.x), v[j].y - bf_hi(h.x)), cvt_pk_bf16(v[j].z - bf_lo(h.y), v[j].w - bf_hi(h.y))}; }
                }
            }
        PHASE_END
        }
        PHASE_BEGIN(pb + 1)
            pg8::PlainSched S; S.so.init(M, NFF2, G, bx, 8); S.nt = DM / 64;
            pg8::EpiSwiglu E{ACT, ssb + (size_t)(3 * l + 2 * which) * M * 8, (LAS float*)(ldsl + RSTD_OFF), -1};
            pg8::gemm_phase<pg8::EpiSwiglu, pg8::PlainSched>(ldsl + RING_OFF, HI, (const bf16_t*)((char*)Wb + (which ? WO_F2IN : WO_F1IN)), DM, S, E);
        PHASE_END
        PHASE_BEGIN(pb + 2)
            pg8::PlainSched S; S.so.init(M, DM, G, bx, 4); S.nt = DFF / 64;
            pg8::EpiStream E{HI, LO, ssb + (size_t)(3 * l + 1 + 2 * which) * M * 8, rep_ == ((REP_MASK >> 2) & 1) ? 0.5f : 0.f, (LAS float*)(ldsl + HTAB_OFF)};
            pg8::gemm_phase<pg8::EpiStream, pg8::PlainSched>(ldsl + RING_OFF, ACT, (const bf16_t*)((char*)Wb + (which ? WO_F2OUT : WO_F1OUT)), DFF, S, E);
        PHASE_END
        if (which == 0) {
        PHASE_BEGIN(pb + 4)
            pg8::PlainSched S; S.so.init(M, PGW, G, bx, 8); S.nt = DM / 64;
            pg8::EpiProjGate E{PROJ, GATES, args.in[12] + (size_t)l * GATEW, ssb + (size_t)(3 * l + 1) * M * 8, rope, ropex, args.in[8] + (size_t)l * 128, args.in[9] + (size_t)l * 128, (LAS float*)(ldsl + HTAB_OFF), (LAS float*)(ldsl + RSTD_OFF), -1};
            pg8::gemm_phase<pg8::EpiProjGate, pg8::PlainSched>(ldsl + RING_OFF, HI, (const bf16_t*)((char*)Wb + WO_PG), DM, S, E);
        PHASE_END
        if (!FUSE_PREP) { PHASE_BEGIN(pb + 5)
            LOCAL_IDS
            const float* gq = args.in[8] + (size_t)l * 128; const float* gk = args.in[9] + (size_t)l * 128;
            const int e1x = (lane >> 5) * 64 + (lane & 31), e2x = e1x + 32;
            const float gq1 = gq[e1x], gq2 = gq[e2x], gk1 = gk[e1x], gk2 = gk[e2x];
            const float pz = rep_ == ((REP_MASK >> 5) & 1) ? 1.f : 0.f, pk = 1.f - pz;
            for (int m = gw; m < M; m += NGW) {
                const int pos = m < S_P ? m : (m & (S_S - 1));
                const f32x2 cs = rope[pos * 64 + lane];
                const int idx = (lane >> 5) ? (pos & 63) : (pos >> 6);
                const f32x2 cx = ropex[idx * 32 + (lane & 31)];
                bf16_t* row = PROJ + (size_t)m * INW;
#pragma unroll 6
                for (int hh = 0; hh < 18; ++hh) {
                    bf16_t* hp = row + (hh < 6 ? hh * 128 : COL_QB + (hh - 6) * 128);
                    const float x1 = __uint_as_float((unsigned)hp[lane] << 16), x2 = __uint_as_float((unsigned)hp[lane + 64] << 16);
                    hp[lane] = (bf16_t)f2bf(REP_MASK ? pk * x1 + pz * (x1 * cs.x - x2 * cs.y) : x1 * cs.x - x2 * cs.y); hp[lane + 64] = (bf16_t)f2bf(REP_MASK ? pk * x2 + pz * (x2 * cs.x + x1 * cs.y) : x2 * cs.x + x1 * cs.y);
                }
#pragma unroll 4
                for (int hh = 0; hh < 8; ++hh) {
                    bf16_t* hp = row + COL_QC + hh * 128;
                    const float x1 = __uint_as_float((unsigned)hp[e1x] << 16), x2 = __uint_as_float((unsigned)hp[e2x] << 16);
                    const float rstd = 1.0f / sqrtf(wave_sum(x1 * x1 + x2 * x2) * (1.0f / 128.0f) + NORM_EPS);
                    const float y1 = x1 * rstd * (hh < 6 ? gq1 : gk1), y2 = x2 * rstd * (hh < 6 ? gq2 : gk2);
                    hp[e1x] = (bf16_t)f2bf(REP_MASK ? pk * x1 + pz * (y1 * cx.x - y2 * cx.y) : y1 * cx.x - y2 * cx.y); hp[e2x] = (bf16_t)f2bf(REP_MASK ? pk * x2 + pz * (y2 * cx.x + y1 * cx.y) : y2 * cx.x + y1 * cx.y);
                }
            }
        PHASE_END }
        PHASE_BEGIN(pb + 6)
            char* alds = (char*)lds + RING_OFF;
            att::Band nob{0, 0, 0, 0, -1e30f, 0.f, nullptr, 0};
            float cb; { const float* gqp = args.in[8] + (size_t)l * 128; const float* gkp = args.in[9] + (size_t)l * 128; int ln = threadIdx.x; asm volatile("" : "+v"(ln)); ln &= 63;
                float a = fmaxf(fabsf(gqp[ln]), fabsf(gqp[ln + 64])), b = fmaxf(fabsf(gkp[ln]), fabsf(gkp[ln + 64]));
#pragma unroll
                for (int o = 1; o < 64; o <<= 1) { a = fmaxf(a, __shfl_xor(a, o)); b = fmaxf(b, __shfl_xor(b, o)); }
                cb = __builtin_amdgcn_readfirstlane(a * b * (128.0f * att::SCALE * 1.4426950408889634f)); }
            if (cb < 40.0f) {
            for (int v = vcu; v < 256; v += G) {
                const bool pr = v < 128;
                const int nun = pr ? 3 : 6, x = (v - 128) >> 5, qb = pr ? (v & 63) : (v & 31);
                for (int r6 = 0; r6 < nun; ++r6) {
                    const int pair = x * 2 + r6 / 3, sq = pair >> 1, kvh = pr ? (v >> 6) : (pair & 1), h = kvh * 3 + (r6 % 3);
                    const size_t sb = pr ? 0 : (size_t)S_P + (size_t)sq * S_S, r0 = sb + (size_t)qb * 256;
                    att::attn_body<false, 2>(PROJ + r0 * INW + COL_QC + h * 128, PROJ + sb * INW + COL_KC + kvh * 128, PROJ + sb * INW + COL_VC + kvh * 128, Y + r0 * DM + YCOL_C + h * 128, INW, INW, DM, pr ? S_P / 64 : S_S / 64, nob, alds);
                }
            }
            } else {
            for (int v = vcu; v < 256; v += G) {
                const bool pr = v < 128;
                const int nun = pr ? 3 : 6, x = (v - 128) >> 5, qb = pr ? (v & 63) : (v & 31);
                for (int r6 = 0; r6 < nun; ++r6) {
                    const int pair = x * 2 + r6 / 3, sq = pair >> 1, kvh = pr ? (v >> 6) : (pair & 1), h = kvh * 3 + (r6 % 3);
                    const size_t sb = pr ? 0 : (size_t)S_P + (size_t)sq * S_S, r0 = sb + (size_t)qb * 256;
                    att::attn_body<false, 1>(PROJ + r0 * INW + COL_QC + h * 128, PROJ + sb * INW + COL_KC + kvh * 128, PROJ + sb * INW + COL_VC + kvh * 128, Y + r0 * DM + YCOL_C + h * 128, INW, INW, DM, pr ? S_P / 64 : S_S / 64, nob, alds);
                }
            }
            }
            const float* sink = args.in[7] + (size_t)l * 4;
            for (int u = vcu; u < 768 + 1152; u += G) {
                const bool isA = u < 768; const int ub = u - 768;
                const int hh = isA ? (u & 3) : ub % 6, blk = isA ? (u >> 2) : ub / 6, dil = isA ? 1 : (hh < 2 ? 1 : (hh < 4 ? 4 : 16));
                const int R0 = blk * 256; const int sb = R0 < S_P ? 0 : S_P + ((R0 - S_P) / S_S) * S_S, Ls = R0 < S_P ? S_P : S_S;
                const int bis = (R0 - sb) / 256, L = Ls / dil, nbr = L / 256, res = bis / nbr, i0 = (bis - res * nbr) * 256;
                const size_t t0 = (size_t)sb + res + (size_t)i0 * dil;
                att::Band bd; bd.i0 = i0; bd.L = L; bd.hw = isA ? 128 : 64; bd.tlo = i0 / 64 - (isA ? 2 : 1); bd.m0 = isA ? sink[hh] * (1.0f / att::SCALE) : -1e30f; bd.l0 = isA ? 1.0f : 0.f;
                bd.lse = isA ? nullptr : lseb + t0 * 8 + hh; bd.lse_ld = (long)8 * dil;
                const bf16_t* pb_ = PROJ + ((size_t)sb + res) * INW;
                const int cq = isA ? COL_QA + hh * 128 : COL_QB + hh * 128, ck = isA ? COL_KA + (hh >> 1) * 128 : COL_KB + hh * 128, cv = isA ? COL_VA + (hh >> 1) * 128 : COL_VB + hh * 128;
                att::attn_body<true, 0>(PROJ + t0 * INW + cq, pb_ + ck, pb_ + cv, Y + t0 * DM + (isA ? YCOL_A : YCOL_B) + hh * 128, (long)INW * dil, (long)INW * dil, (long)DM * dil, isA ? 8 : 6, bd, alds);
            }
        PHASE_END
        PHASE_BEGIN(pb + 7)
            LOCAL_IDS
            if (l + 1 < DEPTH && rep_ == 0) convert_layer(args.in, l + 1, (bf16_t*)(ws + WS_W + (size_t)((l + 1) & 1) * W_SLOT), ldsl, gw, NGW, lane, wave);
            const int RPT = (M % (4 * NGW) == 0) ? 4 : 1;
            if (RPT == 4) {
            for (int m0 = gw; m0 < M; m0 += 4 * NGW) {
                f32x4 l03[4]; f32x2 l45[4]; u32x2 v[4][3];
#pragma unroll
                for (int q = 0; q < 4; ++q) { const int m = m0 + q * NGW; const float* lp = lseb + (size_t)m * 8; l03[q] = *(const f32x4*)lp; l45[q] = *(const f32x2*)(lp + 4);
                    const GAS u32x2* yp = (const GAS u32x2*)(Y + (size_t)m * DM + YCOL_B);
#pragma unroll
                    for (int k = 0; k < 3; ++k) v[q][k] = yp[lane + 64 * k]; }
#pragma unroll
                for (int q = 0; q < 4; ++q) { const int m = m0 + q * NGW;
                    const int j = lane >> 5;
                    const float a = j ? l03[q].y : l03[q].x, b = j ? l03[q].w : l03[q].z, c = j ? l45[q].y : l45[q].x, mx = fmaxf(a, fmaxf(b, c));
                    const float ea = __expf(a - mx), eb = __expf(b - mx), ec = __expf(c - mx), inv = 1.0f / (ea + eb + ec);
                    const float w0 = ea * inv, w1 = eb * inv, w2 = ec * inv;
                    GAS u32x2* yp = (GAS u32x2*)(Y + (size_t)m * DM + YCOL_B);
#pragma unroll
                    for (int k = 0; k < 3; ++k) {
                        float sc = k == 0 ? w0 : (k == 1 ? w1 : w2); if (REP_MASK && rep_ != ((REP_MASK >> 7) & 1)) sc = 1.0f;
                        const u32x2 x = v[q][k]; yp[lane + 64 * k] = (u32x2){cvt_pk_bf16(bf_lo(x.x) * sc, bf_hi(x.x) * sc), cvt_pk_bf16(bf_lo(x.y) * sc, bf_hi(x.y) * sc)}; } }
            }
            } else {
            for (int m = gw; m < M; m += NGW) {
                const float* lp = lseb + (size_t)m * 8;
                const f32x4 l03 = *(const f32x4*)lp; const f32x2 l45 = *(const f32x2*)(lp + 4);
                const int j = lane >> 5;
                const float a = j ? l03.y : l03.x, b = j ? l03.w : l03.z, c = j ? l45.y : l45.x, mx = fmaxf(a, fmaxf(b, c));
                const float ea = __expf(a - mx), eb = __expf(b - mx), ec = __expf(c - mx), inv = 1.0f / (ea + eb + ec);
                const float w0 = ea * inv, w1 = eb * inv, w2 = ec * inv;
                GAS u32x2* yp = (GAS u32x2*)(Y + (size_t)m * DM + YCOL_B);
#pragma unroll
                for (int k = 0; k < 3; ++k) { const int uu = lane + 64 * k;
                    float sc = k == 0 ? w0 : (k == 1 ? w1 : w2); if (REP_MASK && rep_ != ((REP_MASK >> 7) & 1)) sc = 1.0f;
                    const u32x2 x = yp[uu]; yp[uu] = (u32x2){cvt_pk_bf16(bf_lo(x.x) * sc, bf_hi(x.x) * sc), cvt_pk_bf16(bf_lo(x.y) * sc, bf_hi(x.y) * sc)}; }
            }
            }
        PHASE_END
        PHASE_BEGIN(pb + 8)
            pg8::ChainSched S; S.so.init(M, DM, G, bx, 4);
            pg8::EpiBranch E{GATES, MERGED};
            pg8::gemm_phase<pg8::EpiBranch, pg8::ChainSched>(ldsl + RING_OFF, Y, (const bf16_t*)((char*)Wb + WO_BR), DM, S, E);
        PHASE_END
        PHASE_BEGIN(pb + 9)
            pg8::PlainSched S; S.so.init(M, DM, G, bx, 4); S.nt = DM / 64;
            pg8::EpiStream E{HI, LO, ssb + (size_t)(3 * l + 2) * M * 8, rep_ == ((REP_MASK >> 9) & 1) ? 1.0f : 0.f, (LAS float*)(ldsl + HTAB_OFF)};
            pg8::gemm_phase<pg8::EpiStream, pg8::PlainSched>(ldsl + RING_OFF, MERGED, (const bf16_t*)((char*)Wb + WO_WO), DM, S, E);
        PHASE_END
        }
    }
    PHASE_BEGIN(PH_FINAL)
        LOCAL_IDS
        const float* g = args.in[17]; const float* ssf = ssb + (size_t)(NSS - 1) * M * 8;
        f32x4 gv[8];
#pragma unroll
        for (int j = 0; j < 8; ++j) gv[j] = ((const f32x4*)g)[lane + 64 * j];
        for (int m = gw; m < M; m += NGW) {
            const float rstd = 1.0f / sqrtf(row_ssq(ssf, m) * (1.0f / DM) + NORM_EPS);
            const GAS u32x2* ph = (const GAS u32x2*)(HI + (size_t)m * DM) + lane; const GAS u32x2* pl = (const GAS u32x2*)(LO + (size_t)m * DM) + lane;
            GAS f32x4* xr = (GAS f32x4*)(out + (size_t)m * DM) + lane;
#pragma unroll
            for (int j = 0; j < 8; ++j) { const u32x2 h = ph[64 * j], w = STREAM_LO ? pl[64 * j] : (u32x2){0u, 0u};
                const f32x4 x = (f32x4){bf_lo(h.x) + bf_lo(w.x), bf_hi(h.x) + bf_hi(w.x), bf_lo(h.y) + bf_lo(w.y), bf_hi(h.y) + bf_hi(w.y)};
                xr[64 * j] = x * rstd * gv[j]; }
        }
    PHASE_END
#undef PHASE_BEGIN
#undef PHASE_END
}

#ifndef N_LAUNCH_MODE
#define N_LAUNCH_MODE 1
#endif
extern "C" void kernel_launch(void* const* d_in, const int* in_sizes, int n_in, void* d_out, int out_size, void* d_ws, size_t ws_size, hipStream_t stream) {
    static int grid = 0;
    if (grid == 0) {
        if (n_in != 18 || out_size != M * DM || ws_size < WS_END) { fprintf(stderr, "kernel_launch: unexpected shapes: n_in %d out %d ws %zu (need %zu)\n", n_in, out_size, ws_size, (size_t)WS_END); grid = -1; return; }
        int dev = 0, cus = 0, per_cu = 0;
        if (hipGetDevice(&dev) != hipSuccess || hipDeviceGetAttribute(&cus, hipDeviceAttributeMultiprocessorCount, dev) != hipSuccess) { grid = -1; return; }
        if (hipFuncSetAttribute((const void*)fwd_kernel, hipFuncAttributeMaxDynamicSharedMemorySize, LDS_BYTES) != hipSuccess) { fprintf(stderr, "kernel_launch: hipFuncSetAttribute failed\n"); grid = -1; return; }
        if (hipOccupancyMaxActiveBlocksPerMultiprocessor(&per_cu, (const void*)fwd_kernel, NWAVES * 64, LDS_BYTES) != hipSuccess || per_cu < 1)
            fprintf(stderr, "kernel_launch: note: occupancy query reports %d workgroups per CU\n", per_cu);
        (void)hipGetLastError();
        grid = cus < 256 ? cus : 256;
    }
    if (grid < 0) return;
    if (hipMemsetAsync((char*)d_ws + WS_CTL, 0, CTL_ZERO_BYTES, stream) != hipSuccess) return;
    Args a{};
    for (int i = 0; i < 18; ++i) a.in[i] = (const float*)d_in[i];
    a.out = (float*)d_out; a.ws = (unsigned char*)d_ws;
#if N_LAUNCH_MODE == 1
    a.ph_lo = 0; a.ph_hi = PH_END;
    hipLaunchKernelGGL(fwd_kernel, dim3(grid), dim3(NWAVES * 64), LDS_BYTES, stream, a);
#ifdef RUN_TWICE
    (void)hipMemsetAsync((char*)d_ws + WS_CTL, 0, CTL_ZERO_BYTES, stream);
    hipLaunchKernelGGL(fwd_kernel, dim3(grid), dim3(NWAVES * 64), LDS_BYTES, stream, a);
#endif
#else
    for (int s = 0; s < NSTEP; ++s)
        for (int p = 0; p < PH_PER_STEP; ++p) { if (p == 3 || p == 5 || (p == 0 && s != 0) || ((s & 1) && p >= 3)) continue; a.ph_lo = s * PH_PER_STEP + p; a.ph_hi = a.ph_lo + 1;
            hipLaunchKernelGGL(fwd_kernel, dim3(grid), dim3(NWAVES * 64), LDS_BYTES, stream, a); }
    a.ph_lo = PH_FINAL; a.ph_hi = PH_END;
    hipLaunchKernelGGL(fwd_kernel, dim3(grid), dim3(NWAVES * 64), LDS_BYTES, stream, a);
#endif
    const hipError_t le = hipPeekAtLastError();
    if (le != hipSuccess) fprintf(stderr, "kernel_launch: launch failed: %s\n", hipGetErrorName(le));
}
```

```cpp
#include <hip/hip_runtime.h>
#include <cstdio>
#include <cstdint>
#define PROBE_MODE 3
#define STREAM_LO 0
#define FUSE_PREP 1
#ifndef REP_MASK
#define REP_MASK 0
#endif

#define LAS __attribute__((address_space(3)))
#define GAS __attribute__((address_space(1)))
typedef unsigned short bf16_t;
typedef short bf16x8 __attribute__((ext_vector_type(8)));
typedef short s16x4 __attribute__((ext_vector_type(4)));
typedef float f32x2 __attribute__((ext_vector_type(2)));
typedef float f32x4 __attribute__((ext_vector_type(4)));
typedef float f32x16 __attribute__((ext_vector_type(16)));
typedef unsigned u32x2 __attribute__((ext_vector_type(2)));
typedef unsigned u32x4 __attribute__((ext_vector_type(4)));

constexpr int DM = 2048, DFF = 5632, DEPTH = 4, NSTEP = 2 * DEPTH;
constexpr int S_P = 16384, S_S = 8192;
constexpr int M = 49152;
constexpr int INW = 4608, GATEW = 6144, PGW = INW + GATEW, NFF2 = 2 * DFF;
constexpr int COL_QA = 0, COL_KA = 512, COL_VA = 768, COL_QB = 1024, COL_KB = 1792, COL_VB = 2560, COL_QC = 3328, COL_KC = 4096, COL_VC = 4352;
constexpr int YCOL_A = 0, YCOL_B = 512, YCOL_C = 1280;
constexpr float NORM_EPS = 1e-6f;

typedef __bf16 bf16x2_t __attribute__((ext_vector_type(2)));
__device__ __forceinline__ unsigned cvt_pk_bf16(float lo, float hi) { const f32x2 v = {lo, hi}; const bf16x2_t b = __builtin_convertvector(v, bf16x2_t); return __builtin_bit_cast(unsigned, b); }
__device__ __forceinline__ float bf_lo(unsigned w) { return __uint_as_float(w << 16); }
__device__ __forceinline__ float bf_hi(unsigned w) { return __uint_as_float(w & 0xffff0000u); }
__device__ __forceinline__ unsigned f2bf(float f) { unsigned u = __float_as_uint(f); return (u + 0x7fffu + ((u >> 16) & 1u)) >> 16; }
__device__ __forceinline__ unsigned pk2(float lo, float hi) { return f2bf(lo) | (f2bf(hi) << 16); }

__device__ __forceinline__ float row_ssq(const float* ssp, int row) { const f32x4* p = (const f32x4*)(ssp + (size_t)row * 8); const f32x4 a = p[0], b = p[1]; return ((a[0] + a[1]) + (a[2] + a[3])) + ((b[0] + b[1]) + (b[2] + b[3])); }
__device__ __forceinline__ void panel_rstd(const float* ssp, LAS float* rt, int& cpm, int pm, int tid) {
    if (pm != cpm) {
        if (tid < 256) rt[tid] = __builtin_amdgcn_rsqf(row_ssq(ssp, pm * 256 + tid) * (1.0f / DM) + NORM_EPS);
        asm volatile("s_waitcnt lgkmcnt(0)" ::: "memory"); __builtin_amdgcn_s_barrier(); asm volatile("" ::: "memory");
        cpm = pm; }
}
namespace pg8 {
constexpr int BM = 256, BK = 64, HALF = 128, HTB = HALF * BK * 2, STAGE_BYTES = 8 * HTB, NXCD = 8;
__host__ __device__ __forceinline__ int lds_byte(int r, int c) { const int st = (r >> 4) * 2 + (c >> 5), rr = r & 15, cc = c & 31, ob = rr * 64 + cc * 2; return st * 1024 + (ob ^ (((ob >> 9) & 1) << 5)); }
__host__ __device__ __forceinline__ void stage_rc(int b, int& R, int& C) { const int st = b / 1024, sb = b % 1024, swz = sb ^ (((sb >> 9) & 1) << 5); R = (st >> 1) * 16 + swz / 64; C = (st & 1) * 32 + (swz % 64) / 2; }
__host__ __device__ __forceinline__ int perm32(int rho) { const int n = rho >> 4, i = rho & 15; return 8 * (i >> 2) + 4 * n + (i & 3); }

struct Unit { int pm, pn, k0, nt, seg; };
struct StaticOrder {
    int nM, nN, nwg, G, c, WGM;
    __device__ void init(int M_, int N_, int G_, int c_, int wgm) { nM = M_ / BM; nN = N_ / BM; nwg = nM * nN; G = G_; c = c_; WGM = wgm; }
    __device__ bool next(int i, int& pm, int& pn) const {
        const long L = (long)i * G + c; if (L >= nwg) return false;
        int wgid = (int)L; { const int q = nwg / NXCD, r = nwg % NXCD, xcd = wgid % NXCD, off = wgid / NXCD; wgid = (xcd < r ? xcd * (q + 1) : r * (q + 1) + (xcd - r) * q) + off; }
        const int nig = WGM * nN, gid = wgid / nig, fm = gid * WGM, gsz = (nM - fm) < WGM ? (nM - fm) : WGM;
        pm = fm + ((wgid % nig) % gsz); pn = (wgid % nig) / gsz; return true;
    }
};
struct PlainSched { StaticOrder so; int nt;
    __device__ __forceinline__ bool next(int i, Unit& u) const { u.k0 = 0; u.nt = nt; u.seg = 0; return so.next(i, u.pm, u.pn); } };
struct ChainSched { StaticOrder so;
    __device__ __forceinline__ bool next(int i, Unit& u) const { const int t = i / 3, sg = i - 3 * t; u.seg = sg; u.k0 = sg == 0 ? 0 : (sg == 1 ? 512 : 1280); u.nt = sg == 0 ? 8 : 12; return so.next(t, u.pm, u.pn); } };

typedef f32x4 Acc[2][2][4][2];

struct EpiSwiglu { static constexpr bool PERM = true, CHAIN = false; bf16_t* O; const float* ss; LAS float* rt; mutable int cpm;
    __device__ __forceinline__ void operator()(Acc& acc, const Unit& u, int wr, int wc, int fr, int fq) const {
        const int row0 = u.pm * BM + wr * 64 + fr, col0 = u.pn * HALF + wc * 32 + 8 * fq;
        panel_rstd(ss, rt, cpm, u.pm, (wr * 4 + wc) * 64 + fq * 16 + fr);
#pragma unroll
        for (int ai = 0; ai < 2; ++ai)
#pragma unroll
            for (int m = 0; m < 4; ++m) { bf16_t* rowp = O + (size_t)(row0 + ai * HALF + m * 16) * DFF + col0; float v[8];
                const float r = rt[wr * 64 + ai * HALF + m * 16 + fr];
                const float rml = r * -1.4426950408889634f, ir2 = __builtin_amdgcn_rcpf(r * r);
#pragma unroll
                for (int n = 0; n < 2; ++n)
#pragma unroll
                    for (int j = 0; j < 4; ++j) { const float g = acc[ai][0][m][n][j], up = acc[ai][1][m][n][j];
                        const float e = __builtin_amdgcn_exp2f(g * rml); v[4 * n + j] = (g * up) * __builtin_amdgcn_rcpf(fmaf(e, ir2, ir2)); }
                u32x4 w; w.x = cvt_pk_bf16(v[0], v[1]); w.y = cvt_pk_bf16(v[2], v[3]); w.z = cvt_pk_bf16(v[4], v[5]); w.w = cvt_pk_bf16(v[6], v[7]);
                *(u32x4*)rowp = w; }
    }
};
struct EpiStream { static constexpr bool PERM = true, CHAIN = false; bf16_t* hi; bf16_t* lo; float* ssq; float alpha; LAS float* tab;
    __device__ __forceinline__ void operator()(Acc& acc, const Unit& u, int wr, int wc, int fr, int fq) const {
        const unsigned loff = (unsigned)(fr * DM + 8 * fq);
        const size_t ub = (size_t)(u.pm * BM + wr * 64) * DM + u.pn * BM + wc * 32;
#pragma unroll
        for (int ai = 0; ai < 2; ++ai) {
            u32x4 H[4][2], L[4][2];
#pragma unroll
            for (int m = 0; m < 4; ++m)
#pragma unroll
                for (int bj = 0; bj < 2; ++bj) { const size_t uo = ub + (size_t)(ai * HALF + m * 16) * DM + bj * HALF;
                    H[m][bj] = *(const u32x4*)(hi + uo + loff); L[m][bj] = STREAM_LO ? *(const u32x4*)(lo + uo + loff) : (u32x4){0u, 0u, 0u, 0u}; }
#pragma unroll
            for (int m = 0; m < 4; ++m) { float sq = 0.f;
#pragma unroll
                for (int bj = 0; bj < 2; ++bj) { const size_t uo = ub + (size_t)(ai * HALF + m * 16) * DM + bj * HALF; const u32x4 h = H[m][bj], l = L[m][bj]; float x[8];
                    x[0] = bf_lo(h.x) + bf_lo(l.x); x[1] = bf_hi(h.x) + bf_hi(l.x); x[2] = bf_lo(h.y) + bf_lo(l.y); x[3] = bf_hi(h.y) + bf_hi(l.y);
                    x[4] = bf_lo(h.z) + bf_lo(l.z); x[5] = bf_hi(h.z) + bf_hi(l.z); x[6] = bf_lo(h.w) + bf_lo(l.w); x[7] = bf_hi(h.w) + bf_hi(l.w);
#pragma unroll
                    for (int j = 0; j < 4; ++j) { x[j] = fmaf(acc[ai][bj][m][0][j], alpha, x[j]); x[4 + j] = fmaf(acc[ai][bj][m][1][j], alpha, x[4 + j]); }
#pragma unroll
                    for (int j = 0; j < 8; ++j) sq = fmaf(x[j], x[j], sq);
                    u32x4 nh, nl; nh.x = cvt_pk_bf16(x[0], x[1]); nh.y = cvt_pk_bf16(x[2], x[3]); nh.z = cvt_pk_bf16(x[4], x[5]); nh.w = cvt_pk_bf16(x[6], x[7]);
                    nl.x = cvt_pk_bf16(x[0] - bf_lo(nh.x), x[1] - bf_hi(nh.x)); nl.y = cvt_pk_bf16(x[2] - bf_lo(nh.y), x[3] - bf_hi(nh.y));
                    nl.z = cvt_pk_bf16(x[4] - bf_lo(nh.z), x[5] - bf_hi(nh.z)); nl.w = cvt_pk_bf16(x[6] - bf_lo(nh.w), x[7] - bf_hi(nh.w));
                    *(u32x4*)(hi + uo + loff) = nh; if (STREAM_LO) *(u32x4*)(lo + uo + loff) = nl; }
                sq += __shfl_xor(sq, 16); sq += __shfl_xor(sq, 32);
                if (fq == 0) tab[(wr * 64 + ai * HALF + m * 16 + fr) * 4 + wc] = sq; }
            asm volatile("" ::: "memory"); }
        asm volatile("s_waitcnt lgkmcnt(0)" ::: "memory"); __builtin_amdgcn_s_barrier(); asm volatile("" ::: "memory");
        const int t = (wr * 4 + wc) * 64 + fq * 16 + fr;
        if (t < BM) { const f32x4 p = *(const LAS f32x4*)(tab + t * 4); ssq[(size_t)(u.pm * BM + t) * 8 + u.pn] = (p[0] + p[1]) + (p[2] + p[3]); }
    }
};
struct EpiProjGate { static constexpr bool PERM = true, CHAIN = false; bf16_t* proj; bf16_t* gates; const float* bias; const float* ss; const f32x2* rope; const f32x2* ropex; const float* gq; const float* gk; LAS float* tab; LAS float* rt; mutable int cpm;
    __device__ __forceinline__ void store8(bf16_t* p, const float (&v)[8]) const { u32x4 w; w.x = cvt_pk_bf16(v[0], v[1]); w.y = cvt_pk_bf16(v[2], v[3]); w.z = cvt_pk_bf16(v[4], v[5]); w.w = cvt_pk_bf16(v[6], v[7]); *(u32x4*)p = w; }
    __device__ __forceinline__ void operator()(Acc& acc, const Unit& u, int wr, int wc, int fr, int fq) const {
        const int pn = u.pn, rb = u.pm * BM + wr * 64;
        panel_rstd(ss, rt, cpm, u.pm, (wr * 4 + wc) * 64 + fq * 16 + fr);
        if (pn < INW / BM) {
#pragma unroll
        for (int ai = 0; ai < 2; ++ai)
#pragma unroll
            for (int m = 0; m < 4; ++m) { const float r = rt[wr * 64 + ai * HALF + m * 16 + fr];
#pragma unroll
                for (int bj = 0; bj < 2; ++bj) { acc[ai][bj][m][0] *= r; acc[ai][bj][m][1] *= r; } }
        }
        if (pn >= INW / BM) {
            const float* bp = bias + (pn - INW / BM) * BM + wc * 32 + 8 * fq;
            f32x4 bv[2][2];
#pragma unroll
            for (int bj = 0; bj < 2; ++bj)
#pragma unroll
                for (int n = 0; n < 2; ++n) bv[bj][n] = *(const f32x4*)(bp + bj * HALF + 4 * n) * -1.4426950408889634f;
            unsigned char* tb = (unsigned char*)gates + ((size_t)u.pm * (GATEW / BM) + (pn - INW / BM)) * (BM * BM) + (wr * 64) * BM + wc * 64;
            const unsigned lo8 = (unsigned)(fr * BM + fq * 16);
#pragma unroll
            for (int ai = 0; ai < 2; ++ai)
#pragma unroll
                for (int m = 0; m < 4; ++m) { u32x4 w; const float rc = rt[wr * 64 + ai * HALF + m * 16 + fr] * -1.4426950408889634f;
#pragma unroll
                    for (int bj = 0; bj < 2; ++bj) { unsigned q[8];
#pragma unroll
                        for (int j = 0; j < 4; ++j) { q[j] = __float_as_uint(fmaf(__builtin_amdgcn_rcpf(1.0f + __builtin_amdgcn_exp2f(fmaf(acc[ai][bj][m][0][j], rc, bv[bj][0][j]))), 255.0f, 8388608.0f));
                                                      q[4 + j] = __float_as_uint(fmaf(__builtin_amdgcn_rcpf(1.0f + __builtin_amdgcn_exp2f(fmaf(acc[ai][bj][m][1][j], rc, bv[bj][1][j]))), 255.0f, 8388608.0f)); }
                        w[2 * bj] = __builtin_amdgcn_perm(q[1], q[0], 0x0c0c0400u) | (__builtin_amdgcn_perm(q[3], q[2], 0x0c0c0400u) << 16);
                        w[2 * bj + 1] = __builtin_amdgcn_perm(q[5], q[4], 0x0c0c0400u) | (__builtin_amdgcn_perm(q[7], q[6], 0x0c0c0400u) << 16); }
                    *(u32x4*)(tb + (ai * HALF + m * 16) * BM + lo8) = w; }
            return;
        }
        bf16_t* pb = proj + (size_t)rb * INW + pn * BM + wc * 32;
        const unsigned lop = (unsigned)(fr * INW + 8 * fq);
        const int posb = (rb < S_P ? rb : (rb & (S_S - 1)));
        const bool plain = (pn == 3) || (pn >= 10 && pn <= 12) || (pn == 17), axial = (pn >= 13 && pn <= 16);
        if (plain) {
#pragma unroll
            for (int ai = 0; ai < 2; ++ai)
#pragma unroll
                for (int m = 0; m < 4; ++m) { bf16_t* rowp = pb + (size_t)(ai * HALF + m * 16) * INW + lop;
#pragma unroll
                    for (int bj = 0; bj < 2; ++bj) { float v[8];
#pragma unroll
                        for (int j = 0; j < 4; ++j) { v[j] = acc[ai][bj][m][0][j]; v[4 + j] = acc[ai][bj][m][1][j]; }
                        store8(rowp + bj * HALF, v); } }
        } else if (!axial) {
            const f32x2* rp = rope + (size_t)posb * 64 + 16 * wc; const unsigned lor = (unsigned)(fr * 64 + 4 * fq);
#pragma unroll
            for (int ai = 0; ai < 2; ++ai) {
                f32x4 c01[4], c23[4];
#pragma unroll
                for (int m = 0; m < 4; ++m) { const f32x4* cp = (const f32x4*)(rp + (ai * HALF + m * 16) * 64 + lor); c01[m] = cp[0]; c23[m] = cp[1]; }
#pragma unroll
                for (int m = 0; m < 4; ++m) { const float cs[4] = {c01[m][0], c01[m][2], c23[m][0], c23[m][2]}, sn[4] = {c01[m][1], c01[m][3], c23[m][1], c23[m][3]};
                    bf16_t* rowp = pb + (size_t)(ai * HALF + m * 16) * INW + lop;
#pragma unroll
                    for (int bj = 0; bj < 2; ++bj) { float v[8];
#pragma unroll
                        for (int k = 0; k < 4; ++k) { const float x1 = acc[ai][bj][m][k >> 1][(2 * k) & 3], x2 = acc[ai][bj][m][k >> 1][((2 * k) & 3) + 1];
                            v[2 * k] = x1 * cs[k] - x2 * sn[k]; v[2 * k + 1] = x2 * cs[k] + x1 * sn[k]; }
                        store8(rowp + bj * HALF, v); } }
                asm volatile("" ::: "memory"); }
        } else {
            const float* g = (pn == 16 ? gk : gq) + 64 * (wc >> 1) + 16 * (wc & 1) + 4 * fq;
            const float qs = pn == 16 ? 1.0f : 0.088388347648318440f * 1.4426950408889634f;
            const f32x4 gA = *(const f32x4*)g * qs, gB = *(const f32x4*)(g + 32) * qs;
            const int rl0 = wr * 64 + fr;
#pragma unroll
            for (int ai = 0; ai < 2; ++ai)
#pragma unroll
                for (int m = 0; m < 4; ++m)
#pragma unroll
                    for (int bj = 0; bj < 2; ++bj) { float sq = 0.f;
#pragma unroll
                        for (int j = 0; j < 4; ++j) { sq = fmaf(acc[ai][bj][m][0][j], acc[ai][bj][m][0][j], sq); sq = fmaf(acc[ai][bj][m][1][j], acc[ai][bj][m][1][j], sq); }
                        sq += __shfl_xor(sq, 16); sq += __shfl_xor(sq, 32);
                        if (fq == 0) tab[((rl0 + ai * HALF + m * 16) * 2 + bj) * 4 + wc] = sq; }
            asm volatile("s_waitcnt lgkmcnt(0)" ::: "memory"); __builtin_amdgcn_s_barrier(); asm volatile("" ::: "memory");
#pragma unroll
            for (int ai = 0; ai < 2; ++ai)
#pragma unroll
                for (int m = 0; m < 4; ++m) { const int rl = rl0 + ai * HALF + m * 16, pos = posb + ai * HALF + m * 16 + fr;
                    const int id = (wc >> 1) ? (pos & 63) : (pos >> 6);
                    const f32x4* cp = (const f32x4*)(ropex + (size_t)id * 32 + 16 * (wc & 1) + 4 * fq); const f32x4 c01 = cp[0], c23 = cp[1];
                    const float cs[4] = {c01[0], c01[2], c23[0], c23[2]}, sn[4] = {c01[1], c01[3], c23[1], c23[3]};
                    bf16_t* rowp = pb + (size_t)(ai * HALF + m * 16) * INW + lop;
#pragma unroll
                    for (int bj = 0; bj < 2; ++bj) { const f32x4 t = *(const LAS f32x4*)(tab + (rl * 2 + bj) * 4);
                        const float rh = __builtin_amdgcn_rsqf(((t[0] + t[1]) + (t[2] + t[3])) * (1.0f / 128.0f) + NORM_EPS); float v[8];
#pragma unroll
                        for (int k = 0; k < 4; ++k) { const float x1 = acc[ai][bj][m][k >> 1][(2 * k) & 3] * rh * gA[k], x2 = acc[ai][bj][m][k >> 1][((2 * k) & 3) + 1] * rh * gB[k];
                            v[2 * k] = x1 * cs[k] - x2 * sn[k]; v[2 * k + 1] = x2 * cs[k] + x1 * sn[k]; }
                        store8(rowp + bj * HALF, v); } }
        }
    }
};
struct EpiBranch { static constexpr bool PERM = true, CHAIN = true; const bf16_t* gates; bf16_t* O;
    __device__ __forceinline__ void operator()(Acc& acc, const Unit& u, int wr, int wc, int fr, int fq) const {
        const int rl0 = wr * 64 + fr, row0 = u.pm * BM + rl0, col0 = u.pn * BM + wc * 32 + 8 * fq; const int seg = u.seg;
        const unsigned char* tn = (const unsigned char*)gates + ((size_t)u.pm * (GATEW / BM) + seg * (DM / BM) + u.pn) * (BM * BM) + (wc * 4 + fq) * 16;
        const unsigned char* td = tn + (size_t)(DM / BM) * (BM * BM);
#pragma unroll
        for (int ai = 0; ai < 2; ++ai) {
            u32x4 gn[4], gd[4];
#pragma unroll
            for (int m = 0; m < 4; ++m) { const size_t ro = (size_t)(rl0 + ai * HALF + m * 16) * BM;
                gn[m] = *(const u32x4*)(tn + ro); if (seg != 2) gd[m] = *(const u32x4*)(td + ro); else gd[m] = (u32x4){0u, 0u, 0u, 0u}; }
#pragma unroll
            for (int m = 0; m < 4; ++m) { const size_t row = (size_t)(row0 + ai * HALF + m * 16);
#pragma unroll
                for (int bj = 0; bj < 2; ++bj) { float s[8];
#pragma unroll
                    for (int j = 0; j < 8; ++j) s[j] = fmaxf((float)((gn[m][2 * bj + (j >> 2)] >> (8 * (j & 3))) & 0xffu), 0.5f);
                    if (seg != 2) {
#pragma unroll
                        for (int j = 0; j < 8; ++j) s[j] = s[j] * __builtin_amdgcn_rcpf(fmaxf((float)((gd[m][2 * bj + (j >> 2)] >> (8 * (j & 3))) & 0xffu), 0.5f));
                    } else {
#pragma unroll
                        for (int j = 0; j < 8; ++j) s[j] *= (1.0f / 255.0f);
                    }
#pragma unroll
                    for (int j = 0; j < 4; ++j) { acc[ai][bj][m][0][j] *= s[j]; acc[ai][bj][m][1][j] *= s[4 + j]; }
                    if (seg == 2) { const f32x4 v0 = acc[ai][bj][m][0], v1 = acc[ai][bj][m][1];
                        u32x4 w; w.x = cvt_pk_bf16(v0[0], v0[1]); w.y = cvt_pk_bf16(v0[2], v0[3]); w.z = cvt_pk_bf16(v1[0], v1[1]); w.w = cvt_pk_bf16(v1[2], v1[3]);
                        *(u32x4*)(O + row * DM + col0 + bj * HALF) = w; } } }
            asm volatile("" ::: "memory"); }
    }
};

template <class Epi, class Sched>
__device__ __forceinline__ void gemm_phase(LAS unsigned char* lds, const bf16_t* Ag, const bf16_t* Btg, const int Kp, const Sched& S, const Epi& E) {
    int tid = threadIdx.x; asm volatile("" : "+v"(tid));
    const int wid = __builtin_amdgcn_readfirstlane(tid >> 6), lane = tid & 63, wr = wid >> 2, wc = wid & 3, fr = lane & 15, fq = lane >> 4;
    unsigned voffA[2], voffB[2];
#pragma unroll
    for (int i = 0; i < 2; ++i) { int R, C; stage_rc(tid * 16 + i * 8192, R, C); const int Rb = Epi::PERM ? ((R & ~31) + perm32(R & 31)) : R;
        voffA[i] = (unsigned)(R * Kp + C) * 2u; voffB[i] = (unsigned)(Rb * Kp + C) * 2u; }
    const size_t kstep = (size_t)(BK * 2);
    const size_t hstep = (size_t)HALF * Kp * 2;
    const size_t tstep = 2 * hstep;
    const unsigned ldsw = (unsigned)wid * 1024u;
    const int aoff = lds_byte(wr * 64 + fr, fq * 8), boff = lds_byte(wc * 32 + fr, fq * 8);
#define PG8_SA(b, h) (((b) * 2 + (h)) * HTB)
#define PG8_SB(b, h) ((4 + (b) * 2 + (h)) * HTB)
#define PG8_STAGE(bufoff, gbase, voff) do { _Pragma("unroll") for (int _i = 0; _i < 2; ++_i) \
        __builtin_amdgcn_global_load_lds((const unsigned*)((const char*)(gbase) + (voff)[_i]), (LAS unsigned*)(lds + (bufoff) + ldsw + _i * 8192), 16, 0, 0); } while (0)
#define PG8_LDA(dst, b, h) do { _Pragma("unroll") for (int m = 0; m < 4; ++m) _Pragma("unroll") for (int k = 0; k < 2; ++k) dst[m][k] = *(const LAS bf16x8*)(lds + PG8_SA(b, h) + aoff + m * 2048 + k * 1024); } while (0)
#define PG8_LDB(dst, b, h) do { _Pragma("unroll") for (int n = 0; n < 2; ++n) _Pragma("unroll") for (int k = 0; k < 2; ++k) dst[n][k] = *(const LAS bf16x8*)(lds + PG8_SB(b, h) + boff + n * 2048 + k * 1024); } while (0)
#define PG8_MMA(ai, bj, At, Bt) do { __builtin_amdgcn_s_setprio(1); _Pragma("unroll") for (int m = 0; m < 4; ++m) _Pragma("unroll") for (int n = 0; n < 2; ++n) _Pragma("unroll") for (int k = 0; k < 2; ++k) \
        acc[ai][bj][m][n] = __builtin_amdgcn_mfma_f32_16x16x32_bf16(Bt[n][k], At[m][k], acc[ai][bj][m][n], 0, 0, 0); __builtin_amdgcn_s_setprio(0); } while (0)
#define PG8_WAIT_V(n) asm volatile("s_waitcnt vmcnt(" #n ")" ::: "memory")
#define PG8_WAIT_L(n) asm volatile("s_waitcnt lgkmcnt(" #n ")" ::: "memory")
#define PG8_BAR __builtin_amdgcn_s_barrier()
#define PG8_SCHED __builtin_amdgcn_sched_barrier(0)
    Unit cur, nxt; int ui = 0;
    if (!S.next(0, cur)) return;
    Acc acc;
#pragma unroll
    for (int a = 0; a < 2; ++a)
#pragma unroll
        for (int b = 0; b < 2; ++b)
#pragma unroll
            for (int m = 0; m < 4; ++m)
#pragma unroll
                for (int n = 0; n < 2; ++n) acc[a][b][m][n] = (f32x4){0.f, 0.f, 0.f, 0.f};
    bf16x8 At[4][2], B0[2][2], B1[2][2];
    const char* cA = (const char*)Ag + (size_t)cur.pm * tstep + (size_t)cur.k0 * 2; const char* cB = (const char*)Btg + (size_t)cur.pn * tstep + (size_t)cur.k0 * 2;
    PG8_STAGE(PG8_SB(0, 0), cB, voffB); PG8_STAGE(PG8_SB(0, 1), cB + hstep, voffB); PG8_STAGE(PG8_SA(0, 0), cA, voffA); PG8_STAGE(PG8_SA(0, 1), cA + hstep, voffA);
    if (wr == 1) PG8_BAR;
    PG8_WAIT_V(2); PG8_BAR;
    PG8_STAGE(PG8_SB(1, 0), cB + kstep, voffB); PG8_STAGE(PG8_SA(1, 0), cA + kstep, voffA); PG8_STAGE(PG8_SB(1, 1), cB + hstep + kstep, voffB);
    PG8_WAIT_V(6); PG8_BAR;
    for (;;) {
        const bool has_next = S.next(ui + 1, nxt);
        const char* nA = has_next ? (const char*)Ag + (size_t)nxt.pm * tstep + (size_t)nxt.k0 * 2 : cA; const char* nB = has_next ? (const char*)Btg + (size_t)nxt.pn * tstep + (size_t)nxt.k0 * 2 : cB;
        const int nt = cur.nt;
        for (int t = 0; t < nt; t += 2) {
            const bool last = (t == nt - 2);
            const char* a1 = cA + (size_t)(t + 1) * kstep;
            const char* a2 = last ? nA : cA + (size_t)(t + 2) * kstep; const char* b2 = last ? nB : cB + (size_t)(t + 2) * kstep;
            const char* a3 = a2 + kstep; const char* b3 = b2 + kstep;
            PG8_LDB(B0, 0, 0); PG8_LDB(B1, 0, 1); PG8_SCHED; PG8_LDA(At, 0, 0); PG8_STAGE(PG8_SA(1, 1), a1 + hstep, voffA);
            PG8_WAIT_V(8); PG8_WAIT_L(0); PG8_BAR; PG8_MMA(0, 0, At, B0); PG8_MMA(0, 1, At, B1); PG8_BAR; PG8_SCHED;
            PG8_LDA(At, 0, 1); PG8_STAGE(PG8_SB(0, 0), b2, voffB); PG8_STAGE(PG8_SB(0, 1), b2 + hstep, voffB); PG8_STAGE(PG8_SA(0, 0), a2, voffA);
            PG8_WAIT_V(8); PG8_WAIT_L(0); PG8_BAR; PG8_MMA(1, 0, At, B0); PG8_MMA(1, 1, At, B1); PG8_BAR; PG8_SCHED;
            PG8_LDB(B0, 1, 0); PG8_LDB(B1, 1, 1); PG8_SCHED; PG8_LDA(At, 1, 0); PG8_STAGE(PG8_SA(0, 1), a2 + hstep, voffA);
            PG8_WAIT_V(8); PG8_WAIT_L(0); PG8_BAR; PG8_MMA(0, 0, At, B0); PG8_MMA(0, 1, At, B1); PG8_BAR; PG8_SCHED;
            PG8_LDA(At, 1, 1); PG8_STAGE(PG8_SB(1, 0), b3, voffB); PG8_STAGE(PG8_SB(1, 1), b3 + hstep, voffB); PG8_STAGE(PG8_SA(1, 0), a3, voffA);
            PG8_WAIT_V(8); PG8_WAIT_L(0); PG8_BAR; PG8_MMA(1, 0, At, B0); PG8_MMA(1, 1, At, B1); PG8_BAR; PG8_SCHED;
        }
        if (wr == 0) PG8_BAR;
        E(acc, cur, wr, wc, fr, fq);
        if (!has_next) break;
        if (!Epi::CHAIN || cur.seg == 2) {
#pragma unroll
            for (int a = 0; a < 2; ++a)
#pragma unroll
                for (int b = 0; b < 2; ++b)
#pragma unroll
                    for (int m = 0; m < 4; ++m)
#pragma unroll
                        for (int n = 0; n < 2; ++n) acc[a][b][m][n] = (f32x4){0.f, 0.f, 0.f, 0.f};
        }
        cur = nxt; cA = nA; cB = nB; ++ui;
        if (wr == 1) PG8_BAR;
    }
    PG8_WAIT_V(0);
    PG8_BAR;
#undef PG8_SA
#undef PG8_SB
#undef PG8_STAGE
#undef PG8_LDA
#undef PG8_LDB
#undef PG8_MMA
#undef PG8_WAIT_V
#undef PG8_WAIT_L
#undef PG8_BAR
#undef PG8_SCHED
}
}

namespace att {
constexpr int D = 128, NW = 8, QBLK = 32, KVBLK = 64;
constexpr float SCALE = 0.088388347648318440f;
constexpr float THR = 8.f;
constexpr size_t SHM_V = KVBLK * D * 2, SHM_K = KVBLK * D * 2, SHM_ATTN = 2 * SHM_V + 2 * SHM_K + NW * 64 * 4;
#define KSWZ(row, colB) ((row) * 256 + ((colB) ^ (((row) & 15) << 4)))
#define SBAR() __builtin_amdgcn_sched_barrier(0)
__device__ __forceinline__ int crow(int r, int hi) { return (r & 3) + 8 * (r >> 2) + 4 * hi; }
__device__ __forceinline__ unsigned cvtpk(float lo, float hi) { return cvt_pk_bf16(lo, hi); }

template <int MODE>
__device__ __forceinline__ void partialSM(f32x16& p0, f32x16& p1, float& m_reg, float& mn, float& alpha) {
  if (MODE == 2) { mn = 0.f; alpha = 1.f;
#pragma unroll
    for (int r = 0; r < 16; ++r) p0[r] = __builtin_amdgcn_exp2f(p0[r]);
    return; }
  constexpr float C = MODE == 0 ? SCALE * 1.4426950408889634f : 1.0f, TH = MODE == 0 ? THR / SCALE : THR * 1.4426950408889634f;
  float pmax = p0[0];
#pragma unroll
  for (int r = 1; r < 16; ++r) pmax = fmaxf(pmax, p0[r]);
#pragma unroll
  for (int r = 0; r < 16; ++r) pmax = fmaxf(pmax, p1[r]);
  { auto rr = __builtin_amdgcn_permlane32_swap(__float_as_uint(pmax), __float_as_uint(pmax), false, false);
    pmax = fmaxf(__uint_as_float(rr[0]), __uint_as_float(rr[1])); }
  if (__builtin_expect(__all(pmax - m_reg <= TH), 1)) { mn = m_reg; alpha = 1.f; }
  else { mn = fmaxf(m_reg, pmax); alpha = __builtin_amdgcn_exp2f((m_reg - mn) * C); m_reg = mn; }
  float mnC = -mn * C;
#pragma unroll
  for (int r = 0; r < 16; ++r) p0[r] = fmaf(p0[r], C, mnC);
#pragma unroll
  for (int r = 0; r < 16; ++r) p1[r] = fmaf(p1[r], C, mnC);
#pragma unroll
  for (int r = 0; r < 16; ++r) p0[r] = __builtin_amdgcn_exp2f(p0[r]);
}
__device__ __forceinline__ void finishSM(f32x16& p0, f32x16& p1, float alpha, float& l_reg, bf16x8& pa0, bf16x8& pa1, bf16x8& pa2, bf16x8& pa3) {
#pragma unroll
  for (int r = 0; r < 16; ++r) p1[r] = __builtin_amdgcn_exp2f(p1[r]);
  float ps = 0;
#pragma unroll
  for (int r = 0; r < 16; ++r) ps += p0[r];
#pragma unroll
  for (int r = 0; r < 16; ++r) ps += p1[r];
  { auto rr = __builtin_amdgcn_permlane32_swap(__float_as_uint(ps), __float_as_uint(ps), false, false);
    ps = __uint_as_float(rr[0]) + __uint_as_float(rr[1]); }
  l_reg = l_reg * alpha + ps;
#define PK4(P, BASE, OUT) do { unsigned a0 = cvtpk(P[BASE + 0], P[BASE + 1]), a1 = cvtpk(P[BASE + 2], P[BASE + 3]);   \
    unsigned b0 = cvtpk(P[BASE + 4], P[BASE + 5]), b1 = cvtpk(P[BASE + 6], P[BASE + 7]);                              \
    auto r0 = __builtin_amdgcn_permlane32_swap(a0, b0, false, false); auto r1 = __builtin_amdgcn_permlane32_swap(a1, b1, false, false); \
    u32x4 w = {r0[0], r1[0], r0[1], r1[1]}; OUT = *reinterpret_cast<bf16x8*>(&w); } while (0)
  PK4(p0, 0, pa0); PK4(p0, 8, pa1); PK4(p1, 0, pa2); PK4(p1, 8, pa3);
#undef PK4
}
__device__ __forceinline__ void qkt(f32x16& p0, f32x16& p1, const char* Ks, const bf16x8* qr, int r32, int hi) {
  p0 = f32x16{}; p1 = f32x16{};
#pragma unroll
  for (int d0 = 0; d0 < 8; ++d0) { int cb = (d0 * 16 + hi * 8) * 2;
    bf16x8 b0 = *reinterpret_cast<const bf16x8*>(Ks + KSWZ(r32, cb));
    bf16x8 b1 = *reinterpret_cast<const bf16x8*>(Ks + KSWZ(32 + r32, cb));
    p0 = __builtin_amdgcn_mfma_f32_32x32x16_bf16(b0, qr[d0], p0, 0, 0, 0);
    p1 = __builtin_amdgcn_mfma_f32_32x32x16_bf16(b1, qr[d0], p1, 0, 0, 0); }
}
__device__ __forceinline__ int v_st(int k, int c) { const int kk = (k & ~0xC) | ((k & 4) << 1) | ((k & 8) >> 1); return ((kk >> 3) * 4 + (c >> 5)) * 512 + ((kk & 7) * 32 + (c & 31)) * 2; }
__device__ __forceinline__ int v_rd_base(int lane) { return ((lane & 3) << 3) | (((lane >> 2) & 3) << 6) | (((lane >> 4) & 1) << 5) | (((lane >> 5) & 1) << 8); }
constexpr int v_rd_off(int d0, int ks, int half) { return d0 * 512 + ks * 4096 + half * 2048; }
template <int OFF> __device__ __forceinline__ s16x4 tr_read(int vb) {
  s16x4 r; asm volatile("ds_read_b64_tr_b16 %0, %1 offset:%2" : "=&v"(r) : "v"(vb), "i"(OFF) : "memory"); return r;
}
__device__ __forceinline__ float fadd_s(float a, float b) { float r; asm volatile("v_add_f32_e32 %0, %1, %2" : "=v"(r) : "v"(a), "v"(b)); return r; }
template <bool VPRE, bool KW, bool VW>
__device__ __forceinline__ void qkt_fin(f32x16& q0, f32x16& q1, const char* Ks, const bf16x8* qr, int r32, int hi,
                                        f32x16& p0, f32x16& p1, float alpha, float& l_reg, bf16x8& pa0, bf16x8& pa1, bf16x8& pa2, bf16x8& pa3, int vb, s16x4* vp,
                                        char* kw0, char* kw1, bf16x8 kv0, bf16x8 kv1, char* vw0, char* vw1, bf16x8 vv0, bf16x8 vv1) {
  q0 = f32x16{}; q1 = f32x16{};
  float psA = 0.f, psB = 0.f; unsigned c[8], d[8];
  int kof = KSWZ(r32, (hi * 8) * 2); asm volatile("" : "+v"(kof));
  bf16x8 kb0 = *reinterpret_cast<const bf16x8*>(Ks + kof), kb1 = *reinterpret_cast<const bf16x8*>(Ks + kof + 8192);
#define QF_SWAP(OUT, U, B) do { auto r0_ = __builtin_amdgcn_permlane32_swap(U[B], U[B + 2], false, false); auto r1_ = __builtin_amdgcn_permlane32_swap(U[B + 1], U[B + 3], false, false); \
    u32x4 w_ = {r0_[0], r1_[0], r0_[1], r1_[1]}; OUT = *reinterpret_cast<bf16x8*>(&w_); } while (0)
#define QF_SLOT(i) do { p1[i] = __builtin_amdgcn_exp2f(p1[i]); \
    if ((i) < 8) { psA = fadd_s(psA, p0[2 * (i)]); psA = fadd_s(psA, p0[2 * (i) + 1]); c[i] = cvtpk(p0[2 * (i)], p0[2 * (i) + 1]); } \
    if ((i) == 3) QF_SWAP(pa0, c, 0);  if ((i) == 7) QF_SWAP(pa1, c, 4); \
    if ((i) >= 2) psB = fadd_s(psB, p1[(i) - 2]); \
    if ((i) >= 3 && (((i) - 3) & 1) == 0) d[((i) - 3) / 2] = cvtpk(p1[(i) - 3], p1[(i) - 2]); \
    if ((i) == 10) QF_SWAP(pa2, d, 0); } while (0)
#pragma unroll
  for (int d0 = 0; d0 < 8; ++d0) { const int cn = kof ^ ((d0 + 1) << 5);
    q0 = __builtin_amdgcn_mfma_f32_32x32x16_bf16(kb0, qr[d0], q0, 0, 0, 0); if (d0 < 7) kb0 = *reinterpret_cast<const bf16x8*>(Ks + cn); QF_SLOT(2 * d0);
    if (KW && d0 == 2) *(bf16x8*)kw0 = kv0;
    if (VW && d0 == 5) *(bf16x8*)vw0 = vv0;
    SBAR();
    q1 = __builtin_amdgcn_mfma_f32_32x32x16_bf16(kb1, qr[d0], q1, 0, 0, 0); if (d0 < 7) kb1 = *reinterpret_cast<const bf16x8*>(Ks + cn + 8192); QF_SLOT(2 * d0 + 1);
    if (KW && d0 == 4) *(bf16x8*)kw1 = kv1;
    if (VW && d0 == 6) *(bf16x8*)vw1 = vv1;
    SBAR(); }
  if (VPRE) {
    vp[0] = tr_read<v_rd_off(0, 0, 0)>(vb); vp[1] = tr_read<v_rd_off(0, 0, 1)>(vb); vp[2] = tr_read<v_rd_off(0, 1, 0)>(vb); vp[3] = tr_read<v_rd_off(0, 1, 1)>(vb);
    vp[4] = tr_read<v_rd_off(0, 2, 0)>(vb); vp[5] = tr_read<v_rd_off(0, 2, 1)>(vb); vp[6] = tr_read<v_rd_off(0, 3, 0)>(vb); vp[7] = tr_read<v_rd_off(0, 3, 1)>(vb); }
  psB += p1[14]; psB += p1[15];
  d[7] = cvtpk(p1[14], p1[15]); QF_SWAP(pa3, d, 4);
  float ps = psA + psB;
  { auto rr = __builtin_amdgcn_permlane32_swap(__float_as_uint(ps), __float_as_uint(ps), false, false);
    ps = __uint_as_float(rr[0]) + __uint_as_float(rr[1]); }
  l_reg = l_reg * alpha + ps;
#undef QF_SLOT
#undef QF_SWAP
}
template <int D0> __device__ __forceinline__ void pv_one(f32x16& od, int vb, bf16x8 pa0, bf16x8 pa1, bf16x8 pa2, bf16x8 pa3) {
  const s16x4 l0 = tr_read<v_rd_off(D0, 0, 0)>(vb), h0 = tr_read<v_rd_off(D0, 0, 1)>(vb), l1 = tr_read<v_rd_off(D0, 1, 0)>(vb), h1 = tr_read<v_rd_off(D0, 1, 1)>(vb);
  const s16x4 l2 = tr_read<v_rd_off(D0, 2, 0)>(vb), h2 = tr_read<v_rd_off(D0, 2, 1)>(vb), l3 = tr_read<v_rd_off(D0, 3, 0)>(vb), h3 = tr_read<v_rd_off(D0, 3, 1)>(vb);
  asm volatile("s_waitcnt lgkmcnt(0)" ::: "memory"); SBAR();
#define PK(L, H) (bf16x8){L[0], L[1], L[2], L[3], H[0], H[1], H[2], H[3]}
  od = __builtin_amdgcn_mfma_f32_32x32x16_bf16(pa0, PK(l0, h0), od, 0, 0, 0);
  od = __builtin_amdgcn_mfma_f32_32x32x16_bf16(pa1, PK(l1, h1), od, 0, 0, 0);
  od = __builtin_amdgcn_mfma_f32_32x32x16_bf16(pa2, PK(l2, h2), od, 0, 0, 0);
  od = __builtin_amdgcn_mfma_f32_32x32x16_bf16(pa3, PK(l3, h3), od, 0, 0, 0);
#undef PK
}
__device__ __forceinline__ void pv_d0(f32x16* o, int vb, bf16x8 pa0, bf16x8 pa1, bf16x8 pa2, bf16x8 pa3) {
  pv_one<0>(o[0], vb, pa0, pa1, pa2, pa3); pv_one<1>(o[1], vb, pa0, pa1, pa2, pa3); pv_one<2>(o[2], vb, pa0, pa1, pa2, pa3); pv_one<3>(o[3], vb, pa0, pa1, pa2, pa3);
}
__device__ __forceinline__ void pv_d0_exp(f32x16* o, int vb, bf16x8 pa0, bf16x8 pa1, bf16x8 pa2, bf16x8 pa3, f32x16& pn, const s16x4* vp) {
  asm volatile("s_waitcnt lgkmcnt(0)" ::: "memory"); SBAR();
#define PK(L, H) (bf16x8){L[0], L[1], L[2], L[3], H[0], H[1], H[2], H[3]}
  o[0] = __builtin_amdgcn_mfma_f32_32x32x16_bf16(pa0, PK(vp[0], vp[1]), o[0], 0, 0, 0);
  o[0] = __builtin_amdgcn_mfma_f32_32x32x16_bf16(pa1, PK(vp[2], vp[3]), o[0], 0, 0, 0);
  o[0] = __builtin_amdgcn_mfma_f32_32x32x16_bf16(pa2, PK(vp[4], vp[5]), o[0], 0, 0, 0);
  o[0] = __builtin_amdgcn_mfma_f32_32x32x16_bf16(pa3, PK(vp[6], vp[7]), o[0], 0, 0, 0);
#undef PK
#pragma unroll
  for (int r = 0; r < 4; ++r) pn[r] = __builtin_amdgcn_exp2f(pn[r]);
  pv_one<1>(o[1], vb, pa0, pa1, pa2, pa3);
#pragma unroll
  for (int r = 4; r < 8; ++r) pn[r] = __builtin_amdgcn_exp2f(pn[r]);
  pv_one<2>(o[2], vb, pa0, pa1, pa2, pa3);
#pragma unroll
  for (int r = 8; r < 12; ++r) pn[r] = __builtin_amdgcn_exp2f(pn[r]);
  pv_one<3>(o[3], vb, pa0, pa1, pa2, pa3);
#pragma unroll
  for (int r = 12; r < 16; ++r) pn[r] = __builtin_amdgcn_exp2f(pn[r]);
}
__device__ __forceinline__ void bmask(f32x16& p0, f32x16& p1, int dq0, int kj0, int hw, int L) {
  const float ninf = -__builtin_inff();
#pragma unroll
  for (int r = 0; r < 16; ++r) { const int c = (r & 3) + 8 * (r >> 2);
    const bool ok0 = ((unsigned)(dq0 + c + hw) <= (unsigned)(2 * hw)) && ((unsigned)(kj0 + c) < (unsigned)L);
    const bool ok1 = ((unsigned)(dq0 + c + 32 + hw) <= (unsigned)(2 * hw)) && ((unsigned)(kj0 + c + 32) < (unsigned)L);
    p0[r] = ok0 ? p0[r] : ninf; p1[r] = ok1 ? p1[r] : ninf; }
}
struct Band { int i0, L, hw, tlo; float m0, l0; float* lse; long lse_ld; };

template <bool BAND, int MODE>
__device__ __forceinline__ void attn_body(const bf16_t* __restrict__ Qb, const bf16_t* __restrict__ Kh, const bf16_t* __restrict__ Vh, bf16_t* __restrict__ Ob,
                                          const long ldq, const long ldk, const long ldo, const int NT, const Band bd, char* lds) {
  int tid = threadIdx.x; asm volatile("" : "+v"(tid));
  const int wid = tid >> 6, lane = tid & 63, r32 = lane & 31, hi = lane >> 5;
  char* V_lds = lds; char* K_lds = lds + 2 * SHM_V;
  float* ws = (float*)(lds + 2 * SHM_V + 2 * SHM_K) + wid * 64; float* li_l = ws; float* al_l = ws + 32;
  float m_reg = BAND ? bd.m0 : -1e30f, l_reg = BAND ? bd.l0 : 0.f; f32x16 o[4] = {}; bf16x8 qr[8];
  const bf16_t* Qw = Qb + (long)(wid * QBLK + r32) * ldq + hi * 8;
#pragma unroll
  for (int d0 = 0; d0 < 8; ++d0) qr[d0] = *reinterpret_cast<const bf16x8*>(Qw + d0 * 16);
  const int sr = tid >> 4, sc = (tid & 15) * 8, vst0 = v_st(sr, sc), vst1 = v_st(32 + sr, sc);
  const int vb0 = (int)(uintptr_t)V_lds + v_rd_base(lane);
  const int qi = BAND ? bd.i0 + wid * QBLK + r32 : 0;
  struct { bf16x8 vs0, vs1, ks0, ks1; } sr_[2];
#define KROW(k) (BAND ? (long)min(max((k), 0), bd.L - 1) : (long)(k))
#define SLOAD(i, jt) do { const int k0_ = (BAND ? bd.tlo + (jt) : (jt)) * KVBLK; const long ra_ = KROW(k0_ + sr) * ldk + sc, rb_ = KROW(k0_ + 32 + sr) * ldk + sc; \
    sr_[i].ks0 = *reinterpret_cast<const bf16x8*>(Kh + ra_); sr_[i].ks1 = *reinterpret_cast<const bf16x8*>(Kh + rb_); \
    sr_[i].vs0 = *reinterpret_cast<const bf16x8*>(Vh + ra_); sr_[i].vs1 = *reinterpret_cast<const bf16x8*>(Vh + rb_); } while (0)
#define SWRITE(b, i) do { *(bf16x8*)(V_lds + (b) * SHM_V + vst0) = sr_[i].vs0;          \
    *(bf16x8*)(V_lds + (b) * SHM_V + vst1) = sr_[i].vs1; int kc = sc * 2;               \
    *(bf16x8*)(K_lds + (b) * SHM_K + KSWZ(sr, kc)) = sr_[i].ks0;                       \
    *(bf16x8*)(K_lds + (b) * SHM_K + KSWZ(32 + sr, kc)) = sr_[i].ks1; } while (0)
#define SWRITE_V(b, i) do { *(bf16x8*)(V_lds + (b) * SHM_V + vst0) = sr_[i].vs0; *(bf16x8*)(V_lds + (b) * SHM_V + vst1) = sr_[i].vs1; } while (0)
#define SWAIT() asm volatile("s_waitcnt vmcnt(4)" ::: "memory")
#define RESC(a) do { if (MODE != 2 && __any((a) < 1.f)) { if (hi == 0) al_l[r32] = (a); asm volatile("s_waitcnt lgkmcnt(0)" ::: "memory"); \
    _Pragma("unroll") for (int d = 0; d < 4; ++d) _Pragma("unroll") for (int r = 0; r < 16; ++r) o[d][r] *= al_l[crow(r, hi)]; } } while (0)
#define BMASK(P0, P1, jt) do { if (BAND) { const int kt_ = (bd.tlo + (jt)) * KVBLK + 4 * hi; bmask(P0, P1, kt_ - qi, kt_, bd.hw, bd.L); } } while (0)
  f32x16 pA0, pA1, pB0, pB1; float mnA, mnB, alA, alB; bf16x8 pa0, pa1, pa2, pa3; s16x4 vpre[8];
  constexpr int SE = 0, SO = 1;
  SLOAD(SE, 0); asm volatile("s_waitcnt vmcnt(0)" ::: "memory"); SWRITE(0, SE); __syncthreads();
  qkt(pA0, pA1, K_lds, qr, r32, hi); BMASK(pA0, pA1, 0); partialSM<MODE>(pA0, pA1, m_reg, mnA, alA);
  SLOAD(SO, 1); if (2 < NT) SLOAD(SE, 2);
  SWAIT(); SWRITE(1, SO); __syncthreads();
  for (int j = 1; j + 1 < NT; j += 2) {
    SBAR(); qkt_fin<MODE == 2, true, true>(pB0, pB1, K_lds + SHM_K, qr, r32, hi, pA0, pA1, alA, l_reg, pa0, pa1, pa2, pa3, vb0, vpre,
                                           K_lds + KSWZ(sr, sc * 2), K_lds + KSWZ(32 + sr, sc * 2), sr_[SE].ks0, sr_[SE].ks1, V_lds + SHM_V + vst0, V_lds + SHM_V + vst1, sr_[SO].vs0, sr_[SO].vs1); SBAR();
    SLOAD(SO, j + 2); SBAR();
    if (MODE == 2) { pv_d0_exp(o, vb0, pa0, pa1, pa2, pa3, pB0, vpre); mnB = 0.f; alB = 1.f; }
    else { pv_d0(o, vb0, pa0, pa1, pa2, pa3); BMASK(pB0, pB1, j); partialSM<MODE>(pB0, pB1, m_reg, mnB, alB); }
    RESC(alB); __syncthreads();
    SBAR(); qkt_fin<MODE == 2, true, true>(pA0, pA1, K_lds, qr, r32, hi, pB0, pB1, alB, l_reg, pa0, pa1, pa2, pa3, vb0 + (int)SHM_V, vpre,
                                           K_lds + SHM_K + KSWZ(sr, sc * 2), K_lds + SHM_K + KSWZ(32 + sr, sc * 2), sr_[SO].ks0, sr_[SO].ks1, V_lds + vst0, V_lds + vst1, sr_[SE].vs0, sr_[SE].vs1); SBAR();
    if (j + 3 < NT) SLOAD(SE, j + 3); SBAR();
    if (MODE == 2) { pv_d0_exp(o, vb0 + (int)SHM_V, pa0, pa1, pa2, pa3, pA0, vpre); mnA = 0.f; alA = 1.f; }
    else { pv_d0(o, vb0 + (int)SHM_V, pa0, pa1, pa2, pa3); BMASK(pA0, pA1, j + 1); partialSM<MODE>(pA0, pA1, m_reg, mnA, alA); }
    RESC(alA); __syncthreads();
  }
  SBAR(); qkt_fin<false, false, true>(pB0, pB1, K_lds + SHM_K, qr, r32, hi, pA0, pA1, alA, l_reg, pa0, pa1, pa2, pa3, 0, vpre,
                                      nullptr, nullptr, sr_[SE].ks0, sr_[SE].ks1, V_lds + SHM_V + vst0, V_lds + SHM_V + vst1, sr_[SO].vs0, sr_[SO].vs1); SBAR();
  pv_d0(o, vb0, pa0, pa1, pa2, pa3); BMASK(pB0, pB1, NT - 1); partialSM<MODE>(pB0, pB1, m_reg, mnB, alB);
  __syncthreads(); RESC(alB);
  finishSM(pB0, pB1, alB, l_reg, pa0, pa1, pa2, pa3); SBAR();
  pv_d0(o, vb0 + (int)SHM_V, pa0, pa1, pa2, pa3);
  if (hi == 0) li_l[r32] = l_reg; asm volatile("s_waitcnt lgkmcnt(0)" ::: "memory");
  float rli[16];
#pragma unroll
  for (int r = 0; r < 16; ++r) rli[r] = __builtin_amdgcn_rcpf(li_l[crow(r, hi)]);
  bf16_t* Ow = Ob + (long)(wid * QBLK) * ldo;
  const int odd = lane & 1;
#pragma unroll
  for (int r = 0; r < 16; r += 2) { const long orow = crow(r, hi) + odd;
#pragma unroll
    for (int d0 = 0; d0 < 4; ++d0) { const float a = o[d0][r] * rli[r], b = o[d0][r + 1] * rli[r + 1];
      const float snd = odd ? a : b;
      const float rcv = __int_as_float(__builtin_amdgcn_mov_dpp(__float_as_int(snd), 0xB1, 0xF, 0xF, true));
      const unsigned pk = odd ? cvtpk(rcv, b) : cvtpk(a, rcv);
      *(unsigned*)(Ow + orow * ldo + d0 * 32 + (r32 & ~1)) = pk; } }
  if (BAND) { if (bd.lse != nullptr && hi == 0) bd.lse[(long)(wid * QBLK + r32) * bd.lse_ld] = m_reg * SCALE + __logf(l_reg); }
  __syncthreads();
#undef KROW
#undef SLOAD
#undef SWRITE
#undef SWAIT
#undef SWRITE_V
#undef RESC
#undef BMASK
}
}

constexpr size_t MiB = 1u << 20;
constexpr size_t WS_CTL = 0;
constexpr int NSS = 3 * DEPTH + 1;
constexpr size_t CTL_ZERO_BYTES = 1 * MiB;
constexpr size_t WS_ROPE = 1 * MiB;
constexpr size_t WS_ROPEX = 9 * MiB;
constexpr size_t WS_LSE = 10 * MiB;
constexpr size_t WS_SS = 12 * MiB;
constexpr size_t WS_W = 32 * MiB;
static_assert(WS_SS + (size_t)NSS * M * 8 * 4 <= WS_W, "ssq buffers");
constexpr size_t WO_F1IN = 0, WO_F1OUT = WO_F1IN + (size_t)NFF2 * DM * 2, WO_PG = WO_F1OUT + (size_t)DM * DFF * 2, WO_BR = WO_PG + (size_t)PGW * DM * 2,
                 WO_WO = WO_BR + (size_t)DM * DM * 2, WO_F2IN = WO_WO + (size_t)DM * DM * 2, WO_F2OUT = WO_F2IN + (size_t)NFF2 * DM * 2, W_BYTES = WO_F2OUT + (size_t)DM * DFF * 2;
constexpr size_t W_SLOT = ((W_BYTES + MiB - 1) / MiB) * MiB;
constexpr size_t WS_HI = WS_W + 2 * W_SLOT;
constexpr size_t WS_LO = WS_HI + (size_t)M * DM * 2;
constexpr size_t WS_Y = WS_LO + (STREAM_LO ? (size_t)M * DM * 2 : 0);
constexpr size_t WS_BIG = WS_Y + (size_t)M * DM * 2;
constexpr size_t WS_PROJ = WS_BIG, WS_GATES = WS_BIG + (size_t)M * INW * 2, WS_MERGED = WS_PROJ;
constexpr size_t WS_END = WS_GATES + (size_t)M * GATEW;
static_assert((size_t)M * DFF * 2 <= WS_END - WS_BIG, "act fits the overlay");
constexpr int CW_BAR = 4096;

constexpr int RING_OFF = 0, RING_BYTES = 131072;
constexpr int LDSCTL_OFF = RING_BYTES, MISC_OFF = LDSCTL_OFF + 320, HTAB_OFF = LDSCTL_OFF + 1024, RSTD_OFF = HTAB_OFF + 8192;
constexpr int LDS_BYTES = 147456;
constexpr int NWAVES = 8;

typedef GAS unsigned gu32;
#define RLX_AGENT __ATOMIC_RELAXED, __HIP_MEMORY_SCOPE_AGENT
#define LDS_WAIT() asm volatile("s_waitcnt lgkmcnt(0)" ::: "memory")

#define XB_TMO      128
#define XB_XCNT(j)  (256  + 64 * (j))
#define XB_XSUB(j)  (1280 + 64 * (j))
#define XB_XGEN(j)  (2304 + 64 * (j))
#define XB_TOP      3328
#define XB_TOPGEN   3392
#define XCD_BAR_WORDS 3456
#define XB_SPIN_CAP (1u << 22)
__device__ __forceinline__ unsigned xb_ld(unsigned* p)              { return __hip_atomic_load(p, __ATOMIC_RELAXED, __HIP_MEMORY_SCOPE_AGENT); }
__device__ __forceinline__ unsigned xb_add(unsigned* p, unsigned v) { return __hip_atomic_fetch_add(p, v, __ATOMIC_RELAXED, __HIP_MEMORY_SCOPE_AGENT); }
__device__ __forceinline__ unsigned xb_xcc_id() { return (unsigned)__builtin_amdgcn_s_getreg((3 << 11) | 20) & 0xFu; }
#define XB_SPIN(cond, bar) do { unsigned _sp = 0; while (cond) { __builtin_amdgcn_s_sleep(1); \
    if ((++_sp & 255u) == 0u) { if (xb_ld(&(bar)[XB_TMO])) break; if (_sp > XB_SPIN_CAP) { atomicAdd(&(bar)[XB_TMO], 1u); break; } } } } while (0)
struct XcdBarrier { unsigned* bar; unsigned x; volatile LAS unsigned* st; };
__device__ __forceinline__ XcdBarrier xcd_barrier_post(unsigned* bar, volatile LAS unsigned* st) {
    XcdBarrier b; b.bar = bar; b.x = xb_xcc_id(); b.st = st;
    if (threadIdx.x == 0) (void)xb_add(&bar[XB_XCNT(b.x)], 1u);
    return b;
}
__device__ __forceinline__ void xcd_barrier_complete(unsigned* bar, unsigned x, unsigned& nloc, unsigned& nx) {
    const unsigned G = gridDim.x * gridDim.y * gridDim.z;
    unsigned sum, cnt, mine, sp = 0u;
    for (;;) {
        sum = 0u; cnt = 0u; mine = 0u;
#pragma unroll
        for (unsigned j = 0; j < 16; ++j) { const unsigned c = xb_ld(&bar[XB_XCNT(j)]); sum += c; cnt += (c > 0u) ? 1u : 0u; mine = (j == x) ? c : mine; }
        if (sum == G) break;
        __builtin_amdgcn_s_sleep(1);
        if ((++sp & 255u) == 0u) { if (xb_ld(&bar[XB_TMO])) break; if (sp > XB_SPIN_CAP) { atomicAdd(&bar[XB_TMO], 1u); break; } }
    }
    nloc = mine > 0u ? mine : 1u; nx = cnt > 0u ? cnt : 1u;
}
__device__ __forceinline__ void xcd_barrier(const XcdBarrier& b) {
    asm volatile("s_waitcnt vmcnt(0)" ::: "memory");
    __syncthreads();
    if (threadIdx.x == 0) {
        unsigned* bar = b.bar;
        __builtin_amdgcn_s_waitcnt(0);
        unsigned nloc = b.st[0], nx = b.st[1];
        if (nloc == 0u) { xcd_barrier_complete(bar, b.x, nloc, nx); b.st[0] = nloc; b.st[1] = nx; }
        const unsigned old = xb_add(&bar[XB_XSUB(b.x)], 1u);
        const unsigned gen = old / nloc;
        if (old + 1u == (gen + 1u) * nloc) {
            __builtin_amdgcn_fence(__ATOMIC_RELEASE, "agent");
            asm volatile("s_waitcnt vmcnt(0)" ::: "memory");
            const unsigned og = xb_add(&bar[XB_TOP], 1u);
            const unsigned tg = og / nx;
            if (og + 1u == (tg + 1u) * nx) xb_add(&bar[XB_TOPGEN], 1u);
            else XB_SPIN(xb_ld(&bar[XB_TOPGEN]) == tg, bar);
            __builtin_amdgcn_fence(__ATOMIC_ACQUIRE, "agent");
            xb_add(&bar[XB_XGEN(b.x)], 1u);
            asm volatile("s_waitcnt vmcnt(0)" ::: "memory");
        } else {
            XB_SPIN(xb_ld(&bar[XB_XGEN(b.x)]) == gen, bar);
            __builtin_amdgcn_fence(__ATOMIC_ACQUIRE, "agent");
            asm volatile("s_waitcnt vmcnt(0)" ::: "memory");
        }
    }
    __syncthreads();
}

__device__ __forceinline__ float wave_sum(float v) {
#pragma unroll
    for (int o = 1; o < 64; o <<= 1) v += __shfl_xor(v, o);
    return v;
}
__device__ __forceinline__ int w_in_row(int n) {
    const int d = n & 127, hb = n & ~127;
    const bool plain = (n >= COL_VA && n < COL_QB) || (n >= COL_VB && n < COL_QC) || (n >= COL_VC), axial = (n >= COL_QC && n < COL_VC);
    const int cs = 2 * (d & 63) + (d >> 6), ca = 2 * ((d & 31) + 32 * (d >> 6)) + ((d >> 5) & 1);
    return FUSE_PREP ? hb + (plain ? d : (axial ? ca : cs)) : n;
}
template <bool MAPIN>
__device__ __forceinline__ void transpose_item(const float* W, int K, int N, bf16_t* WT, int k0, int n0, int drow, const float* gain, LAS float* scr, int lane) {
    float wv[32];
#pragma unroll
    for (int i = 0; i < 32; ++i) wv[i] = W[(size_t)(k0 + 2 * i + (lane >> 5)) * N + n0 + (lane & 31)];
    if (gain) {
#pragma unroll
        for (int i = 0; i < 32; ++i) wv[i] *= gain[k0 + 2 * i + (lane >> 5)];
    }
#pragma unroll
    for (int i = 0; i < 32; ++i) scr[(2 * i + (lane >> 5)) * 33 + (lane & 31)] = wv[i];
    LDS_WAIT(); asm volatile("" ::: "memory");
    const int c = lane & 7;
#pragma unroll
    for (int j = 0; j < 4; ++j) { const int n = (lane >> 3) + 8 * j; const LAS float* s = scr + (8 * c) * 33 + n;
        u32x4 o; o.x = pk2(s[0 * 33], s[1 * 33]); o.y = pk2(s[2 * 33], s[3 * 33]); o.z = pk2(s[4 * 33], s[5 * 33]); o.w = pk2(s[6 * 33], s[7 * 33]);
        const int dr = MAPIN ? w_in_row(n0 + n) : drow + n;
        *(GAS u32x4*)(WT + (size_t)dr * K + k0 + 8 * c) = o; }
    LDS_WAIT(); asm volatile("" ::: "memory");
}
__device__ __forceinline__ void sincos_d(double a, float& s, float& c) {
    const double q = rint(a * 0.63661977236758134308);
    double y = fma(-q, 1.5707963267948966192, a); y = fma(-q, 6.123233995736766e-17, y);
    const double y2 = y * y;
    double sp = 1.0 / 6227020800.0; sp = fma(sp, y2, -1.0 / 39916800.0); sp = fma(sp, y2, 1.0 / 362880.0); sp = fma(sp, y2, -1.0 / 5040.0); sp = fma(sp, y2, 1.0 / 120.0); sp = fma(sp, y2, -1.0 / 6.0); sp = fma(sp, y2, 1.0);
    const double sy = y * sp;
    double cp = -1.0 / 87178291200.0; cp = fma(cp, y2, 1.0 / 479001600.0); cp = fma(cp, y2, -1.0 / 3628800.0); cp = fma(cp, y2, 1.0 / 40320.0); cp = fma(cp, y2, -1.0 / 720.0); cp = fma(cp, y2, 1.0 / 24.0); cp = fma(cp, y2, -0.5); cp = fma(cp, y2, 1.0);
    const int k = (int)q & 3;
    const double ss = (k & 1) ? cp : sy, cc = (k & 1) ? sy : cp;
    s = (float)((k & 2) ? -ss : ss); c = (float)(((k + 1) & 2) ? -cc : cc);
}

__device__ __forceinline__ void convert_layer(const float* const* in, int l, bf16_t* Wb, LAS unsigned char* ldsl, int gw, int NGW, int lane, int wave) {

                LAS float* scr = (LAS float*)(ldsl + RING_OFF + wave * 16384);
                constexpr int I_FIN = (DM / 64) * (NFF2 / 32), I_FOUT = (DFF / 64) * (DM / 32), I_IN = (DM / 64) * (INW / 32), I_GT = (DM / 64) * (GATEW / 32), I_SQ = (DM / 64) * (DM / 32);
                constexpr int NITEMS = 2 * I_FIN + 2 * I_FOUT + I_IN + I_GT + 2 * I_SQ;
                const float* w_f1in = in[3] + (size_t)l * DM * NFF2; const float* w_f1out = in[4] + (size_t)l * DFF * DM;
                const float* w_in = in[6] + (size_t)l * DM * INW; const float* w_br = in[10] + (size_t)l * DM * DM;
                const float* w_gt = in[11] + (size_t)l * DM * GATEW; const float* w_o = in[13] + (size_t)l * DM * DM;
                const float* w_f2in = in[15] + (size_t)l * DM * NFF2; const float* w_f2out = in[16] + (size_t)l * DFF * DM;
                const float* g1 = in[2] + (size_t)l * DM; const float* gm = in[5] + (size_t)l * DM; const float* g2 = in[14] + (size_t)l * DM;
                for (int it = gw; it < NITEMS; it += NGW) {
                    int r = it;
                    if (r < 2 * I_FIN) { const bool sec = r >= I_FIN; if (sec) r -= I_FIN; const int nblk = NFF2 / 32, kb = r / nblk, nb = r % nblk, n0 = nb * 32;
                        const int half = n0 >= DFF ? 1 : 0, rem = n0 - half * DFF, drow = (rem >> 7) * 256 + half * 128 + (rem & 127);
                        transpose_item<false>(sec ? w_f2in : w_f1in, DM, NFF2, (bf16_t*)((char*)Wb + (sec ? WO_F2IN : WO_F1IN)), kb * 64, n0, drow, sec ? g2 : g1, scr, lane); continue; }
                    r -= 2 * I_FIN;
                    if (r < 2 * I_FOUT) { const bool sec = r >= I_FOUT; if (sec) r -= I_FOUT; const int nblk = DM / 32, kb = r / nblk, nb = r % nblk;
                        transpose_item<false>(sec ? w_f2out : w_f1out, DFF, DM, (bf16_t*)((char*)Wb + (sec ? WO_F2OUT : WO_F1OUT)), kb * 64, nb * 32, nb * 32, nullptr, scr, lane); continue; }
                    r -= 2 * I_FOUT;
                    if (r < I_IN) { const int nblk = INW / 32, kb = r / nblk, nb = r % nblk;
                        transpose_item<true>(w_in, DM, INW, (bf16_t*)((char*)Wb + WO_PG), kb * 64, nb * 32, 0, gm, scr, lane); continue; }
                    r -= I_IN;
                    if (r < I_GT) { const int nblk = GATEW / 32, kb = r / nblk, nb = r % nblk;
                        transpose_item<false>(w_gt, DM, GATEW, (bf16_t*)((char*)Wb + WO_PG), kb * 64, nb * 32, INW + nb * 32, gm, scr, lane); continue; }
                    r -= I_GT;
                    { const bool sec = r >= I_SQ; if (sec) r -= I_SQ; const int nblk = DM / 32, kb = r / nblk, nb = r % nblk;
                        transpose_item<false>(sec ? w_o : w_br, DM, DM, (bf16_t*)((char*)Wb + (sec ? WO_WO : WO_BR)), kb * 64, nb * 32, nb * 32, nullptr, scr, lane); }
                }
            }

struct Args { const float* in[18]; float* out; unsigned char* ws; int ph_lo, ph_hi; };
constexpr int PH_PER_STEP = 10, PH_FINAL = NSTEP * PH_PER_STEP, PH_END = PH_FINAL + 1;

__global__ void __launch_bounds__(NWAVES * 64, 2) fwd_kernel(Args args) {
    extern __shared__ __attribute__((aligned(16))) unsigned char lds[];
    LAS unsigned char* ldsl = (LAS unsigned char*)lds;
    volatile LAS unsigned* MISC = (volatile LAS unsigned*)(ldsl + MISC_OFF);
    const int G = gridDim.x; const int bx = blockIdx.x;
    const int vcu = (G % 8 == 0) ? (bx % 8) * (G / 8) + bx / 8 : bx;
    unsigned char* ws = args.ws;
    gu32* ctl = (gu32*)(ws + WS_CTL);
    for (int u = threadIdx.x; u < (LDS_BYTES - LDSCTL_OFF) / 4; u += NWAVES * 64) ((LAS unsigned*)(ldsl + LDSCTL_OFF))[u] = 0u;
    __syncthreads();
    const int lo = args.ph_lo, hi = args.ph_hi;
    const bool one_launch = (hi - lo) > 1;
    XcdBarrier bar; bar.bar = (unsigned*)(ctl + CW_BAR); bar.x = 0; bar.st = nullptr;
    if (one_launch) bar = xcd_barrier_post((unsigned*)(ctl + CW_BAR), MISC + 8);
    bool first = true;
#ifndef PH_MASK
#define PH_MASK 0xFFFF
#endif
#define PHASE_BEGIN(p) if (((PH_MASK >> ((p) == PH_FINAL ? 10 : (p) % PH_PER_STEP)) & 1) && lo <= (p) && (p) < hi) { if (!first) xcd_barrier(bar); first = false; \
    for (int rep_ = 0; rep_ <= ((REP_MASK >> ((p) == PH_FINAL ? 10 : (p) % PH_PER_STEP)) & 1); ++rep_) {
#define PHASE_END } }

    const float* xp = args.in[0]; const float* xs = args.in[1];
    float* out = args.out;
    f32x2* rope = (f32x2*)(ws + WS_ROPE); f32x2* ropex = (f32x2*)(ws + WS_ROPEX);
    float* lseb = (float*)(ws + WS_LSE); float* ssb = (float*)(ws + WS_SS);
    bf16_t* HI = (bf16_t*)(ws + WS_HI); bf16_t* LO = (bf16_t*)(ws + WS_LO); bf16_t* Y = (bf16_t*)(ws + WS_Y); bf16_t* MERGED = (bf16_t*)(ws + WS_MERGED);
    bf16_t* ACT = (bf16_t*)(ws + WS_BIG); bf16_t* PROJ = (bf16_t*)(ws + WS_PROJ); bf16_t* GATES = (bf16_t*)(ws + WS_GATES);
    const int NGW = G * NWAVES;
#define LOCAL_IDS int tid = threadIdx.x; asm volatile("" : "+v"(tid)); const int lane = tid & 63, wave = __builtin_amdgcn_readfirstlane(tid >> 6), gw = vcu * NWAVES + wave; (void)lane; (void)gw;
#define XCD_STAGGER(ticks) do { const unsigned long long t0_ = __builtin_amdgcn_s_memrealtime(), dl_ = (unsigned long long)((bx & 7) * (ticks)); \
        while (__builtin_amdgcn_s_memrealtime() - t0_ < dl_) __builtin_amdgcn_s_sleep(8); } while (0)
    if (lo == 0) {
        int tid = threadIdx.x; asm volatile("" : "+v"(tid));
        const int gt = vcu * NWAVES * 64 + tid, NGT = G * NWAVES * 64;
        for (int e = gt; e < S_P * 64 + 256 * 32; e += NGT) {
            const bool ax = e >= S_P * 64; const int ee = ax ? e - S_P * 64 : e; const int pos = ax ? ee >> 5 : ee >> 6, i = ax ? ee & 31 : ee & 63;
            const double base = ax ? 0.7498942093324559 : 0.8659643233600653; double inv = 1.0; double bp = base; int ii = i;
            for (int b = 0; b < 6; ++b) { if (ii & 1) inv *= bp; bp *= bp; ii >>= 1; }
            float sn, cs; sincos_d((double)pos * inv, sn, cs);
            (ax ? ropex : rope)[ee] = (f32x2){cs, sn};
        }
    }

    for (int s = 0; s < NSTEP; ++s) {
        const int l = s >> 1, which = s & 1, pb = s * PH_PER_STEP;
        bf16_t* Wb = (bf16_t*)(ws + WS_W + (size_t)(l & 1) * W_SLOT);
        if (s == 0) {
        PHASE_BEGIN(pb + 0)
            LOCAL_IDS
            convert_layer(args.in, l, Wb, ldsl, gw, NGW, lane, wave);
            if (s == 0) {
                for (int m = gw; m < M; m += NGW) {
                    const float* xrow = m < S_P ? xp + (size_t)m * DM : xs + (size_t)(m - S_P) * DM;
                    const GAS f32x4* xr = (const GAS f32x4*)xrow + lane; f32x4 v[8]; float sq = 0.f;
#pragma unroll
                    for (int j = 0; j < 8; ++j) { v[j] = xr[64 * j]; sq += (v[j].x * v[j].x + v[j].y * v[j].y) + (v[j].z * v[j].z + v[j].w * v[j].w); }
                    sq = wave_sum(sq); if (lane < 8) ssb[(size_t)m * 8 + lane] = lane == 0 ? sq : 0.f;
                    GAS u32x2* oh = (GAS u32x2*)(HI + (size_t)m * DM) + lane; GAS u32x2* ol = (GAS u32x2*)(LO + (size_t)m * DM) + lane;
#pragma unroll
                    for (int j = 0; j < 8; ++j) { const u32x2 h = (u32x2){cvt_pk_bf16(v[j].x, v[j].y), cvt_pk_bf16(v[j].z, v[j].w)};
                        oh[64 * j] = h; if (STREAM_LO) ol[64 * j] = (u32x2){cvt_pk_bf16(v[j].x - bf_lo(h.x), v[j].y - bf_hi(h.x)), cvt_pk_bf16(v[j].z - bf_lo(h.y), v[j].w - bf_hi(h.y))}; }
                }
            }
        PHASE_END
        }
        PHASE_BEGIN(pb + 1)
            pg8::PlainSched S; S.so.init(M, NFF2, G, bx, 8); S.nt = DM / 64;
            pg8::EpiSwiglu E{ACT, ssb + (size_t)(3 * l + 2 * which) * M * 8, (LAS float*)(ldsl + RSTD_OFF), -1};
            pg8::gemm_phase<pg8::EpiSwiglu, pg8::PlainSched>(ldsl + RING_OFF, HI, (const bf16_t*)((char*)Wb + (which ? WO_F2IN : WO_F1IN)), DM, S, E);
        PHASE_END
        PHASE_BEGIN(pb + 2)
            pg8::PlainSched S; S.so.init(M, DM, G, bx, 4); S.nt = DFF / 64;
            pg8::EpiStream E{HI, LO, ssb + (size_t)(3 * l + 1 + 2 * which) * M * 8, rep_ == ((REP_MASK >> 2) & 1) ? 0.5f : 0.f, (LAS float*)(ldsl + HTAB_OFF)};
            pg8::gemm_phase<pg8::EpiStream, pg8::PlainSched>(ldsl + RING_OFF, ACT, (const bf16_t*)((char*)Wb + (which ? WO_F2OUT : WO_F1OUT)), DFF, S, E);
        PHASE_END
        if (which == 0) {
        PHASE_BEGIN(pb + 4)
            pg8::PlainSched S; S.so.init(M, PGW, G, bx, 8); S.nt = DM / 64;
            pg8::EpiProjGate E{PROJ, GATES, args.in[12] + (size_t)l * GATEW, ssb + (size_t)(3 * l + 1) * M * 8, rope, ropex, args.in[8] + (size_t)l * 128, args.in[9] + (size_t)l * 128, (LAS float*)(ldsl + HTAB_OFF), (LAS float*)(ldsl + RSTD_OFF), -1};
            pg8::gemm_phase<pg8::EpiProjGate, pg8::PlainSched>(ldsl + RING_OFF, HI, (const bf16_t*)((char*)Wb + WO_PG), DM, S, E);
        PHASE_END
        if (!FUSE_PREP) { PHASE_BEGIN(pb + 5)
            LOCAL_IDS
            const float* gq = args.in[8] + (size_t)l * 128; const float* gk = args.in[9] + (size_t)l * 128;
            const int e1x = (lane >> 5) * 64 + (lane & 31), e2x = e1x + 32;
            const float gq1 = gq[e1x], gq2 = gq[e2x], gk1 = gk[e1x], gk2 = gk[e2x];
            const float pz = rep_ == ((REP_MASK >> 5) & 1) ? 1.f : 0.f, pk = 1.f - pz;
            for (int m = gw; m < M; m += NGW) {
                const int pos = m < S_P ? m : (m & (S_S - 1));
                const f32x2 cs = rope[pos * 64 + lane];
                const int idx = (lane >> 5) ? (pos & 63) : (pos >> 6);
                const f32x2 cx = ropex[idx * 32 + (lane & 31)];
                bf16_t* row = PROJ + (size_t)m * INW;
#pragma unroll 6
                for (int hh = 0; hh < 18; ++hh) {
                    bf16_t* hp = row + (hh < 6 ? hh * 128 : COL_QB + (hh - 6) * 128);
                    const float x1 = __uint_as_float((unsigned)hp[lane] << 16), x2 = __uint_as_float((unsigned)hp[lane + 64] << 16);
                    hp[lane] = (bf16_t)f2bf(REP_MASK ? pk * x1 + pz * (x1 * cs.x - x2 * cs.y) : x1 * cs.x - x2 * cs.y); hp[lane + 64] = (bf16_t)f2bf(REP_MASK ? pk * x2 + pz * (x2 * cs.x + x1 * cs.y) : x2 * cs.x + x1 * cs.y);
                }
#pragma unroll 4
                for (int hh = 0; hh < 8; ++hh) {
                    bf16_t* hp = row + COL_QC + hh * 128;
                    const float x1 = __uint_as_float((unsigned)hp[e1x] << 16), x2 = __uint_as_float((unsigned)hp[e2x] << 16);
                    const float rstd = 1.0f / sqrtf(wave_sum(x1 * x1 + x2 * x2) * (1.0f / 128.0f) + NORM_EPS);
                    const float y1 = x1 * rstd * (hh < 6 ? gq1 : gk1), y2 = x2 * rstd * (hh < 6 ? gq2 : gk2);
                    hp[e1x] = (bf16_t)f2bf(REP_MASK ? pk * x1 + pz * (y1 * cx.x - y2 * cx.y) : y1 * cx.x - y2 * cx.y); hp[e2x] = (bf16_t)f2bf(REP_MASK ? pk * x2 + pz * (y2 * cx.x + y1 * cx.y) : y2 * cx.x + y1 * cx.y);
                }
            }
        PHASE_END }
        PHASE_BEGIN(pb + 6)
            char* alds = (char*)lds + RING_OFF;
            att::Band nob{0, 0, 0, 0, -1e30f, 0.f, nullptr, 0};
            float cb; { const float* gqp = args.in[8] + (size_t)l * 128; const float* gkp = args.in[9] + (size_t)l * 128; int ln = threadIdx.x; asm volatile("" : "+v"(ln)); ln &= 63;
                float a = fmaxf(fabsf(gqp[ln]), fabsf(gqp[ln + 64])), b = fmaxf(fabsf(gkp[ln]), fabsf(gkp[ln + 64]));
#pragma unroll
                for (int o = 1; o < 64; o <<= 1) { a = fmaxf(a, __shfl_xor(a, o)); b = fmaxf(b, __shfl_xor(b, o)); }
                cb = __builtin_amdgcn_readfirstlane(a * b * (128.0f * att::SCALE * 1.4426950408889634f)); }
            if (cb < 40.0f) {
            for (int v = vcu; v < 256; v += G) {
                const bool pr = v < 128;
                const int nun = pr ? 3 : 6, x = (v - 128) >> 5, qb = pr ? (v & 63) : (v & 31);
                for (int r6 = 0; r6 < nun; ++r6) {
                    const int pair = x * 2 + r6 / 3, sq = pair >> 1, kvh = pr ? (v >> 6) : (pair & 1), h = kvh * 3 + (r6 % 3);
                    const size_t sb = pr ? 0 : (size_t)S_P + (size_t)sq * S_S, r0 = sb + (size_t)qb * 256;
                    att::attn_body<false, 2>(PROJ + r0 * INW + COL_QC + h * 128, PROJ + sb * INW + COL_KC + kvh * 128, PROJ + sb * INW + COL_VC + kvh * 128, Y + r0 * DM + YCOL_C + h * 128, INW, INW, DM, pr ? S_P / 64 : S_S / 64, nob, alds);
                }
            }
            } else {
            for (int v = vcu; v < 256; v += G) {
                const bool pr = v < 128;
                const int nun = pr ? 3 : 6, x = (v - 128) >> 5, qb = pr ? (v & 63) : (v & 31);
                for (int r6 = 0; r6 < nun; ++r6) {
                    const int pair = x * 2 + r6 / 3, sq = pair >> 1, kvh = pr ? (v >> 6) : (pair & 1), h = kvh * 3 + (r6 % 3);
                    const size_t sb = pr ? 0 : (size_t)S_P + (size_t)sq * S_S, r0 = sb + (size_t)qb * 256;
                    att::attn_body<false, 1>(PROJ + r0 * INW + COL_QC + h * 128, PROJ + sb * INW + COL_KC + kvh * 128, PROJ + sb * INW + COL_VC + kvh * 128, Y + r0 * DM + YCOL_C + h * 128, INW, INW, DM, pr ? S_P / 64 : S_S / 64, nob, alds);
                }
            }
            }
            const float* sink = args.in[7] + (size_t)l * 4;
            for (int u = vcu; u < 768 + 1152; u += G) {
                const bool isA = u < 768; const int ub = u - 768;
                const int hh = isA ? (u & 3) : ub % 6, blk = isA ? (u >> 2) : ub / 6, dil = isA ? 1 : (hh < 2 ? 1 : (hh < 4 ? 4 : 16));
                const int R0 = blk * 256; const int sb = R0 < S_P ? 0 : S_P + ((R0 - S_P) / S_S) * S_S, Ls = R0 < S_P ? S_P : S_S;
                const int bis = (R0 - sb) / 256, L = Ls / dil, nbr = L / 256, res = bis / nbr, i0 = (bis - res * nbr) * 256;
                const size_t t0 = (size_t)sb + res + (size_t)i0 * dil;
                att::Band bd; bd.i0 = i0; bd.L = L; bd.hw = isA ? 128 : 64; bd.tlo = i0 / 64 - (isA ? 2 : 1); bd.m0 = isA ? sink[hh] * (1.0f / att::SCALE) : -1e30f; bd.l0 = isA ? 1.0f : 0.f;
                bd.lse = isA ? nullptr : lseb + t0 * 8 + hh; bd.lse_ld = (long)8 * dil;
                const bf16_t* pb_ = PROJ + ((size_t)sb + res) * INW;
                const int cq = isA ? COL_QA + hh * 128 : COL_QB + hh * 128, ck = isA ? COL_KA + (hh >> 1) * 128 : COL_KB + hh * 128, cv = isA ? COL_VA + (hh >> 1) * 128 : COL_VB + hh * 128;
                att::attn_body<true, 0>(PROJ + t0 * INW + cq, pb_ + ck, pb_ + cv, Y + t0 * DM + (isA ? YCOL_A : YCOL_B) + hh * 128, (long)INW * dil, (long)INW * dil, (long)DM * dil, isA ? 8 : 6, bd, alds);
            }
        PHASE_END
        PHASE_BEGIN(pb + 7)
            LOCAL_IDS
            if (l + 1 < DEPTH && rep_ == 0) convert_layer(args.in, l + 1, (bf16_t*)(ws + WS_W + (size_t)((l + 1) & 1) * W_SLOT), ldsl, gw, NGW, lane, wave);
            const int RPT = (M % (4 * NGW) == 0) ? 4 : 1;
            if (RPT == 4) {
            for (int m0 = gw; m0 < M; m0 += 4 * NGW) {
                f32x4 l03[4]; f32x2 l45[4]; u32x2 v[4][3];
#pragma unroll
                for (int q = 0; q < 4; ++q) { const int m = m0 + q * NGW; const float* lp = lseb + (size_t)m * 8; l03[q] = *(const f32x4*)lp; l45[q] = *(const f32x2*)(lp + 4);
                    const GAS u32x2* yp = (const GAS u32x2*)(Y + (size_t)m * DM + YCOL_B);
#pragma unroll
                    for (int k = 0; k < 3; ++k) v[q][k] = yp[lane + 64 * k]; }
#pragma unroll
                for (int q = 0; q < 4; ++q) { const int m = m0 + q * NGW;
                    const int j = lane >> 5;
                    const float a = j ? l03[q].y : l03[q].x, b = j ? l03[q].w : l03[q].z, c = j ? l45[q].y : l45[q].x, mx = fmaxf(a, fmaxf(b, c));
                    const float ea = __expf(a - mx), eb = __expf(b - mx), ec = __expf(c - mx), inv = 1.0f / (ea + eb + ec);
                    const float w0 = ea * inv, w1 = eb * inv, w2 = ec * inv;
                    GAS u32x2* yp = (GAS u32x2*)(Y + (size_t)m * DM + YCOL_B);
#pragma unroll
                    for (int k = 0; k < 3; ++k) {
                        float sc = k == 0 ? w0 : (k == 1 ? w1 : w2); if (REP_MASK && rep_ != ((REP_MASK >> 7) & 1)) sc = 1.0f;
                        const u32x2 x = v[q][k]; yp[lane + 64 * k] = (u32x2){cvt_pk_bf16(bf_lo(x.x) * sc, bf_hi(x.x) * sc), cvt_pk_bf16(bf_lo(x.y) * sc, bf_hi(x.y) * sc)}; } }
            }
            } else {
            for (int m = gw; m < M; m += NGW) {
                const float* lp = lseb + (size_t)m * 8;
                const f32x4 l03 = *(const f32x4*)lp; const f32x2 l45 = *(const f32x2*)(lp + 4);
                const int j = lane >> 5;
                const float a = j ? l03.y : l03.x, b = j ? l03.w : l03.z, c = j ? l45.y : l45.x, mx = fmaxf(a, fmaxf(b, c));
                const float ea = __expf(a - mx), eb = __expf(b - mx), ec = __expf(c - mx), inv = 1.0f / (ea + eb + ec);
                const float w0 = ea * inv, w1 = eb * inv, w2 = ec * inv;
                GAS u32x2* yp = (GAS u32x2*)(Y + (size_t)m * DM + YCOL_B);
#pragma unroll
                for (int k = 0; k < 3; ++k) { const int uu = lane + 64 * k;
                    float sc = k == 0 ? w0 : (k == 1 ? w1 : w2); if (REP_MASK && rep_ != ((REP_MASK >> 7) & 1)) sc = 1.0f;
                    const u32x2 x = yp[uu]; yp[uu] = (u32x2){cvt_pk_bf16(bf_lo(x.x) * sc, bf_hi(x.x) * sc), cvt_pk_bf16(bf_lo(x.y) * sc, bf_hi(x.y) * sc)}; }
            }
            }
        PHASE_END
        PHASE_BEGIN(pb + 8)
            pg8::ChainSched S; S.so.init(M, DM, G, bx, 4);
            pg8::EpiBranch E{GATES, MERGED};
            pg8::gemm_phase<pg8::EpiBranch, pg8::ChainSched>(ldsl + RING_OFF, Y, (const bf16_t*)((char*)Wb + WO_BR), DM, S, E);
        PHASE_END
        PHASE_BEGIN(pb + 9)
            pg8::PlainSched S; S.so.init(M, DM, G, bx, 4); S.nt = DM / 64;
            pg8::EpiStream E{HI, LO, ssb + (size_t)(3 * l + 2) * M * 8, rep_ == ((REP_MASK >> 9) & 1) ? 1.0f : 0.f, (LAS float*)(ldsl + HTAB_OFF)};
            pg8::gemm_phase<pg8::EpiStream, pg8::PlainSched>(ldsl + RING_OFF, MERGED, (const bf16_t*)((char*)Wb + WO_WO), DM, S, E);
        PHASE_END
        }
    }
    PHASE_BEGIN(PH_FINAL)
        LOCAL_IDS
        const float* g = args.in[17]; const float* ssf = ssb + (size_t)(NSS - 1) * M * 8;
        f32x4 gv[8];
#pragma unroll
        for (int j = 0; j < 8; ++j) gv[j] = ((const f32x4*)g)[lane + 64 * j];
        for (int m = gw; m < M; m += NGW) {
            const float rstd = 1.0f / sqrtf(row_ssq(ssf, m) * (1.0f / DM) + NORM_EPS);
            const GAS u32x2* ph = (const GAS u32x2*)(HI + (size_t)m * DM) + lane; const GAS u32x2* pl = (const GAS u32x2*)(LO + (size_t)m * DM) + lane;
            GAS f32x4* xr = (GAS f32x4*)(out + (size_t)m * DM) + lane;
#pragma unroll
            for (int j = 0; j < 8; ++j) { const u32x2 h = ph[64 * j], w = STREAM_LO ? pl[64 * j] : (u32x2){0u, 0u};
                const f32x4 x = (f32x4){bf_lo(h.x) + bf_lo(w.x), bf_hi(h.x) + bf_hi(w.x), bf_lo(h.y) + bf_lo(w.y), bf_hi(h.y) + bf_hi(w.y)};
                xr[64 * j] = x * rstd * gv[j]; }
        }
    PHASE_END
#undef PHASE_BEGIN
#undef PHASE_END
}

#ifndef N_LAUNCH_MODE
#define N_LAUNCH_MODE 1
#endif
extern "C" void kernel_launch(void* const* d_in, const int* in_sizes, int n_in, void* d_out, int out_size, void* d_ws, size_t ws_size, hipStream_t stream) {
    static int grid = 0;
    if (grid == 0) {
        if (n_in != 18 || out_size != M * DM || ws_size < WS_END) { fprintf(stderr, "kernel_launch: unexpected shapes: n_in %d out %d ws %zu (need %zu)\n", n_in, out_size, ws_size, (size_t)WS_END); grid = -1; return; }
        int dev = 0, cus = 0, per_cu = 0;
        if (hipGetDevice(&dev) != hipSuccess || hipDeviceGetAttribute(&cus, hipDeviceAttributeMultiprocessorCount, dev) != hipSuccess) { grid = -1; return; }
        if (hipFuncSetAttribute((const void*)fwd_kernel, hipFuncAttributeMaxDynamicSharedMemorySize, LDS_BYTES) != hipSuccess) { fprintf(stderr, "kernel_launch: hipFuncSetAttribute failed\n"); grid = -1; return; }
        if (hipOccupancyMaxActiveBlocksPerMultiprocessor(&per_cu, (const void*)fwd_kernel, NWAVES * 64, LDS_BYTES) != hipSuccess || per_cu < 1)
            fprintf(stderr, "kernel_launch: note: occupancy query reports %d workgroups per CU\n", per_cu);
        (void)hipGetLastError();
        grid = cus < 256 ? cus : 256;
    }
    if (grid < 0) return;
    if (hipMemsetAsync((char*)d_ws + WS_CTL, 0, CTL_ZERO_BYTES, stream) != hipSuccess) return;
    Args a{};
    for (int i = 0; i < 18; ++i) a.in[i] = (const float*)d_in[i];
    a.out = (float*)d_out; a.ws = (unsigned char*)d_ws;
#if N_LAUNCH_MODE == 1
    a.ph_lo = 0; a.ph_hi = PH_END;
    hipLaunchKernelGGL(fwd_kernel, dim3(grid), dim3(NWAVES * 64), LDS_BYTES, stream, a);
#ifdef RUN_TWICE
    (void)hipMemsetAsync((char*)d_ws + WS_CTL, 0, CTL_ZERO_BYTES, stream);
    hipLaunchKernelGGL(fwd_kernel, dim3(grid), dim3(NWAVES * 64), LDS_BYTES, stream, a);
#endif
#else
    for (int s = 0; s < NSTEP; ++s)
        for (int p = 0; p < PH_PER_STEP; ++p) { if (p == 3 || p == 5 || (p == 0 && s != 0) || ((s & 1) && p >= 3)) continue; a.ph_lo = s * PH_PER_STEP + p; a.ph_hi = a.ph_lo + 1;
            hipLaunchKernelGGL(fwd_kernel, dim3(grid), dim3(NWAVES * 64), LDS_BYTES, stream, a); }
    a.ph_lo = PH_FINAL; a.ph_hi = PH_END;
    hipLaunchKernelGGL(fwd_kernel, dim3(grid), dim3(NWAVES * 64), LDS_BYTES, stream, a);
#endif
    const hipError_t le = hipPeekAtLastError();
    if (le != hipSuccess) fprintf(stderr, "kernel_launch: launch failed: %s\n", hipGetErrorName(le));
}
```
